# Optimizing an MI355X kernel written in HIP

```python
import math
import jax
import jax.numpy as jnp
from jax import lax
import numpy as np

D_MODEL = 2048
BATCH = 2
SEQ = 4096
DEPTH = 2

N_A_LAYERS = max(1, DEPTH // 2)
N_B_LAYERS = DEPTH - N_A_LAYERS
S5_GROUP_CH = 16
S5_GROUPS = D_MODEL // S5_GROUP_CH
S5_STATE = 64
HEAD_DIM = 128
N_HEADS = D_MODEL // HEAD_DIM
N_KV_HEADS = 4
DILATED_PATTERNS = ((128, 1), (512, 4), (2048, 16))
N_GROUPS = len(DILATED_PATTERNS)
FFN_HIDDEN = ((8 * D_MODEL // 3 + 255) // 256) * 256
EPS = 1e-6
NEG_INF = -1e30

kernel_name = "yoco_s5_dilated_attention_hybrid"


def rms_norm(x, g):
    xf = x.astype(jnp.float32)
    r = lax.rsqrt(jnp.mean(xf * xf, axis=-1, keepdims=True) + EPS)
    return (xf * r * g.astype(jnp.float32)).astype(x.dtype)


def swiglu(h, w_in, w_out):
    gate, up = jnp.split(h @ w_in, 2, axis=-1)
    return (jax.nn.silu(gate) * up) @ w_out


def s5_mixer(u, lam_re, lam_im, log_dt, b_re, b_im, c_re, c_im, d_skip, w_glu):
    bsz, seq, dm = u.shape
    f32 = jnp.float32
    ug = u.astype(f32).reshape(bsz, seq, S5_GROUPS, S5_GROUP_CH)
    lr = lam_re.astype(f32)
    li = lam_im.astype(f32)
    dt = jnp.exp(log_dt.astype(f32))[:, None]
    mag = jnp.exp(lr * dt)
    ang = li * dt
    lb_re = mag * jnp.cos(ang)
    lb_im = mag * jnp.sin(ang)
    nr = lb_re - 1.0
    den = lr * lr + li * li
    f_re = (nr * lr + lb_im * li) / den
    f_im = (lb_im * lr - nr * li) / den
    br = b_re.astype(f32)
    bi = b_im.astype(f32)
    bb_re = f_re[..., None] * br - f_im[..., None] * bi
    bb_im = f_re[..., None] * bi + f_im[..., None] * br
    bu_re = jnp.einsum('bsgc,gpc->bsgp', ug, bb_re)
    bu_im = jnp.einsum('bsgc,gpc->bsgp', ug, bb_im)
    a_re = jnp.broadcast_to(lb_re, bu_re.shape)
    a_im = jnp.broadcast_to(lb_im, bu_im.shape)

    def combine(e1, e2):
        a1r, a1i, b1r, b1i = e1
        a2r, a2i, b2r, b2i = e2
        return (a2r * a1r - a2i * a1i,
                a2r * a1i + a2i * a1r,
                a2r * b1r - a2i * b1i + b2r,
                a2r * b1i + a2i * b1r + b2i)

    _, _, xs_re, xs_im = lax.associative_scan(combine, (a_re, a_im, bu_re, bu_im), axis=1)
    y = (jnp.einsum('bsgp,gcp->bsgc', xs_re, c_re.astype(f32))
         - jnp.einsum('bsgp,gcp->bsgc', xs_im, c_im.astype(f32)))
    y = y.reshape(bsz, seq, dm) + d_skip.astype(f32) * u.astype(f32)
    z = jax.nn.gelu(y).astype(u.dtype)
    val, gate = jnp.split(z @ w_glu, 2, axis=-1)
    return val * jax.nn.sigmoid(gate)


def dilated_window_attention(q, k, v, window, dilation):
    bsz, seq, nh, hd = q.shape
    nkv = k.shape[2]
    rep = nh // nkv
    n = seq // dilation
    blk = window // dilation
    nb = -(-n // blk)
    pad = nb * blk - n

    def to_residue(t):
        h = t.shape[2]
        t = t.reshape(bsz, n, dilation, h, hd).transpose(0, 2, 1, 3, 4)
        t = t.reshape(bsz * dilation, n, h, hd)
        t = jnp.pad(t, ((0, 0), (0, pad), (0, 0), (0, 0)))
        return t.reshape(bsz * dilation, nb, blk, h, hd)

    def with_prev(t):
        prev = jnp.pad(t, ((0, 0), (1, 0), (0, 0), (0, 0), (0, 0)))[:, :-1]
        return jnp.concatenate([prev, t], axis=2)

    qr = to_residue(q).reshape(bsz * dilation, nb, blk, nkv, rep, hd)
    kb = with_prev(to_residue(k))
    vb = with_prev(to_residue(v))
    scores = jnp.einsum('znqkge,znske->znkgqs', qr, kb).astype(jnp.float32) * (hd ** -0.5)
    qi = jnp.arange(blk)[:, None]
    si = jnp.arange(2 * blk)[None, :]
    dist = qi + blk - si
    band = (dist >= 0) & (dist <= blk)
    valid = band[None] & ((jnp.arange(nb)[:, None, None] > 0) | (si[None] >= blk))
    scores = jnp.where(valid[None, :, None, None], scores, NEG_INF)
    m = jnp.max(scores, axis=-1, keepdims=True)
    p = jnp.exp(scores - m)
    l = jnp.sum(p, axis=-1, keepdims=True)
    out = jnp.einsum('znkgqs,znske->znqkge', (p / l).astype(v.dtype), vb)
    lse = (m + jnp.log(l))[..., 0]
    out = out.reshape(bsz * dilation, nb * blk, nh, hd)[:, :n]
    out = out.reshape(bsz, dilation, n, nh, hd).transpose(0, 2, 1, 3, 4).reshape(bsz, seq, nh, hd)
    lse = lse.transpose(0, 1, 4, 2, 3).reshape(bsz * dilation, nb * blk, nh)[:, :n]
    lse = lse.reshape(bsz, dilation, n, nh).transpose(0, 2, 1, 3).reshape(bsz, seq, nh)
    return out, lse


def dilated_mixer(h, k, v, w_q, w_o):
    bsz, seq, _ = h.shape
    q = (h @ w_q).reshape(bsz, seq, N_GROUPS, N_HEADS, HEAD_DIM)
    outs = []
    lses = []
    for g, (window, dilation) in enumerate(DILATED_PATTERNS):
        o, l = dilated_window_attention(q[:, :, g], k, v, window, dilation)
        outs.append(o)
        lses.append(l)
    wts = jax.nn.softmax(jnp.stack(lses, axis=0), axis=0)
    o = jnp.sum(wts[..., None] * jnp.stack(outs, axis=0).astype(jnp.float32), axis=0)
    return o.astype(h.dtype).reshape(bsz, seq, N_HEADS * HEAD_DIM) @ w_o


def setup_inputs(seed: int = 0) -> dict:
    key = jax.random.key(seed)
    ks = jax.random.split(key, 24)
    f32 = jnp.float32

    def nrm(k, shape, scale):
        return jax.random.normal(k, shape, f32) * scale

    na, nbl, D, F = N_A_LAYERS, N_B_LAYERS, D_MODEL, FFN_HIDDEN
    G, P, C = S5_GROUPS, S5_STATE, S5_GROUP_CH
    x = nrm(ks[0], (BATCH, SEQ, D), 1.0)
    n_idx = jnp.arange(P, dtype=f32)
    s5_lam_re = -0.5 + nrm(ks[1], (na, G, P), 0.01)
    s5_lam_im = math.pi * n_idx + nrm(ks[2], (na, G, P), 0.01)
    s5_log_dt = jax.random.uniform(ks[3], (na, G), f32, math.log(1e-3), math.log(1e-1))
    s5_b_re = nrm(ks[4], (na, G, P, C), (2 * C) ** -0.5)
    s5_b_im = nrm(ks[5], (na, G, P, C), (2 * C) ** -0.5)
    s5_c_re = nrm(ks[6], (na, G, C, P), (2 * P) ** -0.5)
    s5_c_im = nrm(ks[7], (na, G, C, P), (2 * P) ** -0.5)
    s5_d = nrm(ks[8], (na, D), 1.0)
    s5_w_glu = nrm(ks[9], (na, D, 2 * D), D ** -0.5)
    a_norm_mix = 1.0 + nrm(ks[10], (na, D), 0.02)
    ffn_norm = 1.0 + nrm(ks[11], (DEPTH, D), 0.02)
    ffn_w_in = nrm(ks[12], (DEPTH, D, 2 * F), D ** -0.5)
    ffn_w_out = nrm(ks[13], (DEPTH, F, D), F ** -0.5)
    b_norm_mix = 1.0 + nrm(ks[14], (nbl, D), 0.02)
    attn_w_q = nrm(ks[15], (nbl, D, N_GROUPS * N_HEADS * HEAD_DIM), D ** -0.5)
    attn_w_o = nrm(ks[16], (nbl, N_HEADS * HEAD_DIM, D), (N_HEADS * HEAD_DIM) ** -0.5)
    kv_norm = 1.0 + nrm(ks[17], (D,), 0.02)
    w_kv = nrm(ks[18], (D, 2 * N_KV_HEADS * HEAD_DIM), D ** -0.5)
    final_norm = 1.0 + nrm(ks[19], (D,), 0.02)
    return {"x": x, "s5_lam_re": s5_lam_re, "s5_lam_im": s5_lam_im, "s5_log_dt": s5_log_dt,
            "s5_b_re": s5_b_re, "s5_b_im": s5_b_im, "s5_c_re": s5_c_re, "s5_c_im": s5_c_im,
            "s5_d": s5_d, "s5_w_glu": s5_w_glu, "a_norm_mix": a_norm_mix,
            "ffn_norm": ffn_norm, "ffn_w_in": ffn_w_in, "ffn_w_out": ffn_w_out,
            "b_norm_mix": b_norm_mix, "attn_w_q": attn_w_q, "attn_w_o": attn_w_o,
            "kv_norm": kv_norm, "w_kv": w_kv, "final_norm": final_norm}


def reference(x, s5_lam_re, s5_lam_im, s5_log_dt, s5_b_re, s5_b_im, s5_c_re, s5_c_im,
              s5_d, s5_w_glu, a_norm_mix, ffn_norm, ffn_w_in, ffn_w_out,
              b_norm_mix, attn_w_q, attn_w_o, kv_norm, w_kv, final_norm):
    bsz, seq, _ = x.shape
    k = None
    v = None
    for layer in range(DEPTH):
        if layer < N_A_LAYERS:
            i = layer
            h = rms_norm(x, a_norm_mix[i])
            x = x + s5_mixer(h, s5_lam_re[i], s5_lam_im[i], s5_log_dt[i], s5_b_re[i], s5_b_im[i],
                             s5_c_re[i], s5_c_im[i], s5_d[i], s5_w_glu[i])
        else:
            j = layer - N_A_LAYERS
            if j == 0:
                kv = (rms_norm(x, kv_norm) @ w_kv).reshape(bsz, seq, 2, N_KV_HEADS, HEAD_DIM)
                k = kv[:, :, 0]
                v = kv[:, :, 1]
            h = rms_norm(x, b_norm_mix[j])
            x = x + dilated_mixer(h, k, v, attn_w_q[j], attn_w_o[j])
        x = x + swiglu(rms_norm(x, ffn_norm[layer]), ffn_w_in[layer], ffn_w_out[layer])
    return rms_norm(x, final_norm)
```

```cpp
#include <hip/hip_runtime.h>
#include <cstdint>
#include <cstdio>

namespace {
constexpr int D = 2048, NB = 2, S = 4096, T = NB * S;
constexpr int G = 128, P = 64, C = 16;
constexpr int NH = 16, HD = 128, NKV = 4, NG = 3;
constexpr int F = 5632;
constexpr float EPS = 1e-6f;

__device__ __forceinline__ float wave_sum(float v) {
#pragma unroll
    for (int o = 1; o < 64; o <<= 1) v += __shfl_xor(v, o);
    return v;
}
__device__ __forceinline__ float wave_max(float v) {
#pragma unroll
    for (int o = 1; o < 64; o <<= 1) v = fmaxf(v, __shfl_xor(v, o));
    return v;
}
__device__ __forceinline__ float gelu_tanh(float y) {
    const float k0 = 0.7978845608028654f, k1 = 0.044715f;
    float in = k0 * (y + k1 * y * y * y);
    return 0.5f * y * (1.f + tanhf(in));
}
__device__ __forceinline__ float sigmoidf_(float v) { return 1.f / (1.f + expf(-v)); }

__global__ __launch_bounds__(256) void rowrstd_kernel(const float* __restrict__ x, float* __restrict__ rstd) {
    const int wave = threadIdx.x >> 6, lane = threadIdx.x & 63;
    const int row = blockIdx.x * 4 + wave;
    const float4* xr = (const float4*)(x + (size_t)row * D);
    float s = 0.f;
#pragma unroll
    for (int j = 0; j < D / 256; ++j) { float4 v = xr[lane + 64 * j]; s += v.x * v.x + v.y * v.y + v.z * v.z + v.w * v.w; }
    s = wave_sum(s);
    if (lane == 0) rstd[row] = rsqrtf(s * (1.f / D) + EPS);
}

__global__ __launch_bounds__(256) void final_norm_kernel(const float* __restrict__ x, const float* __restrict__ g, float* __restrict__ out) {
    const int wave = threadIdx.x >> 6, lane = threadIdx.x & 63;
    const int row = blockIdx.x * 4 + wave;
    const float4* xr = (const float4*)(x + (size_t)row * D);
    const float4* gr = (const float4*)g;
    float4* orow = (float4*)(out + (size_t)row * D);
    float4 v[D / 256];
    float s = 0.f;
#pragma unroll
    for (int j = 0; j < D / 256; ++j) { v[j] = xr[lane + 64 * j]; s += v[j].x * v[j].x + v[j].y * v[j].y + v[j].z * v[j].z + v[j].w * v[j].w; }
    s = wave_sum(s);
    const float r = rsqrtf(s * (1.f / D) + EPS);
#pragma unroll
    for (int j = 0; j < D / 256; ++j) { float4 gg = gr[lane + 64 * j]; float4 o; o.x = v[j].x * r * gg.x; o.y = v[j].y * r * gg.y; o.z = v[j].z * r * gg.z; o.w = v[j].w * r * gg.w; orow[lane + 64 * j] = o; }
}

__global__ __launch_bounds__(64) void s5_simple_kernel(const float* __restrict__ x, const float* __restrict__ rstd, const float* __restrict__ gn,
        const float* __restrict__ lam_re, const float* __restrict__ lam_im, const float* __restrict__ log_dt,
        const float* __restrict__ b_re, const float* __restrict__ b_im, const float* __restrict__ c_re, const float* __restrict__ c_im,
        const float* __restrict__ d_skip, float* __restrict__ z) {
    const int bg = blockIdx.x, b = bg / G, g = bg % G, p = threadIdx.x;
    const float lr = lam_re[g * P + p], li = lam_im[g * P + p];
    const float dt = expf(log_dt[g]);
    const float mag = expf(lr * dt), ang = li * dt;
    const float lbr = mag * cosf(ang), lbi = mag * sinf(ang);
    const float nr = lbr - 1.f, den = lr * lr + li * li;
    const float fr = (nr * lr + lbi * li) / den, fi = (lbi * lr - nr * li) / den;
    float bbr[C], bbi[C], cr[C], ci[C];
#pragma unroll
    for (int c = 0; c < C; ++c) {
        const float br = b_re[(g * P + p) * C + c], bi = b_im[(g * P + p) * C + c];
        bbr[c] = fr * br - fi * bi; bbi[c] = fr * bi + fi * br;
        cr[c] = c_re[(g * C + c) * P + p]; ci[c] = c_im[(g * C + c) * P + p];
    }
    const int pc = p & 15;
    const float gnp = gn[g * C + pc], dp = d_skip[g * C + pc];
    float gnc[C];
#pragma unroll
    for (int c = 0; c < C; ++c) gnc[c] = gn[g * C + c];
    float xr = 0.f, xi = 0.f;
    for (int t = 0; t < S; ++t) {
        const size_t row = (size_t)b * S + t;
        const float* xp = x + row * D + g * C;
        const float r = rstd[row];
        float bur = 0.f, bui = 0.f;
#pragma unroll
        for (int c = 0; c < C; ++c) { const float u = xp[c] * r * gnc[c]; bur += bbr[c] * u; bui += bbi[c] * u; }
        const float nxr = lbr * xr - lbi * xi + bur, nxi = lbr * xi + lbi * xr + bui;
        xr = nxr; xi = nxi;
        float myy = 0.f;
#pragma unroll
        for (int c = 0; c < C; ++c) { float v = cr[c] * xr - ci[c] * xi; v = wave_sum(v); if (p == c) myy = v; }
        if (p < C) { const float up = xp[pc] * r * gnp; z[row * D + g * C + p] = gelu_tanh(myy + dp * up); }
    }
}

template <int MODE>
__global__ __launch_bounds__(256) void gemm_simple(const float* __restrict__ A, int lda, const float* __restrict__ rstd, const float* __restrict__ gain,
        const float* __restrict__ W, int ldw, int col2, const float* res, float* out, int ldo, int K) {
    constexpr bool PAIRED = (MODE == 2 || MODE == 3);
    __shared__ float As[16][68];
    __shared__ float Bs[16][64];
    __shared__ float B2s[PAIRED ? 16 : 1][64];
    const int tid = threadIdx.x, tx = tid & 15, ty = tid >> 4;
    const int m0 = blockIdx.y * 64, n0 = blockIdx.x * 64;
    float acc1[4][4], acc2[4][4];
#pragma unroll
    for (int i = 0; i < 4; ++i)
#pragma unroll
        for (int j = 0; j < 4; ++j) { acc1[i][j] = 0.f; acc2[i][j] = 0.f; }
    const int ar = tid >> 2, ak = (tid & 3) * 4;
    const float rs = rstd ? rstd[m0 + ar] : 1.f;
    const int bk = tid >> 4, bn = (tid & 15) * 4;
    for (int k0 = 0; k0 < K; k0 += 16) {
        float4 av = *(const float4*)(A + (size_t)(m0 + ar) * lda + k0 + ak);
        if (rstd) { const float4 gv = *(const float4*)(gain + k0 + ak); av.x *= rs * gv.x; av.y *= rs * gv.y; av.z *= rs * gv.z; av.w *= rs * gv.w; }
        const float4 bv = *(const float4*)(W + (size_t)(k0 + bk) * ldw + n0 + bn);
        float4 b2v = bv;
        if (PAIRED) b2v = *(const float4*)(W + (size_t)(k0 + bk) * ldw + n0 + bn + col2);
        __syncthreads();
        As[ak + 0][ar] = av.x; As[ak + 1][ar] = av.y; As[ak + 2][ar] = av.z; As[ak + 3][ar] = av.w;
        *(float4*)&Bs[bk][bn] = bv;
        if (PAIRED) *(float4*)&B2s[bk][bn] = b2v;
        __syncthreads();
#pragma unroll
        for (int k = 0; k < 16; ++k) {
            const float4 a = *(const float4*)&As[k][ty * 4];
            const float4 bq = *(const float4*)&Bs[k][tx * 4];
            const float aa[4] = {a.x, a.y, a.z, a.w}, bb[4] = {bq.x, bq.y, bq.z, bq.w};
#pragma unroll
            for (int i = 0; i < 4; ++i)
#pragma unroll
                for (int j = 0; j < 4; ++j) acc1[i][j] += aa[i] * bb[j];
            if (PAIRED) {
                const float4 b2 = *(const float4*)&B2s[k][tx * 4];
                const float b2b[4] = {b2.x, b2.y, b2.z, b2.w};
#pragma unroll
                for (int i = 0; i < 4; ++i)
#pragma unroll
                    for (int j = 0; j < 4; ++j) acc2[i][j] += aa[i] * b2b[j];
            }
        }
    }
#pragma unroll
    for (int i = 0; i < 4; ++i) {
        const size_t off = (size_t)(m0 + ty * 4 + i) * ldo + n0 + tx * 4;
        float4 rv = {0.f, 0.f, 0.f, 0.f};
        if (MODE == 1 || MODE == 2) rv = *(const float4*)(res + off);
        float o[4]; const float rr[4] = {rv.x, rv.y, rv.z, rv.w};
#pragma unroll
        for (int j = 0; j < 4; ++j) {
            const float a1 = acc1[i][j], a2 = acc2[i][j];
            if (MODE == 0) o[j] = a1;
            else if (MODE == 1) o[j] = rr[j] + a1;
            else if (MODE == 2) o[j] = rr[j] + a1 * sigmoidf_(a2);
            else o[j] = (a1 * sigmoidf_(a1)) * a2;
        }
        *(float4*)(out + off) = make_float4(o[0], o[1], o[2], o[3]);
    }
}

__global__ __launch_bounds__(256) void attn_simple_kernel(const float* __restrict__ q, const float* __restrict__ kv, float* __restrict__ o) {
    __shared__ float qs[4][HD];
    const int wave = threadIdx.x >> 6, lane = threadIdx.x & 63;
    const int idx = blockIdx.x * 4 + wave;
    const int row = idx / NH, h = idx % NH, b = row / S, t = row % S, kvh = h / (NH / NKV);
    const float scale = 0.08838834764831845f;
    float og[NG][2], lse[NG];
#pragma unroll
    for (int g = 0; g < NG; ++g) {
        const int dil = (g == 0) ? 1 : (g == 1 ? 4 : 16);
        const float* qp = q + (size_t)row * (NG * NH * HD) + g * (NH * HD) + h * HD;
        __syncthreads();
        qs[wave][lane] = qp[lane]; qs[wave][lane + 64] = qp[lane + 64];
        __syncthreads();
        float sc[3];
#pragma unroll
        for (int pass = 0; pass < 3; ++pass) {
            const int j = pass * 64 + lane;
            const int tk = t - j * dil;
            float s = -1e30f;
            if (j <= 128 && tk >= 0) {
                const float4* kp = (const float4*)(kv + (size_t)(b * S + tk) * (2 * NKV * HD) + kvh * HD);
                float a = 0.f;
#pragma unroll 8
                for (int e = 0; e < HD / 4; ++e) { const float4 k4 = kp[e]; a += qs[wave][4 * e] * k4.x + qs[wave][4 * e + 1] * k4.y + qs[wave][4 * e + 2] * k4.z + qs[wave][4 * e + 3] * k4.w; }
                s = a * scale;
            }
            sc[pass] = s;
        }
        const float m = wave_max(fmaxf(fmaxf(sc[0], sc[1]), sc[2]));
        float pr[3]; float l = 0.f;
#pragma unroll
        for (int pass = 0; pass < 3; ++pass) { pr[pass] = (sc[pass] > -1e29f) ? expf(sc[pass] - m) : 0.f; l += pr[pass]; }
        l = wave_sum(l);
        lse[g] = m + logf(l);
        float a0 = 0.f, a1 = 0.f;
#pragma unroll
        for (int pass = 0; pass < 3; ++pass) {
            const int jn = (pass < 2) ? 64 : 1;
            for (int jj = 0; jj < jn; ++jj) {
                const float pj = __shfl(pr[pass], jj);
                const int j = pass * 64 + jj; const int tk = t - j * dil;
                if (tk >= 0) {
                    const float* vp = kv + (size_t)(b * S + tk) * (2 * NKV * HD) + NKV * HD + kvh * HD;
                    a0 += pj * vp[lane]; a1 += pj * vp[lane + 64];
                }
            }
        }
        og[g][0] = a0 / l; og[g][1] = a1 / l;
    }
    const float mx = fmaxf(fmaxf(lse[0], lse[1]), lse[2]);
    const float w0 = expf(lse[0] - mx), w1 = expf(lse[1] - mx), w2 = expf(lse[2] - mx), ws = w0 + w1 + w2;
    float* op = o + (size_t)row * D + h * HD;
    op[lane] = (w0 * og[0][0] + w1 * og[1][0] + w2 * og[2][0]) / ws;
    op[lane + 64] = (w0 * og[0][1] + w1 * og[1][1] + w2 * og[2][1]) / ws;
}
}

extern "C" void kernel_launch(void* const* d_in, const int* in_sizes, int n_in, void* d_out, int out_size, void* d_ws, size_t ws_size, hipStream_t stream) {
    const float* x = (const float*)d_in[0];
    const float* lam_re = (const float*)d_in[1]; const float* lam_im = (const float*)d_in[2]; const float* log_dt = (const float*)d_in[3];
    const float* b_re = (const float*)d_in[4]; const float* b_im = (const float*)d_in[5]; const float* c_re = (const float*)d_in[6]; const float* c_im = (const float*)d_in[7];
    const float* s5_d = (const float*)d_in[8]; const float* w_glu = (const float*)d_in[9]; const float* a_norm = (const float*)d_in[10];
    const float* ffn_norm = (const float*)d_in[11]; const float* w_in = (const float*)d_in[12]; const float* w_out = (const float*)d_in[13];
    const float* b_norm = (const float*)d_in[14]; const float* w_q = (const float*)d_in[15]; const float* w_o = (const float*)d_in[16];
    const float* kv_norm = (const float*)d_in[17]; const float* w_kv = (const float*)d_in[18]; const float* final_norm = (const float*)d_in[19];
    float* out = (float*)d_out;
    char* ws = (char*)d_ws;
    const size_t MiB = 1u << 20;
    float* rstd = (float*)(ws);
    float* XA = (float*)(ws + 1 * MiB);
    float* ZO = (float*)(ws + 65 * MiB);
    float* KV = (float*)(ws + 129 * MiB);
    float* HQ = (float*)(ws + 161 * MiB);
    if (ws_size < 353 * MiB) { fprintf(stderr, "ws too small\n"); return; }

    rowrstd_kernel<<<T / 4, 256, 0, stream>>>(x, rstd);
    s5_simple_kernel<<<NB * G, 64, 0, stream>>>(x, rstd, a_norm, lam_re, lam_im, log_dt, b_re, b_im, c_re, c_im, s5_d, ZO);
    gemm_simple<2><<<dim3(D / 64, T / 64), 256, 0, stream>>>(ZO, D, nullptr, nullptr, w_glu, 2 * D, D, x, XA, D, D);
    rowrstd_kernel<<<T / 4, 256, 0, stream>>>(XA, rstd);
    gemm_simple<3><<<dim3(F / 64, T / 64), 256, 0, stream>>>(XA, D, rstd, ffn_norm, w_in, 2 * F, F, nullptr, HQ, F, D);
    gemm_simple<1><<<dim3(D / 64, T / 64), 256, 0, stream>>>(HQ, F, nullptr, nullptr, w_out, D, 0, XA, XA, D, F);
    rowrstd_kernel<<<T / 4, 256, 0, stream>>>(XA, rstd);
    gemm_simple<0><<<dim3(2 * NKV * HD / 64, T / 64), 256, 0, stream>>>(XA, D, rstd, kv_norm, w_kv, 2 * NKV * HD, 0, nullptr, KV, 2 * NKV * HD, D);
    gemm_simple<0><<<dim3(NG * NH * HD / 64, T / 64), 256, 0, stream>>>(XA, D, rstd, b_norm, w_q, NG * NH * HD, 0, nullptr, HQ, NG * NH * HD, D);
    attn_simple_kernel<<<T * NH / 4, 256, 0, stream>>>(HQ, KV, ZO);
    gemm_simple<1><<<dim3(D / 64, T / 64), 256, 0, stream>>>(ZO, D, nullptr, nullptr, w_o, D, 0, XA, XA, D, D);
    rowrstd_kernel<<<T / 4, 256, 0, stream>>>(XA, rstd);
    gemm_simple<3><<<dim3(F / 64, T / 64), 256, 0, stream>>>(XA, D, rstd, ffn_norm + D, w_in + (size_t)D * 2 * F, 2 * F, F, nullptr, HQ, F, D);
    gemm_simple<1><<<dim3(D / 64, T / 64), 256, 0, stream>>>(HQ, F, nullptr, nullptr, w_out + (size_t)F * D, D, 0, XA, XA, D, F);
    final_norm_kernel<<<T / 4, 256, 0, stream>>>(XA, final_norm, out);
}
```

```cpp
#include <hip/hip_runtime.h>
#include <cstdint>
#include <cstdio>
namespace pg8 {
#define PG8_LAS __attribute__((address_space(3)))
typedef unsigned short bf16_t;
typedef short bf16x8 __attribute__((ext_vector_type(8)));
typedef float f32x4 __attribute__((ext_vector_type(4)));
typedef unsigned u32x4 __attribute__((ext_vector_type(4)));
constexpr int BM = 256, BK = 64, HALF = 128, HTB = HALF * BK * 2  , STAGE_BYTES = 8 * HTB, NXCD = 8, WGM = 8;

__host__ __device__ __forceinline__ int lds_byte(int r, int c) { const int st = (r >> 4) * 2 + (c >> 5), rr = r & 15, cc = c & 31, ob = rr * 64 + cc * 2; return st * 1024 + (ob ^ (((ob >> 9) & 1) << 5)); }
__host__ __device__ __forceinline__ void stage_rc(int b, int& R, int& C) { const int st = b / 1024, sb = b % 1024, swz = sb ^ (((sb >> 9) & 1) << 5); R = (st >> 1) * 16 + swz / 64; C = (st & 1) * 32 + (swz % 64) / 2; }
__host__ __device__ __forceinline__ int perm32(int rho) { const int n = rho >> 4, i = rho & 15; return 8 * (i >> 2) + 4 * n + (i & 3); }

struct Unit { int pm, pn; };
struct Gemm { const bf16_t* A; const bf16_t* Bt; int M, N, K; };

struct StaticOrder {
    int nM, nN, nwg, G, c;
    __host__ __device__ void init(int M, int N, int G_, int c_) { nM = M / BM; nN = N / BM; nwg = nM * nN; G = G_; c = c_; }
    __host__ __device__ bool next(int i, Unit& u) const {
        const long L = (long)i * G + c; if (L >= nwg) return false;
        int wgid = (int)L; { const int q = nwg / NXCD, r = nwg % NXCD, xcd = wgid % NXCD, off = wgid / NXCD; wgid = (xcd < r ? xcd * (q + 1) : r * (q + 1) + (xcd - r) * q) + off; }
        const int nig = WGM * nN, gid = wgid / nig, fm = gid * WGM, gsz = (nM - fm) < WGM ? (nM - fm) : WGM;
        u.pm = fm + ((wgid % nig) % gsz); u.pn = (wgid % nig) / gsz; return true;
    }
    __device__ __forceinline__ void a_ready(const Unit&) const {}
    __device__ __forceinline__ void done(const Unit&) const {}
};

__device__ __forceinline__ unsigned cvt_pk_bf16(float lo, float hi) { unsigned r; asm volatile("v_cvt_pk_bf16_f32 %0, %1, %2" : "=v"(r) : "v"(lo), "v"(hi)); return r; }
__device__ __forceinline__ float sigm(float v) { return __builtin_amdgcn_rcpf(1.0f + __builtin_amdgcn_exp2f(v * -1.4426950408889634f)); }
__device__ __forceinline__ u32x4 pack8(const f32x4& a, const f32x4& b) { u32x4 w; w.x = cvt_pk_bf16(a[0], a[1]); w.y = cvt_pk_bf16(a[2], a[3]); w.z = cvt_pk_bf16(b[0], b[1]); w.w = cvt_pk_bf16(b[2], b[3]); return w; }
constexpr int DM = 2048;
constexpr float NORM_EPS = 1e-6f;

struct EpiGluRes {
    static constexpr bool PERM = true, AFTER_DRAIN = false;
    const float* res; float* XA; bf16_t* XB; float* rowsq;
    __device__ __forceinline__ void operator()(const f32x4 (&acc)[2][2][4][2], const Unit& u, int wr, int wc, int fr, int fq) const {
        const int row0 = u.pm * BM + wr * 64 + fr, col0 = u.pn * HALF + wc * 32 + 8 * fq;
#pragma unroll
        for (int ai = 0; ai < 2; ++ai)
#pragma unroll
            for (int m = 0; m < 4; ++m) {
                const int row = row0 + ai * HALF + m * 16; const size_t off = (size_t)row * DM + col0;
                const f32x4 r0 = *(const f32x4*)(res + off), r1 = *(const f32x4*)(res + off + 4);
                f32x4 v0, v1;
#pragma unroll
                for (int j = 0; j < 4; ++j) { v0[j] = r0[j] + acc[ai][0][m][0][j] * sigm(acc[ai][1][m][0][j]); v1[j] = r1[j] + acc[ai][0][m][1][j] * sigm(acc[ai][1][m][1][j]); }
                *(f32x4*)(XA + off) = v0; *(f32x4*)(XA + off + 4) = v1;
                *(u32x4*)(XB + off) = pack8(v0, v1);
                float s = (v0[0] * v0[0] + v0[1] * v0[1]) + (v0[2] * v0[2] + v0[3] * v0[3]) + (v1[0] * v1[0] + v1[1] * v1[1]) + (v1[2] * v1[2] + v1[3] * v1[3]);
                s += __shfl_xor(s, 16); s += __shfl_xor(s, 32);
                if (fq == 0) atomicAdd(rowsq + row, s);
            }
    }
};
struct EpiSwiGlu {
    static constexpr bool PERM = true, AFTER_DRAIN = false;
    const float* rowsq; bf16_t* H; int ldh;
    __device__ __forceinline__ void operator()(const f32x4 (&acc)[2][2][4][2], const Unit& u, int wr, int wc, int fr, int fq) const {
        const int row0 = u.pm * BM + wr * 64 + fr, col0 = u.pn * HALF + wc * 32 + 8 * fq;
#pragma unroll
        for (int ai = 0; ai < 2; ++ai)
#pragma unroll
            for (int m = 0; m < 4; ++m) {
                const int row = row0 + ai * HALF + m * 16;
                const float rs = __builtin_amdgcn_rsqf(rowsq[row] * (1.0f / DM) + NORM_EPS);
                f32x4 v0, v1;
#pragma unroll
                for (int j = 0; j < 4; ++j) { const float g0 = acc[ai][0][m][0][j] * rs, g1 = acc[ai][0][m][1][j] * rs;
                    v0[j] = g0 * sigm(g0) * (acc[ai][1][m][0][j] * rs); v1[j] = g1 * sigm(g1) * (acc[ai][1][m][1][j] * rs); }
                *(u32x4*)(H + (size_t)row * ldh + col0) = pack8(v0, v1);
            }
    }
};
template <bool WRITE_XB> struct EpiRes {
    static constexpr bool PERM = true, AFTER_DRAIN = false;
    float* XA; bf16_t* XB; float* rowsq;
    __device__ __forceinline__ void operator()(const f32x4 (&acc)[2][2][4][2], const Unit& u, int wr, int wc, int fr, int fq) const {
        const int row0 = u.pm * BM + wr * 64 + fr, col0 = u.pn * BM + wc * 32 + 8 * fq;
#pragma unroll
        for (int ai = 0; ai < 2; ++ai)
#pragma unroll
            for (int m = 0; m < 4; ++m) {
                const int row = row0 + ai * HALF + m * 16; float s = 0.f;
#pragma unroll
                for (int bj = 0; bj < 2; ++bj) {
                    const size_t off = (size_t)row * DM + col0 + bj * HALF;
                    const f32x4 v0 = *(const f32x4*)(XA + off) + acc[ai][bj][m][0], v1 = *(const f32x4*)(XA + off + 4) + acc[ai][bj][m][1];
                    *(f32x4*)(XA + off) = v0; *(f32x4*)(XA + off + 4) = v1;
                    if (WRITE_XB) *(u32x4*)(XB + off) = pack8(v0, v1);
                    s += (v0[0] * v0[0] + v0[1] * v0[1]) + (v0[2] * v0[2] + v0[3] * v0[3]) + (v1[0] * v1[0] + v1[1] * v1[1]) + (v1[2] * v1[2] + v1[3] * v1[3]);
                }
                s += __shfl_xor(s, 16); s += __shfl_xor(s, 32);
                if (fq == 0) atomicAdd(rowsq + row, s);
            }
    }
};
struct EpiQKV {
    static constexpr bool PERM = true, AFTER_DRAIN = false;
    const float* rowsq; bf16_t* Q; bf16_t* K; bf16_t* V; float qscale;
    __device__ __forceinline__ void operator()(const f32x4 (&acc)[2][2][4][2], const Unit& u, int wr, int wc, int fr, int fq) const {
        const int row0 = u.pm * BM + wr * 64 + fr;
        bf16_t* base; int ld, colt; float sc = 1.f;
        if (u.pn < 24) { base = Q; ld = 6144; colt = u.pn * BM; sc = qscale; }
        else if (u.pn < 26) { base = K; ld = 512; colt = (u.pn - 24) * BM; }
        else { base = V; ld = 512; colt = (u.pn - 26) * BM; }
        const int col0 = colt + wc * 32 + 8 * fq;
#pragma unroll
        for (int ai = 0; ai < 2; ++ai)
#pragma unroll
            for (int m = 0; m < 4; ++m) {
                const int row = row0 + ai * HALF + m * 16;
                const float rs = __builtin_amdgcn_rsqf(rowsq[row] * (1.0f / DM) + NORM_EPS) * sc;
#pragma unroll
                for (int bj = 0; bj < 2; ++bj) *(u32x4*)(base + (size_t)row * ld + col0 + bj * HALF) = pack8(acc[ai][bj][m][0] * rs, acc[ai][bj][m][1] * rs);
            }
    }
};
template <class Epi, class Sched, bool ALIGN_EPI = false, bool SP2 = false>
__device__ __forceinline__ void gemm_phase(PG8_LAS unsigned char* lds, const Gemm g, const Sched& S, const Epi& E) {
    const int tid = threadIdx.x, wid = __builtin_amdgcn_readfirstlane(tid >> 6), lane = tid & 63, wr = wid >> 2, wc = wid & 3, fr = lane & 15, fq = lane >> 4;
    const int K = g.K, nt = K / BK;
    unsigned voffA[2], voffB[2];
#pragma unroll
    for (int i = 0; i < 2; ++i) { int R, C; stage_rc(tid * 16 + i * 8192, R, C); const int Rb = Epi::PERM ? ((R & ~31) + perm32(R & 31)) : R;
        voffA[i] = (unsigned)(R * K + C) * 2u; voffB[i] = (unsigned)(Rb * K + C) * 2u; }
    const size_t kstep = (size_t)(BK * 2);
    const size_t hstep = (size_t)HALF * K * 2;
    const size_t tstep = 2 * hstep;
    const unsigned ldsw = (unsigned)wid * 1024u;
    const int aoff = lds_byte(wr * 64 + fr, fq * 8), boff = lds_byte(wc * 32 + fr, fq * 8);
#define PG8_SA(b, h) (((b) * 2 + (h)) * HTB)
#define PG8_SB(b, h) ((4 + (b) * 2 + (h)) * HTB)
#define PG8_STAGE(bufoff, gbase, voff) do { _Pragma("unroll") for (int _i = 0; _i < 2; ++_i) \
        __builtin_amdgcn_global_load_lds((const unsigned*)((const char*)(gbase) + (voff)[_i]), (PG8_LAS unsigned*)(lds + (bufoff) + ldsw + _i * 8192), 16, 0, 0); } while (0)
#define PG8_LDA(dst, b, h) do { _Pragma("unroll") for (int m = 0; m < 4; ++m) _Pragma("unroll") for (int k = 0; k < 2; ++k) dst[m][k] = *(const PG8_LAS bf16x8*)(lds + PG8_SA(b, h) + aoff + m * 2048 + k * 1024); } while (0)
#define PG8_LDB(dst, b, h) do { _Pragma("unroll") for (int n = 0; n < 2; ++n) _Pragma("unroll") for (int k = 0; k < 2; ++k) dst[n][k] = *(const PG8_LAS bf16x8*)(lds + PG8_SB(b, h) + boff + n * 2048 + k * 1024); } while (0)
#define PG8_MMA(ai, bj, At, Bt) do { __builtin_amdgcn_s_setprio(1); _Pragma("unroll") for (int m = 0; m < 4; ++m) _Pragma("unroll") for (int n = 0; n < 2; ++n) _Pragma("unroll") for (int k = 0; k < 2; ++k) \
        acc[ai][bj][m][n] = __builtin_amdgcn_mfma_f32_16x16x32_bf16(Bt[n][k], At[m][k], acc[ai][bj][m][n], 0, 0, 0); __builtin_amdgcn_s_setprio(0); } while (0)
#define PG8_WAIT_V(n) asm volatile("s_waitcnt vmcnt(" #n ")" ::: "memory")
#define PG8_WAIT_L(n) asm volatile("s_waitcnt lgkmcnt(" #n ")" ::: "memory")
#define PG8_BAR __builtin_amdgcn_s_barrier()
#define PG8_SCHED __builtin_amdgcn_sched_barrier(0)
    Unit cur, nxt; int ui = 0;
    if (!S.next(0, cur)) return;
    f32x4 acc[2][2][4][2];
#pragma unroll
    for (int a = 0; a < 2; ++a)
#pragma unroll
        for (int b = 0; b < 2; ++b)
#pragma unroll
            for (int m = 0; m < 4; ++m)
#pragma unroll
                for (int n = 0; n < 2; ++n) acc[a][b][m][n] = (f32x4){0.f, 0.f, 0.f, 0.f};
    bf16x8 At[4][2], B0[2][2], B1[2][2];
    const char* cA = (const char*)g.A + (size_t)cur.pm * tstep; const char* cB = (const char*)g.Bt + (size_t)cur.pn * tstep;
    S.a_ready(cur);
    if constexpr (SP2) {
        PG8_STAGE(PG8_SB(0, 0), cB, voffB); PG8_STAGE(PG8_SB(0, 1), cB + hstep, voffB); PG8_STAGE(PG8_SA(0, 0), cA, voffA); PG8_STAGE(PG8_SA(0, 1), cA + hstep, voffA);
        if (wr == 1) PG8_BAR;
        PG8_WAIT_V(2); PG8_BAR;
        PG8_STAGE(PG8_SB(1, 0), cB + kstep, voffB); PG8_STAGE(PG8_SA(1, 0), cA + kstep, voffA); PG8_STAGE(PG8_SB(1, 1), cB + hstep + kstep, voffB);
        PG8_WAIT_V(6); PG8_BAR;
    } else {
        PG8_STAGE(PG8_SB(0, 0), cB, voffB); PG8_STAGE(PG8_SA(0, 0), cA, voffA); PG8_STAGE(PG8_SB(0, 1), cB + hstep, voffB); PG8_STAGE(PG8_SA(0, 1), cA + hstep, voffA);
        if (wr == 1) PG8_BAR;
        PG8_WAIT_V(4); PG8_BAR;
        PG8_STAGE(PG8_SB(1, 0), cB + kstep, voffB); PG8_STAGE(PG8_SA(1, 0), cA + kstep, voffA); PG8_STAGE(PG8_SB(1, 1), cB + hstep + kstep, voffB);
        PG8_WAIT_V(6); PG8_BAR;
    }
    for (;;) {
        const bool has_next = S.next(ui + 1, nxt);
        const char* nA = has_next ? (const char*)g.A + (size_t)nxt.pm * tstep : cA; const char* nB = has_next ? (const char*)g.Bt + (size_t)nxt.pn * tstep : cB;
        for (int t = 0; t < nt; t += 2) {
            const bool last = (t == nt - 2);
            const char* a1 = cA + (size_t)(t + 1) * kstep;
            const char* a2 = last ? nA : cA + (size_t)(t + 2) * kstep; const char* b2 = last ? nB : cB + (size_t)(t + 2) * kstep;
            const char* a3 = a2 + kstep; const char* b3 = b2 + kstep;
            if (last && has_next) S.a_ready(nxt);
            if constexpr (SP2) {
            PG8_LDB(B0, 0, 0); PG8_LDB(B1, 0, 1); PG8_SCHED; PG8_LDA(At, 0, 0); PG8_STAGE(PG8_SA(1, 1), a1 + hstep, voffA);
            PG8_WAIT_V(8); PG8_WAIT_L(0); PG8_BAR; PG8_MMA(0, 0, At, B0); PG8_MMA(0, 1, At, B1); PG8_BAR; PG8_SCHED;
            PG8_LDA(At, 0, 1); PG8_STAGE(PG8_SB(0, 0), b2, voffB); PG8_STAGE(PG8_SB(0, 1), b2 + hstep, voffB); PG8_STAGE(PG8_SA(0, 0), a2, voffA);
            PG8_WAIT_V(8); PG8_WAIT_L(0); PG8_BAR; PG8_MMA(1, 0, At, B0); PG8_MMA(1, 1, At, B1); PG8_BAR; PG8_SCHED;
            PG8_LDB(B0, 1, 0); PG8_LDB(B1, 1, 1); PG8_SCHED; PG8_LDA(At, 1, 0); PG8_STAGE(PG8_SA(0, 1), a2 + hstep, voffA);
            PG8_WAIT_V(8); PG8_WAIT_L(0); PG8_BAR; PG8_MMA(0, 0, At, B0); PG8_MMA(0, 1, At, B1); PG8_BAR; PG8_SCHED;
            PG8_LDA(At, 1, 1); PG8_STAGE(PG8_SB(1, 0), b3, voffB); PG8_STAGE(PG8_SB(1, 1), b3 + hstep, voffB); PG8_STAGE(PG8_SA(1, 0), a3, voffA);
            PG8_WAIT_V(8); PG8_WAIT_L(0); PG8_BAR; PG8_MMA(1, 0, At, B0); PG8_MMA(1, 1, At, B1); PG8_BAR; PG8_SCHED;
            } else {
            PG8_LDB(B0, 0, 0); PG8_SCHED; PG8_LDA(At, 0, 0); PG8_STAGE(PG8_SA(1, 1), a1 + hstep, voffA);
            PG8_WAIT_L(8); PG8_BAR; PG8_WAIT_L(0); PG8_MMA(0, 0, At, B0); PG8_BAR; PG8_SCHED;
            PG8_LDB(B1, 0, 1); PG8_STAGE(PG8_SB(0, 0), b2, voffB);
            PG8_BAR; PG8_WAIT_L(0); PG8_MMA(0, 1, At, B1); PG8_BAR;
            PG8_LDA(At, 0, 1); PG8_STAGE(PG8_SA(0, 0), a2, voffA);
            PG8_BAR; PG8_WAIT_L(0); PG8_MMA(1, 0, At, B0); PG8_BAR; PG8_SCHED;
            PG8_STAGE(PG8_SB(0, 1), b2 + hstep, voffB);
            PG8_WAIT_V(6); PG8_BAR; PG8_MMA(1, 1, At, B1); PG8_BAR;
            PG8_LDB(B0, 1, 0); PG8_SCHED; PG8_LDA(At, 1, 0); PG8_STAGE(PG8_SA(0, 1), a2 + hstep, voffA);
            PG8_WAIT_L(8); PG8_BAR; PG8_WAIT_L(0); PG8_MMA(0, 0, At, B0); PG8_BAR; PG8_SCHED;
            PG8_LDB(B1, 1, 1); PG8_STAGE(PG8_SB(1, 0), b3, voffB);
            PG8_BAR; PG8_WAIT_L(0); PG8_MMA(0, 1, At, B1); PG8_BAR;
            PG8_LDA(At, 1, 1); PG8_STAGE(PG8_SA(1, 0), a3, voffA);
            PG8_BAR; PG8_WAIT_L(0); PG8_MMA(1, 0, At, B0); PG8_BAR; PG8_SCHED;
            PG8_STAGE(PG8_SB(1, 1), b3 + hstep, voffB);
            PG8_WAIT_V(6); PG8_BAR; PG8_MMA(1, 1, At, B1); PG8_BAR;
            }
        }
        if constexpr (ALIGN_EPI) { if (wr == 0) PG8_BAR; }
        if constexpr (!Epi::AFTER_DRAIN) { E(acc, cur, wr, wc, fr, fq); S.done(cur); }
        if (!has_next) break;
#pragma unroll
        for (int a = 0; a < 2; ++a)
#pragma unroll
            for (int b = 0; b < 2; ++b)
#pragma unroll
                for (int m = 0; m < 4; ++m)
#pragma unroll
                    for (int n = 0; n < 2; ++n) acc[a][b][m][n] = (f32x4){0.f, 0.f, 0.f, 0.f};
        cur = nxt; cA = nA; cB = nB; ++ui;
        if constexpr (ALIGN_EPI) { if (wr == 1) PG8_BAR; }
    }
    PG8_WAIT_V(0);
    if constexpr (!ALIGN_EPI) { if (wr == 0) PG8_BAR; }
    PG8_BAR;
    if constexpr (Epi::AFTER_DRAIN) { E.fused(acc, cur, wr, wc, fr, fq, lds, wid, lane); S.done(cur); }
#undef PG8_SA
#undef PG8_SB
#undef PG8_STAGE
#undef PG8_LDA
#undef PG8_LDB
#undef PG8_MMA
#undef PG8_WAIT_V
#undef PG8_WAIT_L
#undef PG8_BAR
#undef PG8_SCHED
}
}
#define GAS __attribute__((address_space(1)))
#define LAS __attribute__((address_space(3)))
typedef unsigned short bf16;
typedef unsigned v4u __attribute__((ext_vector_type(4)));
typedef float f32x4 __attribute__((ext_vector_type(4)));
typedef short bf16x8 __attribute__((ext_vector_type(8)));
typedef GAS unsigned gu32;
typedef GAS unsigned long long gu64;
#define RLX_AGENT __ATOMIC_RELAXED, __HIP_MEMORY_SCOPE_AGENT
#define LDS_WAIT() asm volatile("s_waitcnt lgkmcnt(0)" ::: "memory")
#define VM_WAIT() asm volatile("s_waitcnt vmcnt(0)" ::: "memory")
__device__ __forceinline__ unsigned long long rt() { return __builtin_amdgcn_s_memrealtime(); }
__device__ __forceinline__ unsigned f2bf(float f) { unsigned u = __builtin_bit_cast(unsigned, f); return (u + 0x7fffu + ((u >> 16) & 1u)) >> 16; }
__device__ __forceinline__ unsigned pk2(float lo, float hi) { return f2bf(lo) | (f2bf(hi) << 16); }

#define XB_TMO      128
#define XB_XCNT(j)  (256  + 64 * (j))
#define XB_XSUB(j)  (1280 + 64 * (j))
#define XB_XGEN(j)  (2304 + 64 * (j))
#define XB_TOP      3328
#define XB_TOPGEN   3392
#define XCD_BAR_WORDS 3456
#define XB_SPIN_CAP (1u << 18)

__device__ __forceinline__ unsigned xb_ld(unsigned* p)              { return __hip_atomic_load(p, __ATOMIC_RELAXED, __HIP_MEMORY_SCOPE_AGENT); }
__device__ __forceinline__ unsigned xb_add(unsigned* p, unsigned v) { return __hip_atomic_fetch_add(p, v, __ATOMIC_RELAXED, __HIP_MEMORY_SCOPE_AGENT); }
__device__ __forceinline__ unsigned xb_xcc_id() { return (unsigned)__builtin_amdgcn_s_getreg((3 << 11) | 20) & 0xFu; }
#define XB_SPIN(cond, bar) do { unsigned _sp = 0; while (cond) { __builtin_amdgcn_s_sleep(1); \
    if ((++_sp & 255u) == 0u) { if (xb_ld(&(bar)[XB_TMO])) break; if (_sp > XB_SPIN_CAP) { atomicAdd(&(bar)[XB_TMO], 1u); break; } } } } while (0)

struct XcdBarrier {
    unsigned* bar; unsigned x;
    volatile LAS unsigned* st;
};

__device__ __forceinline__ XcdBarrier xcd_barrier_post(unsigned* bar, volatile LAS unsigned* st) {
    XcdBarrier b; b.bar = bar; b.x = xb_xcc_id(); b.st = st;
    if (threadIdx.x == 0) (void)xb_add(&bar[XB_XCNT(b.x)], 1u);
    return b;
}
__device__ __forceinline__ void xcd_barrier_complete(unsigned* bar, unsigned x, unsigned& nloc, unsigned& nx) {
    const unsigned G = gridDim.x * gridDim.y * gridDim.z;
    unsigned sum, cnt, mine, sp = 0u;
    for (;;) {
        sum = 0u; cnt = 0u; mine = 0u;
#pragma unroll
        for (unsigned j = 0; j < 16; ++j) { const unsigned c = xb_ld(&bar[XB_XCNT(j)]); sum += c; cnt += (c > 0u) ? 1u : 0u; mine = (j == x) ? c : mine; }
        if (sum == G) break;
        __builtin_amdgcn_s_sleep(1);
        if ((++sp & 255u) == 0u) { if (xb_ld(&bar[XB_TMO])) break; if (sp > XB_SPIN_CAP) { atomicAdd(&bar[XB_TMO], 1u); break; } }
    }
    nloc = mine > 0u ? mine : 1u; nx = cnt > 0u ? cnt : 1u;
}

__device__ __forceinline__ void xcd_barrier(const XcdBarrier& b) {
    asm volatile("s_waitcnt vmcnt(0)" ::: "memory");
    __syncthreads();
    if (threadIdx.x == 0) {
        unsigned* bar = b.bar;
        __builtin_amdgcn_s_waitcnt(0);
        unsigned nloc = b.st[0], nx = b.st[1];
        if (nloc == 0u) { xcd_barrier_complete(bar, b.x, nloc, nx); b.st[0] = nloc; b.st[1] = nx; }
        const unsigned old = xb_add(&bar[XB_XSUB(b.x)], 1u);
        const unsigned gen = old / nloc;
        if (old + 1u == (gen + 1u) * nloc) {
            __builtin_amdgcn_fence(__ATOMIC_RELEASE, "agent");
            asm volatile("s_waitcnt vmcnt(0)" ::: "memory");
            const unsigned og = xb_add(&bar[XB_TOP], 1u);
            const unsigned tg = og / nx;
            if (og + 1u == (tg + 1u) * nx) xb_add(&bar[XB_TOPGEN], 1u);
            else XB_SPIN(xb_ld(&bar[XB_TOPGEN]) == tg, bar);
            __builtin_amdgcn_fence(__ATOMIC_ACQUIRE, "agent");
            xb_add(&bar[XB_XGEN(b.x)], 1u);
            asm volatile("s_waitcnt vmcnt(0)" ::: "memory");
        } else {
            XB_SPIN(xb_ld(&bar[XB_XGEN(b.x)]) == gen, bar);
            __builtin_amdgcn_fence(__ATOMIC_ACQUIRE, "agent");
            asm volatile("s_waitcnt vmcnt(0)" ::: "memory");
        }
    }
    __syncthreads();
}
constexpr int NWAVES = 8;
constexpr int D = 2048, NB = 2, SEQ = 4096, T = NB * SEQ;
constexpr int SG = 128, SP = 64, SC = 16;
constexpr int NH = 16, HD = 128, NKV = 4, NGRP = 3;
constexpr int FF = 5632;
constexpr int NQ = NGRP * NH * HD, NKVC = NKV * HD;
constexpr int NQKV = NQ + 2 * NKVC;
constexpr float EPS = 1e-6f;
constexpr float QSCALE = 0.08838834764831845f * 1.4426950408889634f;

constexpr size_t MiB = 1u << 20;
constexpr size_t WS_CTL = 0, CTL_ZERO_BYTES = 1 * MiB;
constexpr size_t WS_RSTD0 = 1 * MiB;
constexpr size_t WS_WGLU = 2 * MiB, WS_WIN0 = 18 * MiB, WS_WOUT0 = 62 * MiB, WS_WQKV = 84 * MiB, WS_WO = 112 * MiB, WS_WIN1 = 120 * MiB, WS_WOUT1 = 164 * MiB;
constexpr size_t WS_XA = 186 * MiB;
constexpr size_t WS_XB = 250 * MiB;
constexpr size_t WS_ZO = 282 * MiB;
constexpr size_t WS_HQ = 314 * MiB;
constexpr size_t WS_K = 410 * MiB, WS_V = 418 * MiB;
constexpr size_t WS_OG = 426 * MiB;
constexpr size_t WS_LSE = 522 * MiB;
constexpr size_t WS_END = 524 * MiB;
constexpr int CW_TMO = 0, CW_CODE = 1, CW_BAR = 4096;
constexpr int CW_ROWSQ = 16384;
static_assert((CW_ROWSQ + 4 * T) * 4 <= (int)CTL_ZERO_BYTES, "ctl");

constexpr int RING_OFF = 0, RING_BYTES = 131072;
constexpr int LDSCTL_OFF = RING_BYTES, MISC_OFF = LDSCTL_OFF + 320;
constexpr int LDS_BYTES = 147456;

struct Frame {
    LAS unsigned char* lds;
    volatile LAS unsigned* MISC;
    gu32* ctl;
    int tid, lane, wave;
    int vcu, G;
};

__device__ __forceinline__ float wave_sum(float v) {
#pragma unroll
    for (int o = 1; o < 64; o <<= 1) v += __shfl_xor(v, o);
    return v;
}
__device__ __forceinline__ float wave_max(float v) {
#pragma unroll
    for (int o = 1; o < 64; o <<= 1) v = fmaxf(v, __shfl_xor(v, o));
    return v;
}
__device__ __forceinline__ void p0_transpose_item(const float* W, int K, int N, const float* gain, bf16* WT, int Nh, int row_off, LAS float* scr, int item, int lane) {
    const int nblk = N / 32, kb = item / nblk, nb = item % nblk, k0 = 64 * kb, n0 = 32 * nb;
#pragma unroll 8
    for (int i = 0; i < 32; ++i) { const int kk = 2 * i + (lane >> 5); float v = W[(size_t)(k0 + kk) * N + n0 + (lane & 31)]; if (gain) v *= gain[k0 + kk]; scr[kk * 33 + (lane & 31)] = v; }
    LDS_WAIT(); asm volatile("" ::: "memory");
    const int c = lane & 7;
    int drow0 = row_off + n0;
    if (Nh) { const int nn = n0 % Nh; drow0 = 256 * (nn / 128) + 128 * (n0 / Nh) + (nn % 128); }
#pragma unroll
    for (int j = 0; j < 4; ++j) { const int n = (lane >> 3) + 8 * j; const LAS float* s = scr + (8 * c) * 33 + n;
        v4u o; o.x = pk2(s[0 * 33], s[1 * 33]); o.y = pk2(s[2 * 33], s[3 * 33]); o.z = pk2(s[4 * 33], s[5 * 33]); o.w = pk2(s[6 * 33], s[7 * 33]);
        *(GAS v4u*)(WT + (size_t)(drow0 + n) * K + k0 + 8 * c) = o; }
    LDS_WAIT(); asm volatile("" ::: "memory");
}

struct Args { const float* in[20]; float* out; unsigned char* ws; int ph_lo, ph_hi; };

__global__ void __launch_bounds__(NWAVES * 64, 2) mk_fwd(Args args) {
    extern __shared__ __attribute__((aligned(16))) unsigned char lds[];
    Frame F;
    F.lds = (LAS unsigned char*)lds;
    F.MISC = (volatile LAS unsigned*)(F.lds + MISC_OFF);
    F.tid = threadIdx.x; F.lane = F.tid & 63; F.wave = __builtin_amdgcn_readfirstlane(F.tid >> 6);
    F.G = gridDim.x; { const int bx = blockIdx.x; F.vcu = (F.G % 8 == 0) ? (bx % 8) * (F.G / 8) + bx / 8 : bx; }
    unsigned char* ws = args.ws;
    F.ctl = (gu32*)(ws + WS_CTL);
    const float* x = args.in[0];
    bf16* WgluT = (bf16*)(ws + WS_WGLU); bf16* Win0T = (bf16*)(ws + WS_WIN0); bf16* Wout0T = (bf16*)(ws + WS_WOUT0); bf16* WqkvT = (bf16*)(ws + WS_WQKV);
    bf16* WoT = (bf16*)(ws + WS_WO); bf16* Win1T = (bf16*)(ws + WS_WIN1); bf16* Wout1T = (bf16*)(ws + WS_WOUT1);
    float* XA = (float*)(ws + WS_XA); bf16* XB = (bf16*)(ws + WS_XB); bf16* ZO = (bf16*)(ws + WS_ZO); bf16* HQ = (bf16*)(ws + WS_HQ);
    bf16* KB = (bf16*)(ws + WS_K); bf16* VB = (bf16*)(ws + WS_V);
    float* rstd0 = (float*)(ws + WS_RSTD0);
    float* rowsq = (float*)(ws + WS_CTL) + CW_ROWSQ;
    for (int u = F.tid; u < (LDS_BYTES - LDSCTL_OFF) / 4; u += NWAVES * 64) ((LAS unsigned*)(F.lds + LDSCTL_OFF))[u] = 0u;
    __syncthreads();
    XcdBarrier bar = xcd_barrier_post((unsigned*)(F.ctl + CW_BAR), F.MISC + 8);
    const int lo = args.ph_lo, hi = args.ph_hi;
#define IN(k) (lo <= (k) && (k) < hi)
#define BOTH(k) (IN(k) && IN((k) + 1))
#define GRID_BAR() xcd_barrier(bar)

    if (IN(0)) {
        LAS float* scr = (LAS float*)(F.lds + RING_OFF + F.wave * 16384);
        const int gw = F.vcu * NWAVES + F.wave, NGW = F.G * NWAVES;
        constexpr int I0 = (D / 64) * (2 * D / 32), I1 = (D / 64) * (2 * FF / 32), I2 = (FF / 64) * (D / 32), I3 = (D / 64) * (NQ / 32), I4 = (D / 64) * (2 * NKVC / 32), I5 = (D / 64) * (D / 32);
        constexpr int NITEMS = I0 + 2 * I1 + 2 * I2 + I3 + I4 + I5;
        for (int it = gw; it < NITEMS; it += NGW) {
            int r = it;
            if (r < I0) { p0_transpose_item(args.in[9], D, 2 * D, nullptr, WgluT, D, 0, scr, r, F.lane); continue; } r -= I0;
            if (r < I1) { p0_transpose_item(args.in[12], D, 2 * FF, args.in[11], Win0T, FF, 0, scr, r, F.lane); continue; } r -= I1;
            if (r < I2) { p0_transpose_item(args.in[13], FF, D, nullptr, Wout0T, 0, 0, scr, r, F.lane); continue; } r -= I2;
            if (r < I3) { p0_transpose_item(args.in[15], D, NQ, args.in[14], WqkvT, 0, 0, scr, r, F.lane); continue; } r -= I3;
            if (r < I4) { p0_transpose_item(args.in[18], D, 2 * NKVC, args.in[17], WqkvT, 0, NQ, scr, r, F.lane); continue; } r -= I4;
            if (r < I5) { p0_transpose_item(args.in[16], D, D, nullptr, WoT, 0, 0, scr, r, F.lane); continue; } r -= I5;
            if (r < I1) { p0_transpose_item(args.in[12] + (size_t)D * 2 * FF, D, 2 * FF, args.in[11] + D, Win1T, FF, 0, scr, r, F.lane); continue; } r -= I1;
            p0_transpose_item(args.in[13] + (size_t)FF * D, FF, D, nullptr, Wout1T, 0, 0, scr, r, F.lane);
        }
        for (int m = gw; m < T; m += NGW) {
            const GAS f32x4* xr = (const GAS f32x4*)(x + (size_t)m * D) + F.lane; float s = 0.f;
#pragma unroll
            for (int j = 0; j < D / 256; ++j) { const f32x4 v = xr[64 * j]; s += (v.x * v.x + v.y * v.y) + (v.z * v.z + v.w * v.w); }
            s = wave_sum(s);
            if (F.lane == 0) rstd0[m] = 1.0f / sqrtf(s * (1.0f / D) + EPS);
        }
        if (BOTH(0)) GRID_BAR();
    }
    if (IN(2)) {
        pg8::Gemm g{ZO, WgluT, T, 2 * D, D}; pg8::StaticOrder S; S.init(T, 2 * D, F.G, (int)blockIdx.x);
        pg8::EpiGluRes E{x, XA, XB, rowsq};
        pg8::gemm_phase<pg8::EpiGluRes, pg8::StaticOrder, true, true>(F.lds + RING_OFF, g, S, E);
        if (BOTH(2)) GRID_BAR();
    }
    if (IN(3)) {
        pg8::Gemm g{XB, Win0T, T, 2 * FF, D}; pg8::StaticOrder S; S.init(T, 2 * FF, F.G, (int)blockIdx.x);
        pg8::EpiSwiGlu E{rowsq, HQ, FF};
        pg8::gemm_phase<pg8::EpiSwiGlu, pg8::StaticOrder, true, true>(F.lds + RING_OFF, g, S, E);
        if (BOTH(3)) GRID_BAR();
    }
    if (IN(4)) {
        pg8::Gemm g{HQ, Wout0T, T, D, FF}; pg8::StaticOrder S; S.init(T, D, F.G, (int)blockIdx.x);
        pg8::EpiRes<true> E{XA, XB, rowsq + T};
        pg8::gemm_phase<pg8::EpiRes<true>, pg8::StaticOrder, true, true>(F.lds + RING_OFF, g, S, E);
        if (BOTH(4)) GRID_BAR();
    }
    if (IN(5)) {
        pg8::Gemm g{XB, WqkvT, T, NQKV, D}; pg8::StaticOrder S; S.init(T, NQKV, F.G, (int)blockIdx.x);
        pg8::EpiQKV E{rowsq + T, HQ, KB, VB, QSCALE};
        pg8::gemm_phase<pg8::EpiQKV, pg8::StaticOrder, true, true>(F.lds + RING_OFF, g, S, E);
        if (BOTH(5)) GRID_BAR();
    }
    if (IN(8)) {
        pg8::Gemm g{ZO, WoT, T, D, D}; pg8::StaticOrder S; S.init(T, D, F.G, (int)blockIdx.x);
        pg8::EpiRes<true> E{XA, XB, rowsq + 2 * T};
        pg8::gemm_phase<pg8::EpiRes<true>, pg8::StaticOrder, true, true>(F.lds + RING_OFF, g, S, E);
        if (BOTH(8)) GRID_BAR();
    }
    if (IN(9)) {
        pg8::Gemm g{XB, Win1T, T, 2 * FF, D}; pg8::StaticOrder S; S.init(T, 2 * FF, F.G, (int)blockIdx.x);
        pg8::EpiSwiGlu E{rowsq + 2 * T, HQ, FF};
        pg8::gemm_phase<pg8::EpiSwiGlu, pg8::StaticOrder, true, true>(F.lds + RING_OFF, g, S, E);
        if (BOTH(9)) GRID_BAR();
    }
    if (IN(10)) {
        pg8::Gemm g{HQ, Wout1T, T, D, FF}; pg8::StaticOrder S; S.init(T, D, F.G, (int)blockIdx.x);
        pg8::EpiRes<true> E{XA, XB, rowsq + 3 * T};
        pg8::gemm_phase<pg8::EpiRes<true>, pg8::StaticOrder, true, true>(F.lds + RING_OFF, g, S, E);
        if (BOTH(10)) GRID_BAR();
    }
    if (IN(11)) {
        const int gw = F.vcu * NWAVES + F.wave, NGW = F.G * NWAVES;
        const GAS f32x4* gr = (const GAS f32x4*)args.in[19] + F.lane;
        for (int m = gw; m < T; m += NGW) {
            const GAS f32x4* xr = (const GAS f32x4*)(XA + (size_t)m * D) + F.lane; GAS f32x4* orow = (GAS f32x4*)(args.out + (size_t)m * D) + F.lane;
            f32x4 v[D / 256]; float s = 0.f;
#pragma unroll
            for (int j = 0; j < D / 256; ++j) { v[j] = xr[64 * j]; s += (v[j].x * v[j].x + v[j].y * v[j].y) + (v[j].z * v[j].z + v[j].w * v[j].w); }
            s = wave_sum(s);
            const float r = 1.0f / sqrtf(s * (1.0f / D) + EPS);
#pragma unroll
            for (int j = 0; j < D / 256; ++j) orow[64 * j] = v[j] * r * gr[64 * j];
        }
    }
#undef IN
#undef BOTH
#undef GRID_BAR
}

__device__ __forceinline__ float bf2f(bf16 v) { return __builtin_bit_cast(float, (unsigned)v << 16); }
__device__ __forceinline__ float gelu_tanh(float y) {
    const float k0 = 0.7978845608028654f, k1 = 0.044715f;
    return 0.5f * y * (1.f + tanhf(k0 * (y + k1 * y * y * y)));
}
__global__ __launch_bounds__(64) void s5_simple_kernel(const float* __restrict__ x, const float* __restrict__ rstd, const float* __restrict__ gn,
        const float* __restrict__ lam_re, const float* __restrict__ lam_im, const float* __restrict__ log_dt,
        const float* __restrict__ b_re, const float* __restrict__ b_im, const float* __restrict__ c_re, const float* __restrict__ c_im,
        const float* __restrict__ d_skip, bf16* __restrict__ z) {
    constexpr int G = SG, P = SP, C = SC, S = SEQ;
    const int bg = blockIdx.x, b = bg / G, g = bg % G, p = threadIdx.x;
    const float lr = lam_re[g * P + p], li = lam_im[g * P + p];
    const float dt = expf(log_dt[g]);
    const float mag = expf(lr * dt), ang = li * dt;
    const float lbr = mag * cosf(ang), lbi = mag * sinf(ang);
    const float nr = lbr - 1.f, den = lr * lr + li * li;
    const float fr = (nr * lr + lbi * li) / den, fi = (lbi * lr - nr * li) / den;
    float bbr[C], bbi[C], cr[C], ci[C];
#pragma unroll
    for (int c = 0; c < C; ++c) {
        const float br = b_re[(g * P + p) * C + c], bi = b_im[(g * P + p) * C + c];
        bbr[c] = fr * br - fi * bi; bbi[c] = fr * bi + fi * br;
        cr[c] = c_re[(g * C + c) * P + p]; ci[c] = c_im[(g * C + c) * P + p];
    }
    const int pc = p & 15;
    const float gnp = gn[g * C + pc], dp = d_skip[g * C + pc];
    float gnc[C];
#pragma unroll
    for (int c = 0; c < C; ++c) gnc[c] = gn[g * C + c];
    float xr = 0.f, xi = 0.f;
    for (int t = 0; t < S; ++t) {
        const size_t row = (size_t)b * S + t;
        const float* xp = x + row * D + g * C;
        const float r = rstd[row];
        float bur = 0.f, bui = 0.f;
#pragma unroll
        for (int c = 0; c < C; ++c) { const float u = xp[c] * r * gnc[c]; bur += bbr[c] * u; bui += bbi[c] * u; }
        const float nxr = lbr * xr - lbi * xi + bur, nxi = lbr * xi + lbi * xr + bui;
        xr = nxr; xi = nxi;
        float myy = 0.f;
#pragma unroll
        for (int c = 0; c < C; ++c) { float v = cr[c] * xr - ci[c] * xi; v = wave_sum(v); if (p == c) myy = v; }
        if (p < C) { const float up = xp[pc] * r * gnp; z[row * D + g * C + p] = (bf16)f2bf(gelu_tanh(myy + dp * up)); }
    }
}
__global__ __launch_bounds__(256) void attn_simple_kernel(const bf16* __restrict__ q, const bf16* __restrict__ kk, const bf16* __restrict__ vv, bf16* __restrict__ o) {
    __shared__ float qs[4][HD];
    const int wave = threadIdx.x >> 6, lane = threadIdx.x & 63;
    const int idx = blockIdx.x * 4 + wave;
    const int row = idx / NH, h = idx % NH, b = row / SEQ, t = row % SEQ, kvh = h / (NH / NKV);
    float og[NGRP][2], lse[NGRP];
#pragma unroll
    for (int g = 0; g < NGRP; ++g) {
        const int dil = (g == 0) ? 1 : (g == 1 ? 4 : 16);
        const bf16* qp = q + (size_t)row * NQ + g * (NH * HD) + h * HD;
        __syncthreads();
        qs[wave][lane] = bf2f(qp[lane]); qs[wave][lane + 64] = bf2f(qp[lane + 64]);
        __syncthreads();
        float sc[3];
#pragma unroll
        for (int pass = 0; pass < 3; ++pass) {
            const int j = pass * 64 + lane;
            const int tk = t - j * dil;
            float s = -1e30f;
            if (j <= 128 && tk >= 0) {
                const bf16* kp = kk + (size_t)(b * SEQ + tk) * NKVC + kvh * HD;
                float a = 0.f;
#pragma unroll 8
                for (int e = 0; e < HD; ++e) a += qs[wave][e] * bf2f(kp[e]);
                s = a;
            }
            sc[pass] = s;
        }
        const float m = wave_max(fmaxf(fmaxf(sc[0], sc[1]), sc[2]));
        float pr[3]; float l = 0.f;
#pragma unroll
        for (int pass = 0; pass < 3; ++pass) { pr[pass] = (sc[pass] > -1e29f) ? exp2f(sc[pass] - m) : 0.f; l += pr[pass]; }
        l = wave_sum(l);
        lse[g] = m + log2f(l);
        float a0 = 0.f, a1 = 0.f;
#pragma unroll
        for (int pass = 0; pass < 3; ++pass) {
            const int jn = (pass < 2) ? 64 : 1;
            for (int jj = 0; jj < jn; ++jj) {
                const float pj = __shfl(pr[pass], jj);
                const int j = pass * 64 + jj; const int tk = t - j * dil;
                if (tk >= 0) {
                    const bf16* vp = vv + (size_t)(b * SEQ + tk) * NKVC + kvh * HD;
                    a0 += pj * bf2f(vp[lane]); a1 += pj * bf2f(vp[lane + 64]);
                }
            }
        }
        og[g][0] = a0 / l; og[g][1] = a1 / l;
    }
    const float mx = fmaxf(fmaxf(lse[0], lse[1]), lse[2]);
    const float w0 = exp2f(lse[0] - mx), w1 = exp2f(lse[1] - mx), w2 = exp2f(lse[2] - mx), wsum = w0 + w1 + w2;
    bf16* op = o + (size_t)row * D + h * HD;
    op[lane] = (bf16)f2bf((w0 * og[0][0] + w1 * og[1][0] + w2 * og[2][0]) / wsum);
    op[lane + 64] = (bf16)f2bf((w0 * og[0][1] + w1 * og[1][1] + w2 * og[2][1]) / wsum);
}

extern "C" void kernel_launch(void* const* d_in, const int* in_sizes, int n_in, void* d_out, int out_size, void* d_ws, size_t ws_size, hipStream_t stream) {
    static int grid = 0;
    if (grid == 0) {
        if (n_in != 20 || out_size != T * D || ws_size < WS_END) { fprintf(stderr, "kernel_launch: unexpected shapes/ws (n_in %d out %d ws %zu)\n", n_in, out_size, ws_size); grid = -1; return; }
        int dev = 0, cus = 0;
        if (hipGetDevice(&dev) != hipSuccess || hipDeviceGetAttribute(&cus, hipDeviceAttributeMultiprocessorCount, dev) != hipSuccess) { grid = -1; return; }
        if (hipFuncSetAttribute((const void*)mk_fwd, hipFuncAttributeMaxDynamicSharedMemorySize, LDS_BYTES) != hipSuccess) { fprintf(stderr, "kernel_launch: hipFuncSetAttribute failed\n"); grid = -1; return; }
        (void)hipGetLastError();
        grid = cus;
    }
    if (grid < 0) return;
    (void)hipMemsetAsync((char*)d_ws + WS_CTL, 0, CTL_ZERO_BYTES, stream);
    Args a{};
    for (int i = 0; i < 20; ++i) a.in[i] = (const float*)d_in[i];
    a.out = (float*)d_out; a.ws = (unsigned char*)d_ws;
    unsigned char* ws = (unsigned char*)d_ws;
#define LAUNCH(lo_, hi_) do { a.ph_lo = (lo_); a.ph_hi = (hi_); hipLaunchKernelGGL(mk_fwd, dim3(grid), dim3(NWAVES * 64), LDS_BYTES, stream, a); } while (0)
    LAUNCH(0, 1);
    s5_simple_kernel<<<NB * SG, 64, 0, stream>>>(a.in[0], (const float*)(ws + WS_RSTD0), a.in[10], a.in[1], a.in[2], a.in[3], a.in[4], a.in[5], a.in[6], a.in[7], a.in[8], (bf16*)(ws + WS_ZO));
    LAUNCH(2, 3); LAUNCH(3, 4); LAUNCH(4, 5); LAUNCH(5, 6);
    attn_simple_kernel<<<T * NH / 4, 256, 0, stream>>>((const bf16*)(ws + WS_HQ), (const bf16*)(ws + WS_K), (const bf16*)(ws + WS_V), (bf16*)(ws + WS_ZO));
    LAUNCH(8, 9); LAUNCH(9, 10); LAUNCH(10, 11); LAUNCH(11, 12);
#undef LAUNCH
}
```

```cpp
#include <hip/hip_runtime.h>
#include <cstdint>
#include <cstdio>
namespace pg8 {
#define PG8_LAS __attribute__((address_space(3)))
typedef unsigned short bf16_t;
typedef short bf16x8 __attribute__((ext_vector_type(8)));
typedef float f32x4 __attribute__((ext_vector_type(4)));
typedef unsigned u32x4 __attribute__((ext_vector_type(4)));
constexpr int BM = 256, BK = 64, HALF = 128, HTB = HALF * BK * 2  , STAGE_BYTES = 8 * HTB, NXCD = 8, WGM = 8;

__host__ __device__ __forceinline__ int lds_byte(int r, int c) { const int st = (r >> 4) * 2 + (c >> 5), rr = r & 15, cc = c & 31, ob = rr * 64 + cc * 2; return st * 1024 + (ob ^ (((ob >> 9) & 1) << 5)); }
__host__ __device__ __forceinline__ void stage_rc(int b, int& R, int& C) { const int st = b / 1024, sb = b % 1024, swz = sb ^ (((sb >> 9) & 1) << 5); R = (st >> 1) * 16 + swz / 64; C = (st & 1) * 32 + (swz % 64) / 2; }
__host__ __device__ __forceinline__ int perm32(int rho) { const int n = rho >> 4, i = rho & 15; return 8 * (i >> 2) + 4 * n + (i & 3); }

struct Unit { int pm, pn; };
struct Gemm { const bf16_t* A; const bf16_t* Bt; int M, N, K; };

struct StaticOrder {
    int nM, nN, nwg, G, c;
    __host__ __device__ void init(int M, int N, int G_, int c_) { nM = M / BM; nN = N / BM; nwg = nM * nN; G = G_; c = c_; }
    __host__ __device__ bool next(int i, Unit& u) const {
        const long L = (long)i * G + c; if (L >= nwg) return false;
        int wgid = (int)L; { const int q = nwg / NXCD, r = nwg % NXCD, xcd = wgid % NXCD, off = wgid / NXCD; wgid = (xcd < r ? xcd * (q + 1) : r * (q + 1) + (xcd - r) * q) + off; }
        const int nig = WGM * nN, gid = wgid / nig, fm = gid * WGM, gsz = (nM - fm) < WGM ? (nM - fm) : WGM;
        u.pm = fm + ((wgid % nig) % gsz); u.pn = (wgid % nig) / gsz; return true;
    }
    __device__ __forceinline__ void a_ready(const Unit&) const {}
    __device__ __forceinline__ void done(const Unit&) const {}
};

__device__ __forceinline__ unsigned cvt_pk_bf16(float lo, float hi) { unsigned r; asm volatile("v_cvt_pk_bf16_f32 %0, %1, %2" : "=v"(r) : "v"(lo), "v"(hi)); return r; }
__device__ __forceinline__ float sigm(float v) { return __builtin_amdgcn_rcpf(1.0f + __builtin_amdgcn_exp2f(v * -1.4426950408889634f)); }
__device__ __forceinline__ u32x4 pack8(const f32x4& a, const f32x4& b) { u32x4 w; w.x = cvt_pk_bf16(a[0], a[1]); w.y = cvt_pk_bf16(a[2], a[3]); w.z = cvt_pk_bf16(b[0], b[1]); w.w = cvt_pk_bf16(b[2], b[3]); return w; }
constexpr int DM = 2048;
constexpr float NORM_EPS = 1e-6f;

struct EpiGluRes {
    static constexpr bool PERM = true, AFTER_DRAIN = false;
    const float* res; float* XA; bf16_t* XB; float* rowsq;
    __device__ __forceinline__ void operator()(const f32x4 (&acc)[2][2][4][2], const Unit& u, int wr, int wc, int fr, int fq) const {
        const int row0 = u.pm * BM + wr * 64 + fr, col0 = u.pn * HALF + wc * 32 + 8 * fq;
#pragma unroll
        for (int ai = 0; ai < 2; ++ai)
#pragma unroll
            for (int m = 0; m < 4; ++m) {
                const int row = row0 + ai * HALF + m * 16; const size_t off = (size_t)row * DM + col0;
                const f32x4 r0 = *(const f32x4*)(res + off), r1 = *(const f32x4*)(res + off + 4);
                f32x4 v0, v1;
#pragma unroll
                for (int j = 0; j < 4; ++j) { v0[j] = r0[j] + acc[ai][0][m][0][j] * sigm(acc[ai][1][m][0][j]); v1[j] = r1[j] + acc[ai][0][m][1][j] * sigm(acc[ai][1][m][1][j]); }
                *(f32x4*)(XA + off) = v0; *(f32x4*)(XA + off + 4) = v1;
                *(u32x4*)(XB + off) = pack8(v0, v1);
                float s = (v0[0] * v0[0] + v0[1] * v0[1]) + (v0[2] * v0[2] + v0[3] * v0[3]) + (v1[0] * v1[0] + v1[1] * v1[1]) + (v1[2] * v1[2] + v1[3] * v1[3]);
                s += __shfl_xor(s, 16); s += __shfl_xor(s, 32);
                if (fq == 0) atomicAdd(rowsq + row, s);
            }
    }
};
struct EpiSwiGlu {
    static constexpr bool PERM = true, AFTER_DRAIN = false;
    const float* rowsq; bf16_t* H; int ldh;
    __device__ __forceinline__ void operator()(const f32x4 (&acc)[2][2][4][2], const Unit& u, int wr, int wc, int fr, int fq) const {
        const int row0 = u.pm * BM + wr * 64 + fr, col0 = u.pn * HALF + wc * 32 + 8 * fq;
#pragma unroll
        for (int ai = 0; ai < 2; ++ai)
#pragma unroll
            for (int m = 0; m < 4; ++m) {
                const int row = row0 + ai * HALF + m * 16;
                const float rs = __builtin_amdgcn_rsqf(rowsq[row] * (1.0f / DM) + NORM_EPS);
                f32x4 v0, v1;
#pragma unroll
                for (int j = 0; j < 4; ++j) { const float g0 = acc[ai][0][m][0][j] * rs, g1 = acc[ai][0][m][1][j] * rs;
                    v0[j] = g0 * sigm(g0) * (acc[ai][1][m][0][j] * rs); v1[j] = g1 * sigm(g1) * (acc[ai][1][m][1][j] * rs); }
                *(u32x4*)(H + (size_t)row * ldh + col0) = pack8(v0, v1);
            }
    }
};
template <bool WRITE_XB> struct EpiRes {
    static constexpr bool PERM = true, AFTER_DRAIN = false;
    float* XA; bf16_t* XB; float* rowsq;
    __device__ __forceinline__ void operator()(const f32x4 (&acc)[2][2][4][2], const Unit& u, int wr, int wc, int fr, int fq) const {
        const int row0 = u.pm * BM + wr * 64 + fr, col0 = u.pn * BM + wc * 32 + 8 * fq;
#pragma unroll
        for (int ai = 0; ai < 2; ++ai)
#pragma unroll
            for (int m = 0; m < 4; ++m) {
                const int row = row0 + ai * HALF + m * 16; float s = 0.f;
#pragma unroll
                for (int bj = 0; bj < 2; ++bj) {
                    const size_t off = (size_t)row * DM + col0 + bj * HALF;
                    const f32x4 v0 = *(const f32x4*)(XA + off) + acc[ai][bj][m][0], v1 = *(const f32x4*)(XA + off + 4) + acc[ai][bj][m][1];
                    *(f32x4*)(XA + off) = v0; *(f32x4*)(XA + off + 4) = v1;
                    if (WRITE_XB) *(u32x4*)(XB + off) = pack8(v0, v1);
                    s += (v0[0] * v0[0] + v0[1] * v0[1]) + (v0[2] * v0[2] + v0[3] * v0[3]) + (v1[0] * v1[0] + v1[1] * v1[1]) + (v1[2] * v1[2] + v1[3] * v1[3]);
                }
                s += __shfl_xor(s, 16); s += __shfl_xor(s, 32);
                if (fq == 0) atomicAdd(rowsq + row, s);
            }
    }
};
struct EpiQKV {
    static constexpr bool PERM = true, AFTER_DRAIN = false;
    const float* rowsq; bf16_t* Q; bf16_t* K; bf16_t* V; float qscale;
    __device__ __forceinline__ void operator()(const f32x4 (&acc)[2][2][4][2], const Unit& u, int wr, int wc, int fr, int fq) const {
        const int row0 = u.pm * BM + wr * 64 + fr;
        bf16_t* base; int ld, colt; float sc = 1.f;
        if (u.pn < 24) { base = Q; ld = 6144; colt = u.pn * BM; sc = qscale; }
        else if (u.pn < 26) { base = K; ld = 512; colt = (u.pn - 24) * BM; }
        else { base = V; ld = 512; colt = (u.pn - 26) * BM; }
        const int col0 = colt + wc * 32 + 8 * fq;
#pragma unroll
        for (int ai = 0; ai < 2; ++ai)
#pragma unroll
            for (int m = 0; m < 4; ++m) {
                const int row = row0 + ai * HALF + m * 16;
                const float rs = __builtin_amdgcn_rsqf(rowsq[row] * (1.0f / DM) + NORM_EPS) * sc;
#pragma unroll
                for (int bj = 0; bj < 2; ++bj) *(u32x4*)(base + (size_t)row * ld + col0 + bj * HALF) = pack8(acc[ai][bj][m][0] * rs, acc[ai][bj][m][1] * rs);
            }
    }
};
template <class Epi, class Sched, bool ALIGN_EPI = false, bool SP2 = false>
__device__ __forceinline__ void gemm_phase(PG8_LAS unsigned char* lds, const Gemm g, const Sched& S, const Epi& E) {
    const int tid = threadIdx.x, wid = __builtin_amdgcn_readfirstlane(tid >> 6), lane = tid & 63, wr = wid >> 2, wc = wid & 3, fr = lane & 15, fq = lane >> 4;
    const int K = g.K, nt = K / BK;
    unsigned voffA[2], voffB[2];
#pragma unroll
    for (int i = 0; i < 2; ++i) { int R, C; stage_rc(tid * 16 + i * 8192, R, C); const int Rb = Epi::PERM ? ((R & ~31) + perm32(R & 31)) : R;
        voffA[i] = (unsigned)(R * K + C) * 2u; voffB[i] = (unsigned)(Rb * K + C) * 2u; }
    const size_t kstep = (size_t)(BK * 2);
    const size_t hstep = (size_t)HALF * K * 2;
    const size_t tstep = 2 * hstep;
    const unsigned ldsw = (unsigned)wid * 1024u;
    const int aoff = lds_byte(wr * 64 + fr, fq * 8), boff = lds_byte(wc * 32 + fr, fq * 8);
#define PG8_SA(b, h) (((b) * 2 + (h)) * HTB)
#define PG8_SB(b, h) ((4 + (b) * 2 + (h)) * HTB)
#define PG8_STAGE(bufoff, gbase, voff) do { _Pragma("unroll") for (int _i = 0; _i < 2; ++_i) \
        __builtin_amdgcn_global_load_lds((const unsigned*)((const char*)(gbase) + (voff)[_i]), (PG8_LAS unsigned*)(lds + (bufoff) + ldsw + _i * 8192), 16, 0, 0); } while (0)
#define PG8_LDA(dst, b, h) do { _Pragma("unroll") for (int m = 0; m < 4; ++m) _Pragma("unroll") for (int k = 0; k < 2; ++k) dst[m][k] = *(const PG8_LAS bf16x8*)(lds + PG8_SA(b, h) + aoff + m * 2048 + k * 1024); } while (0)
#define PG8_LDB(dst, b, h) do { _Pragma("unroll") for (int n = 0; n < 2; ++n) _Pragma("unroll") for (int k = 0; k < 2; ++k) dst[n][k] = *(const PG8_LAS bf16x8*)(lds + PG8_SB(b, h) + boff + n * 2048 + k * 1024); } while (0)
#define PG8_MMA(ai, bj, At, Bt) do { __builtin_amdgcn_s_setprio(1); _Pragma("unroll") for (int m = 0; m < 4; ++m) _Pragma("unroll") for (int n = 0; n < 2; ++n) _Pragma("unroll") for (int k = 0; k < 2; ++k) \
        acc[ai][bj][m][n] = __builtin_amdgcn_mfma_f32_16x16x32_bf16(Bt[n][k], At[m][k], acc[ai][bj][m][n], 0, 0, 0); __builtin_amdgcn_s_setprio(0); } while (0)
#define PG8_WAIT_V(n) asm volatile("s_waitcnt vmcnt(" #n ")" ::: "memory")
#define PG8_WAIT_L(n) asm volatile("s_waitcnt lgkmcnt(" #n ")" ::: "memory")
#define PG8_BAR __builtin_amdgcn_s_barrier()
#define PG8_SCHED __builtin_amdgcn_sched_barrier(0)
    Unit cur, nxt; int ui = 0;
    if (!S.next(0, cur)) return;
    f32x4 acc[2][2][4][2];
#pragma unroll
    for (int a = 0; a < 2; ++a)
#pragma unroll
        for (int b = 0; b < 2; ++b)
#pragma unroll
            for (int m = 0; m < 4; ++m)
#pragma unroll
                for (int n = 0; n < 2; ++n) acc[a][b][m][n] = (f32x4){0.f, 0.f, 0.f, 0.f};
    bf16x8 At[4][2], B0[2][2], B1[2][2];
    const char* cA = (const char*)g.A + (size_t)cur.pm * tstep; const char* cB = (const char*)g.Bt + (size_t)cur.pn * tstep;
    S.a_ready(cur);
    if constexpr (SP2) {
        PG8_STAGE(PG8_SB(0, 0), cB, voffB); PG8_STAGE(PG8_SB(0, 1), cB + hstep, voffB); PG8_STAGE(PG8_SA(0, 0), cA, voffA); PG8_STAGE(PG8_SA(0, 1), cA + hstep, voffA);
        if (wr == 1) PG8_BAR;
        PG8_WAIT_V(2); PG8_BAR;
        PG8_STAGE(PG8_SB(1, 0), cB + kstep, voffB); PG8_STAGE(PG8_SA(1, 0), cA + kstep, voffA); PG8_STAGE(PG8_SB(1, 1), cB + hstep + kstep, voffB);
        PG8_WAIT_V(6); PG8_BAR;
    } else {
        PG8_STAGE(PG8_SB(0, 0), cB, voffB); PG8_STAGE(PG8_SA(0, 0), cA, voffA); PG8_STAGE(PG8_SB(0, 1), cB + hstep, voffB); PG8_STAGE(PG8_SA(0, 1), cA + hstep, voffA);
        if (wr == 1) PG8_BAR;
        PG8_WAIT_V(4); PG8_BAR;
        PG8_STAGE(PG8_SB(1, 0), cB + kstep, voffB); PG8_STAGE(PG8_SA(1, 0), cA + kstep, voffA); PG8_STAGE(PG8_SB(1, 1), cB + hstep + kstep, voffB);
        PG8_WAIT_V(6); PG8_BAR;
    }
    for (;;) {
        const bool has_next = S.next(ui + 1, nxt);
        const char* nA = has_next ? (const char*)g.A + (size_t)nxt.pm * tstep : cA; const char* nB = has_next ? (const char*)g.Bt + (size_t)nxt.pn * tstep : cB;
        for (int t = 0; t < nt; t += 2) {
            const bool last = (t == nt - 2);
            const char* a1 = cA + (size_t)(t + 1) * kstep;
            const char* a2 = last ? nA : cA + (size_t)(t + 2) * kstep; const char* b2 = last ? nB : cB + (size_t)(t + 2) * kstep;
            const char* a3 = a2 + kstep; const char* b3 = b2 + kstep;
            if (last && has_next) S.a_ready(nxt);
            if constexpr (SP2) {
            PG8_LDB(B0, 0, 0); PG8_LDB(B1, 0, 1); PG8_SCHED; PG8_LDA(At, 0, 0); PG8_STAGE(PG8_SA(1, 1), a1 + hstep, voffA);
            PG8_WAIT_V(8); PG8_WAIT_L(0); PG8_BAR; PG8_MMA(0, 0, At, B0); PG8_MMA(0, 1, At, B1); PG8_BAR; PG8_SCHED;
            PG8_LDA(At, 0, 1); PG8_STAGE(PG8_SB(0, 0), b2, voffB); PG8_STAGE(PG8_SB(0, 1), b2 + hstep, voffB); PG8_STAGE(PG8_SA(0, 0), a2, voffA);
            PG8_WAIT_V(8); PG8_WAIT_L(0); PG8_BAR; PG8_MMA(1, 0, At, B0); PG8_MMA(1, 1, At, B1); PG8_BAR; PG8_SCHED;
            PG8_LDB(B0, 1, 0); PG8_LDB(B1, 1, 1); PG8_SCHED; PG8_LDA(At, 1, 0); PG8_STAGE(PG8_SA(0, 1), a2 + hstep, voffA);
            PG8_WAIT_V(8); PG8_WAIT_L(0); PG8_BAR; PG8_MMA(0, 0, At, B0); PG8_MMA(0, 1, At, B1); PG8_BAR; PG8_SCHED;
            PG8_LDA(At, 1, 1); PG8_STAGE(PG8_SB(1, 0), b3, voffB); PG8_STAGE(PG8_SB(1, 1), b3 + hstep, voffB); PG8_STAGE(PG8_SA(1, 0), a3, voffA);
            PG8_WAIT_V(8); PG8_WAIT_L(0); PG8_BAR; PG8_MMA(1, 0, At, B0); PG8_MMA(1, 1, At, B1); PG8_BAR; PG8_SCHED;
            } else {
            PG8_LDB(B0, 0, 0); PG8_SCHED; PG8_LDA(At, 0, 0); PG8_STAGE(PG8_SA(1, 1), a1 + hstep, voffA);
            PG8_WAIT_L(8); PG8_BAR; PG8_WAIT_L(0); PG8_MMA(0, 0, At, B0); PG8_BAR; PG8_SCHED;
            PG8_LDB(B1, 0, 1); PG8_STAGE(PG8_SB(0, 0), b2, voffB);
            PG8_BAR; PG8_WAIT_L(0); PG8_MMA(0, 1, At, B1); PG8_BAR;
            PG8_LDA(At, 0, 1); PG8_STAGE(PG8_SA(0, 0), a2, voffA);
            PG8_BAR; PG8_WAIT_L(0); PG8_MMA(1, 0, At, B0); PG8_BAR; PG8_SCHED;
            PG8_STAGE(PG8_SB(0, 1), b2 + hstep, voffB);
            PG8_WAIT_V(6); PG8_BAR; PG8_MMA(1, 1, At, B1); PG8_BAR;
            PG8_LDB(B0, 1, 0); PG8_SCHED; PG8_LDA(At, 1, 0); PG8_STAGE(PG8_SA(0, 1), a2 + hstep, voffA);
            PG8_WAIT_L(8); PG8_BAR; PG8_WAIT_L(0); PG8_MMA(0, 0, At, B0); PG8_BAR; PG8_SCHED;
            PG8_LDB(B1, 1, 1); PG8_STAGE(PG8_SB(1, 0), b3, voffB);
            PG8_BAR; PG8_WAIT_L(0); PG8_MMA(0, 1, At, B1); PG8_BAR;
            PG8_LDA(At, 1, 1); PG8_STAGE(PG8_SA(1, 0), a3, voffA);
            PG8_BAR; PG8_WAIT_L(0); PG8_MMA(1, 0, At, B0); PG8_BAR; PG8_SCHED;
            PG8_STAGE(PG8_SB(1, 1), b3 + hstep, voffB);
            PG8_WAIT_V(6); PG8_BAR; PG8_MMA(1, 1, At, B1); PG8_BAR;
            }
        }
        if constexpr (ALIGN_EPI) { if (wr == 0) PG8_BAR; }
        if constexpr (!Epi::AFTER_DRAIN) { E(acc, cur, wr, wc, fr, fq); S.done(cur); }
        if (!has_next) break;
#pragma unroll
        for (int a = 0; a < 2; ++a)
#pragma unroll
            for (int b = 0; b < 2; ++b)
#pragma unroll
                for (int m = 0; m < 4; ++m)
#pragma unroll
                    for (int n = 0; n < 2; ++n) acc[a][b][m][n] = (f32x4){0.f, 0.f, 0.f, 0.f};
        cur = nxt; cA = nA; cB = nB; ++ui;
        if constexpr (ALIGN_EPI) { if (wr == 1) PG8_BAR; }
    }
    PG8_WAIT_V(0);
    if constexpr (!ALIGN_EPI) { if (wr == 0) PG8_BAR; }
    PG8_BAR;
    if constexpr (Epi::AFTER_DRAIN) { E.fused(acc, cur, wr, wc, fr, fq, lds, wid, lane); S.done(cur); }
#undef PG8_SA
#undef PG8_SB
#undef PG8_STAGE
#undef PG8_LDA
#undef PG8_LDB
#undef PG8_MMA
#undef PG8_WAIT_V
#undef PG8_WAIT_L
#undef PG8_BAR
#undef PG8_SCHED
}
}
#define GAS __attribute__((address_space(1)))
#define LAS __attribute__((address_space(3)))
typedef unsigned short bf16;
typedef unsigned v4u __attribute__((ext_vector_type(4)));
typedef float f32x4 __attribute__((ext_vector_type(4)));
typedef short bf16x8 __attribute__((ext_vector_type(8)));
typedef GAS unsigned gu32;
typedef GAS unsigned long long gu64;
#define RLX_AGENT __ATOMIC_RELAXED, __HIP_MEMORY_SCOPE_AGENT
#define LDS_WAIT() asm volatile("s_waitcnt lgkmcnt(0)" ::: "memory")
#define VM_WAIT() asm volatile("s_waitcnt vmcnt(0)" ::: "memory")
__device__ __forceinline__ unsigned long long rt() { return __builtin_amdgcn_s_memrealtime(); }
__device__ __forceinline__ unsigned f2bf(float f) { unsigned u = __builtin_bit_cast(unsigned, f); return (u + 0x7fffu + ((u >> 16) & 1u)) >> 16; }
__device__ __forceinline__ unsigned pk2(float lo, float hi) { return f2bf(lo) | (f2bf(hi) << 16); }

#define XB_TMO      128
#define XB_XCNT(j)  (256  + 64 * (j))
#define XB_XSUB(j)  (1280 + 64 * (j))
#define XB_XGEN(j)  (2304 + 64 * (j))
#define XB_TOP      3328
#define XB_TOPGEN   3392
#define XCD_BAR_WORDS 3456
#define XB_SPIN_CAP (1u << 18)

__device__ __forceinline__ unsigned xb_ld(unsigned* p)              { return __hip_atomic_load(p, __ATOMIC_RELAXED, __HIP_MEMORY_SCOPE_AGENT); }
__device__ __forceinline__ unsigned xb_add(unsigned* p, unsigned v) { return __hip_atomic_fetch_add(p, v, __ATOMIC_RELAXED, __HIP_MEMORY_SCOPE_AGENT); }
__device__ __forceinline__ unsigned xb_xcc_id() { return (unsigned)__builtin_amdgcn_s_getreg((3 << 11) | 20) & 0xFu; }
#define XB_SPIN(cond, bar) do { unsigned _sp = 0; while (cond) { __builtin_amdgcn_s_sleep(1); \
    if ((++_sp & 255u) == 0u) { if (xb_ld(&(bar)[XB_TMO])) break; if (_sp > XB_SPIN_CAP) { atomicAdd(&(bar)[XB_TMO], 1u); break; } } } } while (0)

struct XcdBarrier {
    unsigned* bar; unsigned x;
    volatile LAS unsigned* st;
};

__device__ __forceinline__ XcdBarrier xcd_barrier_post(unsigned* bar, volatile LAS unsigned* st) {
    XcdBarrier b; b.bar = bar; b.x = xb_xcc_id(); b.st = st;
    if (threadIdx.x == 0) (void)xb_add(&bar[XB_XCNT(b.x)], 1u);
    return b;
}
__device__ __forceinline__ void xcd_barrier_complete(unsigned* bar, unsigned x, unsigned& nloc, unsigned& nx) {
    const unsigned G = gridDim.x * gridDim.y * gridDim.z;
    unsigned sum, cnt, mine, sp = 0u;
    for (;;) {
        sum = 0u; cnt = 0u; mine = 0u;
#pragma unroll
        for (unsigned j = 0; j < 16; ++j) { const unsigned c = xb_ld(&bar[XB_XCNT(j)]); sum += c; cnt += (c > 0u) ? 1u : 0u; mine = (j == x) ? c : mine; }
        if (sum == G) break;
        __builtin_amdgcn_s_sleep(1);
        if ((++sp & 255u) == 0u) { if (xb_ld(&bar[XB_TMO])) break; if (sp > XB_SPIN_CAP) { atomicAdd(&bar[XB_TMO], 1u); break; } }
    }
    nloc = mine > 0u ? mine : 1u; nx = cnt > 0u ? cnt : 1u;
}

__device__ __forceinline__ void xcd_barrier(const XcdBarrier& b) {
    asm volatile("s_waitcnt vmcnt(0)" ::: "memory");
    __syncthreads();
    if (threadIdx.x == 0) {
        unsigned* bar = b.bar;
        __builtin_amdgcn_s_waitcnt(0);
        unsigned nloc = b.st[0], nx = b.st[1];
        if (nloc == 0u) { xcd_barrier_complete(bar, b.x, nloc, nx); b.st[0] = nloc; b.st[1] = nx; }
        const unsigned old = xb_add(&bar[XB_XSUB(b.x)], 1u);
        const unsigned gen = old / nloc;
        if (old + 1u == (gen + 1u) * nloc) {
            __builtin_amdgcn_fence(__ATOMIC_RELEASE, "agent");
            asm volatile("s_waitcnt vmcnt(0)" ::: "memory");
            const unsigned og = xb_add(&bar[XB_TOP], 1u);
            const unsigned tg = og / nx;
            if (og + 1u == (tg + 1u) * nx) xb_add(&bar[XB_TOPGEN], 1u);
            else XB_SPIN(xb_ld(&bar[XB_TOPGEN]) == tg, bar);
            __builtin_amdgcn_fence(__ATOMIC_ACQUIRE, "agent");
            xb_add(&bar[XB_XGEN(b.x)], 1u);
            asm volatile("s_waitcnt vmcnt(0)" ::: "memory");
        } else {
            XB_SPIN(xb_ld(&bar[XB_XGEN(b.x)]) == gen, bar);
            __builtin_amdgcn_fence(__ATOMIC_ACQUIRE, "agent");
            asm volatile("s_waitcnt vmcnt(0)" ::: "memory");
        }
    }
    __syncthreads();
}
constexpr int NWAVES = 8;
constexpr int D = 2048, NB = 2, SEQ = 4096, T = NB * SEQ;
constexpr int SG = 128, SP = 64, SC = 16;
constexpr int NH = 16, HD = 128, NKV = 4, NGRP = 3;
constexpr int FF = 5632;
constexpr int NQ = NGRP * NH * HD, NKVC = NKV * HD;
constexpr int NQKV = NQ + 2 * NKVC;
constexpr float EPS = 1e-6f;
constexpr float QSCALE = 0.08838834764831845f * 1.4426950408889634f;

constexpr size_t MiB = 1u << 20;
constexpr size_t WS_CTL = 0, CTL_ZERO_BYTES = 1 * MiB;
constexpr size_t WS_RSTD0 = 1 * MiB;
constexpr size_t WS_WGLU = 2 * MiB, WS_WIN0 = 18 * MiB, WS_WOUT0 = 62 * MiB, WS_WQKV = 84 * MiB, WS_WO = 112 * MiB, WS_WIN1 = 120 * MiB, WS_WOUT1 = 164 * MiB;
constexpr size_t WS_XA = 186 * MiB;
constexpr size_t WS_XB = 250 * MiB;
constexpr size_t WS_ZO = 282 * MiB;
constexpr size_t WS_HQ = 314 * MiB;
constexpr size_t WS_K = 410 * MiB, WS_V = 418 * MiB;
constexpr size_t WS_OG = 426 * MiB;
constexpr size_t WS_LSE = 522 * MiB;
constexpr size_t WS_END = 524 * MiB;
constexpr int CW_TMO = 0, CW_CODE = 1, CW_BAR = 4096;
constexpr int CW_ROWSQ = 16384;
static_assert((CW_ROWSQ + 4 * T) * 4 <= (int)CTL_ZERO_BYTES, "ctl");

constexpr int RING_OFF = 0, RING_BYTES = 131072;
constexpr int LDSCTL_OFF = RING_BYTES, MISC_OFF = LDSCTL_OFF + 320;
constexpr int LDS_BYTES = 147456;

struct Frame {
    LAS unsigned char* lds;
    volatile LAS unsigned* MISC;
    gu32* ctl;
    int tid, lane, wave;
    int vcu, G;
};

__device__ __forceinline__ float wave_sum(float v) {
#pragma unroll
    for (int o = 1; o < 64; o <<= 1) v += __shfl_xor(v, o);
    return v;
}
__device__ __forceinline__ float wave_max(float v) {
#pragma unroll
    for (int o = 1; o < 64; o <<= 1) v = fmaxf(v, __shfl_xor(v, o));
    return v;
}
__device__ __forceinline__ void p0_transpose_item(const float* W, int K, int N, const float* gain, bf16* WT, int Nh, int row_off, LAS float* scr, int item, int lane) {
    const int nblk = N / 32, kb = item / nblk, nb = item % nblk, k0 = 64 * kb, n0 = 32 * nb;
#pragma unroll 8
    for (int i = 0; i < 32; ++i) { const int kk = 2 * i + (lane >> 5); float v = W[(size_t)(k0 + kk) * N + n0 + (lane & 31)]; if (gain) v *= gain[k0 + kk]; scr[kk * 33 + (lane & 31)] = v; }
    LDS_WAIT(); asm volatile("" ::: "memory");
    const int c = lane & 7;
    int drow0 = row_off + n0;
    if (Nh) { const int nn = n0 % Nh; drow0 = 256 * (nn / 128) + 128 * (n0 / Nh) + (nn % 128); }
#pragma unroll
    for (int j = 0; j < 4; ++j) { const int n = (lane >> 3) + 8 * j; const LAS float* s = scr + (8 * c) * 33 + n;
        v4u o; o.x = pk2(s[0 * 33], s[1 * 33]); o.y = pk2(s[2 * 33], s[3 * 33]); o.z = pk2(s[4 * 33], s[5 * 33]); o.w = pk2(s[6 * 33], s[7 * 33]);
        *(GAS v4u*)(WT + (size_t)(drow0 + n) * K + k0 + 8 * c) = o; }
    LDS_WAIT(); asm volatile("" ::: "memory");
}

__device__ __forceinline__ float bf2f(bf16 v) { return __builtin_bit_cast(float, (unsigned)v << 16); }
__device__ __forceinline__ float gelu_tanh(float y) {
    const float k0 = 0.7978845608028654f, k1 = 0.044715f;
    return 0.5f * y * (1.f + tanhf(k0 * (y + k1 * y * y * y)));
}
__device__ __forceinline__ void s5_simple_item(int bg, int p, const float* __restrict__ x, const float* __restrict__ rstd, const float* __restrict__ gn,
        const float* __restrict__ lam_re, const float* __restrict__ lam_im, const float* __restrict__ log_dt,
        const float* __restrict__ b_re, const float* __restrict__ b_im, const float* __restrict__ c_re, const float* __restrict__ c_im,
        const float* __restrict__ d_skip, bf16* __restrict__ z) {
    constexpr int G = SG, P = SP, C = SC, S = SEQ;
    const int b = bg / G, g = bg % G;
    const float lr = lam_re[g * P + p], li = lam_im[g * P + p];
    const float dt = expf(log_dt[g]);
    const float mag = expf(lr * dt), ang = li * dt;
    const float lbr = mag * cosf(ang), lbi = mag * sinf(ang);
    const float nr = lbr - 1.f, den = lr * lr + li * li;
    const float fr = (nr * lr + lbi * li) / den, fi = (lbi * lr - nr * li) / den;
    float bbr[C], bbi[C], cr[C], ci[C];
#pragma unroll
    for (int c = 0; c < C; ++c) {
        const float br = b_re[(g * P + p) * C + c], bi = b_im[(g * P + p) * C + c];
        bbr[c] = fr * br - fi * bi; bbi[c] = fr * bi + fi * br;
        cr[c] = c_re[(g * C + c) * P + p]; ci[c] = c_im[(g * C + c) * P + p];
    }
    const int pc = p & 15;
    const float gnp = gn[g * C + pc], dp = d_skip[g * C + pc];
    float gnc[C];
#pragma unroll
    for (int c = 0; c < C; ++c) gnc[c] = gn[g * C + c];
    float xr = 0.f, xi = 0.f;
    for (int t = 0; t < S; ++t) {
        const size_t row = (size_t)b * S + t;
        const float* xp = x + row * D + g * C;
        const float r = rstd[row];
        float bur = 0.f, bui = 0.f;
#pragma unroll
        for (int c = 0; c < C; ++c) { const float u = xp[c] * r * gnc[c]; bur += bbr[c] * u; bui += bbi[c] * u; }
        const float nxr = lbr * xr - lbi * xi + bur, nxi = lbr * xi + lbi * xr + bui;
        xr = nxr; xi = nxi;
        float myy = 0.f;
#pragma unroll
        for (int c = 0; c < C; ++c) { float v = cr[c] * xr - ci[c] * xi; v = wave_sum(v); if (p == c) myy = v; }
        if (p < C) { const float up = xp[pc] * r * gnp; z[row * D + g * C + p] = (bf16)f2bf(gelu_tanh(myy + dp * up)); }
    }
}
__device__ __forceinline__ void attn_simple_item(int idx, int lane, LAS float* qs, const bf16* __restrict__ q, const bf16* __restrict__ kk, const bf16* __restrict__ vv, bf16* __restrict__ o) {
    const int row = idx / NH, h = idx % NH, b = row / SEQ, t = row % SEQ, kvh = h / (NH / NKV);
    float og[NGRP][2], lse[NGRP];
#pragma unroll
    for (int g = 0; g < NGRP; ++g) {
        const int dil = (g == 0) ? 1 : (g == 1 ? 4 : 16);
        const bf16* qp = q + (size_t)row * NQ + g * (NH * HD) + h * HD;
        LDS_WAIT(); asm volatile("" ::: "memory");
        qs[lane] = bf2f(qp[lane]); qs[lane + 64] = bf2f(qp[lane + 64]);
        LDS_WAIT(); asm volatile("" ::: "memory");
        float sc[3];
#pragma unroll
        for (int pass = 0; pass < 3; ++pass) {
            const int j = pass * 64 + lane;
            const int tk = t - j * dil;
            float s = -1e30f;
            if (j <= 128 && tk >= 0) {
                const bf16* kp = kk + (size_t)(b * SEQ + tk) * NKVC + kvh * HD;
                float a = 0.f;
#pragma unroll 8
                for (int e = 0; e < HD; ++e) a += qs[e] * bf2f(kp[e]);
                s = a;
            }
            sc[pass] = s;
        }
        const float m = wave_max(fmaxf(fmaxf(sc[0], sc[1]), sc[2]));
        float pr[3]; float l = 0.f;
#pragma unroll
        for (int pass = 0; pass < 3; ++pass) { pr[pass] = (sc[pass] > -1e29f) ? exp2f(sc[pass] - m) : 0.f; l += pr[pass]; }
        l = wave_sum(l);
        lse[g] = m + log2f(l);
        float a0 = 0.f, a1 = 0.f;
#pragma unroll
        for (int pass = 0; pass < 3; ++pass) {
            const int jn = (pass < 2) ? 64 : 1;
            for (int jj = 0; jj < jn; ++jj) {
                const float pj = __shfl(pr[pass], jj);
                const int j = pass * 64 + jj; const int tk = t - j * dil;
                if (tk >= 0) {
                    const bf16* vp = vv + (size_t)(b * SEQ + tk) * NKVC + kvh * HD;
                    a0 += pj * bf2f(vp[lane]); a1 += pj * bf2f(vp[lane + 64]);
                }
            }
        }
        og[g][0] = a0 / l; og[g][1] = a1 / l;
    }
    const float mx = fmaxf(fmaxf(lse[0], lse[1]), lse[2]);
    const float w0 = exp2f(lse[0] - mx), w1 = exp2f(lse[1] - mx), w2 = exp2f(lse[2] - mx), wsum = w0 + w1 + w2;
    bf16* op = o + (size_t)row * D + h * HD;
    op[lane] = (bf16)f2bf((w0 * og[0][0] + w1 * og[1][0] + w2 * og[2][0]) / wsum);
    op[lane + 64] = (bf16)f2bf((w0 * og[0][1] + w1 * og[1][1] + w2 * og[2][1]) / wsum);
}

struct Args { const float* in[20]; float* out; unsigned char* ws; int ph_lo, ph_hi; };

__global__ void __launch_bounds__(NWAVES * 64, 2) mk_fwd(Args args) {
    extern __shared__ __attribute__((aligned(16))) unsigned char lds[];
    Frame F;
    F.lds = (LAS unsigned char*)lds;
    F.MISC = (volatile LAS unsigned*)(F.lds + MISC_OFF);
    F.tid = threadIdx.x; F.lane = F.tid & 63; F.wave = __builtin_amdgcn_readfirstlane(F.tid >> 6);
    F.G = gridDim.x; { const int bx = blockIdx.x; F.vcu = (F.G % 8 == 0) ? (bx % 8) * (F.G / 8) + bx / 8 : bx; }
    unsigned char* ws = args.ws;
    F.ctl = (gu32*)(ws + WS_CTL);
    const float* x = args.in[0];
    bf16* WgluT = (bf16*)(ws + WS_WGLU); bf16* Win0T = (bf16*)(ws + WS_WIN0); bf16* Wout0T = (bf16*)(ws + WS_WOUT0); bf16* WqkvT = (bf16*)(ws + WS_WQKV);
    bf16* WoT = (bf16*)(ws + WS_WO); bf16* Win1T = (bf16*)(ws + WS_WIN1); bf16* Wout1T = (bf16*)(ws + WS_WOUT1);
    float* XA = (float*)(ws + WS_XA); bf16* XB = (bf16*)(ws + WS_XB); bf16* ZO = (bf16*)(ws + WS_ZO); bf16* HQ = (bf16*)(ws + WS_HQ);
    bf16* KB = (bf16*)(ws + WS_K); bf16* VB = (bf16*)(ws + WS_V);
    float* rstd0 = (float*)(ws + WS_RSTD0);
    float* rowsq = (float*)(ws + WS_CTL) + CW_ROWSQ;
    for (int u = F.tid; u < (LDS_BYTES - LDSCTL_OFF) / 4; u += NWAVES * 64) ((LAS unsigned*)(F.lds + LDSCTL_OFF))[u] = 0u;
    __syncthreads();
    XcdBarrier bar = xcd_barrier_post((unsigned*)(F.ctl + CW_BAR), F.MISC + 8);
    const int lo = args.ph_lo, hi = args.ph_hi;
#define IN(k) (lo <= (k) && (k) < hi)
#define BOTH(k) (IN(k) && IN((k) + 1))
#define GRID_BAR() xcd_barrier(bar)

    if (IN(0)) {
        LAS float* scr = (LAS float*)(F.lds + RING_OFF + F.wave * 16384);
        const int gw = F.vcu * NWAVES + F.wave, NGW = F.G * NWAVES;
        constexpr int I0 = (D / 64) * (2 * D / 32), I1 = (D / 64) * (2 * FF / 32), I2 = (FF / 64) * (D / 32), I3 = (D / 64) * (NQ / 32), I4 = (D / 64) * (2 * NKVC / 32), I5 = (D / 64) * (D / 32);
        constexpr int NITEMS = I0 + 2 * I1 + 2 * I2 + I3 + I4 + I5;
        for (int it = gw; it < NITEMS; it += NGW) {
            int r = it;
            if (r < I0) { p0_transpose_item(args.in[9], D, 2 * D, nullptr, WgluT, D, 0, scr, r, F.lane); continue; } r -= I0;
            if (r < I1) { p0_transpose_item(args.in[12], D, 2 * FF, args.in[11], Win0T, FF, 0, scr, r, F.lane); continue; } r -= I1;
            if (r < I2) { p0_transpose_item(args.in[13], FF, D, nullptr, Wout0T, 0, 0, scr, r, F.lane); continue; } r -= I2;
            if (r < I3) { p0_transpose_item(args.in[15], D, NQ, args.in[14], WqkvT, 0, 0, scr, r, F.lane); continue; } r -= I3;
            if (r < I4) { p0_transpose_item(args.in[18], D, 2 * NKVC, args.in[17], WqkvT, 0, NQ, scr, r, F.lane); continue; } r -= I4;
            if (r < I5) { p0_transpose_item(args.in[16], D, D, nullptr, WoT, 0, 0, scr, r, F.lane); continue; } r -= I5;
            if (r < I1) { p0_transpose_item(args.in[12] + (size_t)D * 2 * FF, D, 2 * FF, args.in[11] + D, Win1T, FF, 0, scr, r, F.lane); continue; } r -= I1;
            p0_transpose_item(args.in[13] + (size_t)FF * D, FF, D, nullptr, Wout1T, 0, 0, scr, r, F.lane);
        }
        for (int m = gw; m < T; m += NGW) {
            const GAS f32x4* xr = (const GAS f32x4*)(x + (size_t)m * D) + F.lane; float s = 0.f;
#pragma unroll
            for (int j = 0; j < D / 256; ++j) { const f32x4 v = xr[64 * j]; s += (v.x * v.x + v.y * v.y) + (v.z * v.z + v.w * v.w); }
            s = wave_sum(s);
            if (F.lane == 0) rstd0[m] = 1.0f / sqrtf(s * (1.0f / D) + EPS);
        }
        if (BOTH(0)) GRID_BAR();
    }
    if (IN(1)) {
        if (F.wave == 0) {
            for (int bg = blockIdx.x; bg < NB * SG; bg += F.G)
                s5_simple_item(bg, F.lane, x, rstd0, args.in[10], args.in[1], args.in[2], args.in[3], args.in[4], args.in[5], args.in[6], args.in[7], args.in[8], ZO);
        }
        if (BOTH(1)) GRID_BAR();
    }
    if (IN(2)) {
        pg8::Gemm g{ZO, WgluT, T, 2 * D, D}; pg8::StaticOrder S; S.init(T, 2 * D, F.G, (int)blockIdx.x);
        pg8::EpiGluRes E{x, XA, XB, rowsq};
        pg8::gemm_phase<pg8::EpiGluRes, pg8::StaticOrder, true, true>(F.lds + RING_OFF, g, S, E);
        if (BOTH(2)) GRID_BAR();
    }
    if (IN(3)) {
        pg8::Gemm g{XB, Win0T, T, 2 * FF, D}; pg8::StaticOrder S; S.init(T, 2 * FF, F.G, (int)blockIdx.x);
        pg8::EpiSwiGlu E{rowsq, HQ, FF};
        pg8::gemm_phase<pg8::EpiSwiGlu, pg8::StaticOrder, true, true>(F.lds + RING_OFF, g, S, E);
        if (BOTH(3)) GRID_BAR();
    }
    if (IN(4)) {
        pg8::Gemm g{HQ, Wout0T, T, D, FF}; pg8::StaticOrder S; S.init(T, D, F.G, (int)blockIdx.x);
        pg8::EpiRes<true> E{XA, XB, rowsq + T};
        pg8::gemm_phase<pg8::EpiRes<true>, pg8::StaticOrder, true, true>(F.lds + RING_OFF, g, S, E);
        if (BOTH(4)) GRID_BAR();
    }
    if (IN(5)) {
        pg8::Gemm g{XB, WqkvT, T, NQKV, D}; pg8::StaticOrder S; S.init(T, NQKV, F.G, (int)blockIdx.x);
        pg8::EpiQKV E{rowsq + T, HQ, KB, VB, QSCALE};
        pg8::gemm_phase<pg8::EpiQKV, pg8::StaticOrder, true, true>(F.lds + RING_OFF, g, S, E);
        if (BOTH(5)) GRID_BAR();
    }
    if (IN(6)) {
        LAS float* qs = (LAS float*)(F.lds + RING_OFF + F.wave * 1024);
        const int gw = F.vcu * NWAVES + F.wave, NGW = F.G * NWAVES;
        for (int idx = gw; idx < T * NH; idx += NGW) attn_simple_item(idx, F.lane, qs, HQ, KB, VB, ZO);
        if (BOTH(6)) GRID_BAR();
    }
    if (IN(7)) {
        pg8::Gemm g{ZO, WoT, T, D, D}; pg8::StaticOrder S; S.init(T, D, F.G, (int)blockIdx.x);
        pg8::EpiRes<true> E{XA, XB, rowsq + 2 * T};
        pg8::gemm_phase<pg8::EpiRes<true>, pg8::StaticOrder, true, true>(F.lds + RING_OFF, g, S, E);
        if (BOTH(7)) GRID_BAR();
    }
    if (IN(8)) {
        pg8::Gemm g{XB, Win1T, T, 2 * FF, D}; pg8::StaticOrder S; S.init(T, 2 * FF, F.G, (int)blockIdx.x);
        pg8::EpiSwiGlu E{rowsq + 2 * T, HQ, FF};
        pg8::gemm_phase<pg8::EpiSwiGlu, pg8::StaticOrder, true, true>(F.lds + RING_OFF, g, S, E);
        if (BOTH(8)) GRID_BAR();
    }
    if (IN(9)) {
        pg8::Gemm g{HQ, Wout1T, T, D, FF}; pg8::StaticOrder S; S.init(T, D, F.G, (int)blockIdx.x);
        pg8::EpiRes<true> E{XA, XB, rowsq + 3 * T};
        pg8::gemm_phase<pg8::EpiRes<true>, pg8::StaticOrder, true, true>(F.lds + RING_OFF, g, S, E);
        if (BOTH(9)) GRID_BAR();
    }
    if (IN(10)) {
        const int gw = F.vcu * NWAVES + F.wave, NGW = F.G * NWAVES;
        const GAS f32x4* gr = (const GAS f32x4*)args.in[19] + F.lane;
        for (int m = gw; m < T; m += NGW) {
            const GAS f32x4* xr = (const GAS f32x4*)(XA + (size_t)m * D) + F.lane; GAS f32x4* orow = (GAS f32x4*)(args.out + (size_t)m * D) + F.lane;
            f32x4 v[D / 256]; float s = 0.f;
#pragma unroll
            for (int j = 0; j < D / 256; ++j) { v[j] = xr[64 * j]; s += (v[j].x * v[j].x + v[j].y * v[j].y) + (v[j].z * v[j].z + v[j].w * v[j].w); }
            s = wave_sum(s);
            const float r = 1.0f / sqrtf(s * (1.0f / D) + EPS);
#pragma unroll
            for (int j = 0; j < D / 256; ++j) orow[64 * j] = v[j] * r * gr[64 * j];
        }
    }
#undef IN
#undef BOTH
#undef GRID_BAR
}

extern "C" void kernel_launch(void* const* d_in, const int* in_sizes, int n_in, void* d_out, int out_size, void* d_ws, size_t ws_size, hipStream_t stream) {
    static int grid = 0;
    if (grid == 0) {
        if (n_in != 20 || out_size != T * D || ws_size < WS_END) { fprintf(stderr, "kernel_launch: unexpected shapes/ws (n_in %d out %d ws %zu)\n", n_in, out_size, ws_size); grid = -1; return; }
        int dev = 0, cus = 0;
        if (hipGetDevice(&dev) != hipSuccess || hipDeviceGetAttribute(&cus, hipDeviceAttributeMultiprocessorCount, dev) != hipSuccess) { grid = -1; return; }
        if (hipFuncSetAttribute((const void*)mk_fwd, hipFuncAttributeMaxDynamicSharedMemorySize, LDS_BYTES) != hipSuccess) { fprintf(stderr, "kernel_launch: hipFuncSetAttribute failed\n"); grid = -1; return; }
        (void)hipGetLastError();
        grid = cus;
    }
    if (grid < 0) return;
    (void)hipMemsetAsync((char*)d_ws + WS_CTL, 0, CTL_ZERO_BYTES, stream);
    Args a{};
    for (int i = 0; i < 20; ++i) a.in[i] = (const float*)d_in[i];
    a.out = (float*)d_out; a.ws = (unsigned char*)d_ws;
    unsigned char* ws = (unsigned char*)d_ws;
#define LAUNCH(lo_, hi_) do { a.ph_lo = (lo_); a.ph_hi = (hi_); hipLaunchKernelGGL(mk_fwd, dim3(grid), dim3(NWAVES * 64), LDS_BYTES, stream, a); } while (0)
    LAUNCH(0, 11);
#undef LAUNCH
}
```

```cpp
#include <hip/hip_runtime.h>
#include <cstdint>
#include <cstdio>
namespace pg8 {
#define PG8_LAS __attribute__((address_space(3)))
typedef unsigned short bf16_t;
typedef short bf16x8 __attribute__((ext_vector_type(8)));
typedef float f32x4 __attribute__((ext_vector_type(4)));
typedef unsigned u32x4 __attribute__((ext_vector_type(4)));
constexpr int BM = 256, BK = 64, HALF = 128, HTB = HALF * BK * 2  , STAGE_BYTES = 8 * HTB, NXCD = 8, WGM = 8;

__host__ __device__ __forceinline__ int lds_byte(int r, int c) { const int st = (r >> 4) * 2 + (c >> 5), rr = r & 15, cc = c & 31, ob = rr * 64 + cc * 2; return st * 1024 + (ob ^ (((ob >> 9) & 1) << 5)); }
__host__ __device__ __forceinline__ void stage_rc(int b, int& R, int& C) { const int st = b / 1024, sb = b % 1024, swz = sb ^ (((sb >> 9) & 1) << 5); R = (st >> 1) * 16 + swz / 64; C = (st & 1) * 32 + (swz % 64) / 2; }
__host__ __device__ __forceinline__ int perm32(int rho) { const int n = rho >> 4, i = rho & 15; return 8 * (i >> 2) + 4 * n + (i & 3); }

struct Unit { int pm, pn; };
struct Gemm { const bf16_t* A; const bf16_t* Bt; int M, N, K; };

struct StaticOrder {
    int nM, nN, nwg, G, c;
    __host__ __device__ void init(int M, int N, int G_, int c_) { nM = M / BM; nN = N / BM; nwg = nM * nN; G = G_; c = c_; }
    __host__ __device__ bool next(int i, Unit& u) const {
        const long L = (long)i * G + c; if (L >= nwg) return false;
        int wgid = (int)L; { const int q = nwg / NXCD, r = nwg % NXCD, xcd = wgid % NXCD, off = wgid / NXCD; wgid = (xcd < r ? xcd * (q + 1) : r * (q + 1) + (xcd - r) * q) + off; }
        const int nig = WGM * nN, gid = wgid / nig, fm = gid * WGM, gsz = (nM - fm) < WGM ? (nM - fm) : WGM;
        u.pm = fm + ((wgid % nig) % gsz); u.pn = (wgid % nig) / gsz; return true;
    }
    __device__ __forceinline__ void a_ready(const Unit&) const {}
    __device__ __forceinline__ void done(const Unit&) const {}
};

__device__ __forceinline__ unsigned cvt_pk_bf16(float lo, float hi) { unsigned r; asm volatile("v_cvt_pk_bf16_f32 %0, %1, %2" : "=v"(r) : "v"(lo), "v"(hi)); return r; }
__device__ __forceinline__ float sigm(float v) { return __builtin_amdgcn_rcpf(1.0f + __builtin_amdgcn_exp2f(v * -1.4426950408889634f)); }
__device__ __forceinline__ u32x4 pack8(const f32x4& a, const f32x4& b) { u32x4 w; w.x = cvt_pk_bf16(a[0], a[1]); w.y = cvt_pk_bf16(a[2], a[3]); w.z = cvt_pk_bf16(b[0], b[1]); w.w = cvt_pk_bf16(b[2], b[3]); return w; }
constexpr int DM = 2048;
constexpr float NORM_EPS = 1e-6f;

struct EpiGluRes {
    static constexpr bool PERM = true, AFTER_DRAIN = false;
    const float* res; float* XA; bf16_t* XB; float* rowsq;
    __device__ __forceinline__ void operator()(const f32x4 (&acc)[2][2][4][2], const Unit& u, int wr, int wc, int fr, int fq) const {
        const int row0 = u.pm * BM + wr * 64 + fr, col0 = u.pn * HALF + wc * 32 + 8 * fq;
#pragma unroll
        for (int ai = 0; ai < 2; ++ai)
#pragma unroll
            for (int m = 0; m < 4; ++m) {
                const int row = row0 + ai * HALF + m * 16; const size_t off = (size_t)row * DM + col0;
                const f32x4 r0 = *(const f32x4*)(res + off), r1 = *(const f32x4*)(res + off + 4);
                f32x4 v0, v1;
#pragma unroll
                for (int j = 0; j < 4; ++j) { v0[j] = r0[j] + acc[ai][0][m][0][j] * sigm(acc[ai][1][m][0][j]); v1[j] = r1[j] + acc[ai][0][m][1][j] * sigm(acc[ai][1][m][1][j]); }
                *(f32x4*)(XA + off) = v0; *(f32x4*)(XA + off + 4) = v1;
                *(u32x4*)(XB + off) = pack8(v0, v1);
                float s = (v0[0] * v0[0] + v0[1] * v0[1]) + (v0[2] * v0[2] + v0[3] * v0[3]) + (v1[0] * v1[0] + v1[1] * v1[1]) + (v1[2] * v1[2] + v1[3] * v1[3]);
                s += __shfl_xor(s, 16); s += __shfl_xor(s, 32);
                if (fq == 0) atomicAdd(rowsq + row, s);
            }
    }
};
struct EpiSwiGlu {
    static constexpr bool PERM = true, AFTER_DRAIN = false;
    const float* rowsq; bf16_t* H; int ldh;
    __device__ __forceinline__ void operator()(const f32x4 (&acc)[2][2][4][2], const Unit& u, int wr, int wc, int fr, int fq) const {
        const int row0 = u.pm * BM + wr * 64 + fr, col0 = u.pn * HALF + wc * 32 + 8 * fq;
#pragma unroll
        for (int ai = 0; ai < 2; ++ai)
#pragma unroll
            for (int m = 0; m < 4; ++m) {
                const int row = row0 + ai * HALF + m * 16;
                const float rs = __builtin_amdgcn_rsqf(rowsq[row] * (1.0f / DM) + NORM_EPS);
                f32x4 v0, v1;
#pragma unroll
                for (int j = 0; j < 4; ++j) { const float g0 = acc[ai][0][m][0][j] * rs, g1 = acc[ai][0][m][1][j] * rs;
                    v0[j] = g0 * sigm(g0) * (acc[ai][1][m][0][j] * rs); v1[j] = g1 * sigm(g1) * (acc[ai][1][m][1][j] * rs); }
                *(u32x4*)(H + (size_t)row * ldh + col0) = pack8(v0, v1);
            }
    }
};
template <bool WRITE_XB> struct EpiRes {
    static constexpr bool PERM = true, AFTER_DRAIN = false;
    float* XA; bf16_t* XB; float* rowsq;
    __device__ __forceinline__ void operator()(const f32x4 (&acc)[2][2][4][2], const Unit& u, int wr, int wc, int fr, int fq) const {
        const int row0 = u.pm * BM + wr * 64 + fr, col0 = u.pn * BM + wc * 32 + 8 * fq;
#pragma unroll
        for (int ai = 0; ai < 2; ++ai)
#pragma unroll
            for (int m = 0; m < 4; ++m) {
                const int row = row0 + ai * HALF + m * 16; float s = 0.f;
#pragma unroll
                for (int bj = 0; bj < 2; ++bj) {
                    const size_t off = (size_t)row * DM + col0 + bj * HALF;
                    const f32x4 v0 = *(const f32x4*)(XA + off) + acc[ai][bj][m][0], v1 = *(const f32x4*)(XA + off + 4) + acc[ai][bj][m][1];
                    *(f32x4*)(XA + off) = v0; *(f32x4*)(XA + off + 4) = v1;
                    if (WRITE_XB) *(u32x4*)(XB + off) = pack8(v0, v1);
                    s += (v0[0] * v0[0] + v0[1] * v0[1]) + (v0[2] * v0[2] + v0[3] * v0[3]) + (v1[0] * v1[0] + v1[1] * v1[1]) + (v1[2] * v1[2] + v1[3] * v1[3]);
                }
                s += __shfl_xor(s, 16); s += __shfl_xor(s, 32);
                if (fq == 0) atomicAdd(rowsq + row, s);
            }
    }
};
struct EpiQKV {
    static constexpr bool PERM = true, AFTER_DRAIN = false;
    const float* rowsq; bf16_t* Q; bf16_t* K; bf16_t* V; float qscale;
    __device__ __forceinline__ void operator()(const f32x4 (&acc)[2][2][4][2], const Unit& u, int wr, int wc, int fr, int fq) const {
        const int row0 = u.pm * BM + wr * 64 + fr;
        bf16_t* base; int ld, colt; float sc = 1.f;
        if (u.pn < 24) { base = Q; ld = 6144; colt = u.pn * BM; sc = qscale; }
        else if (u.pn < 26) { base = K; ld = 512; colt = (u.pn - 24) * BM; }
        else { base = V; ld = 512; colt = (u.pn - 26) * BM; }
        const int col0 = colt + wc * 32 + 8 * fq;
#pragma unroll
        for (int ai = 0; ai < 2; ++ai)
#pragma unroll
            for (int m = 0; m < 4; ++m) {
                const int row = row0 + ai * HALF + m * 16;
                const float rs = __builtin_amdgcn_rsqf(rowsq[row] * (1.0f / DM) + NORM_EPS) * sc;
#pragma unroll
                for (int bj = 0; bj < 2; ++bj) *(u32x4*)(base + (size_t)row * ld + col0 + bj * HALF) = pack8(acc[ai][bj][m][0] * rs, acc[ai][bj][m][1] * rs);
            }
    }
};
template <class Epi, class Sched, bool ALIGN_EPI = false, bool SP2 = false>
__device__ __forceinline__ void gemm_phase(PG8_LAS unsigned char* lds, const Gemm g, const Sched& S, const Epi& E) {
    const int tid = threadIdx.x, wid = __builtin_amdgcn_readfirstlane(tid >> 6), lane = tid & 63, wr = wid >> 2, wc = wid & 3, fr = lane & 15, fq = lane >> 4;
    const int K = g.K, nt = K / BK;
    unsigned voffA[2], voffB[2];
#pragma unroll
    for (int i = 0; i < 2; ++i) { int R, C; stage_rc(tid * 16 + i * 8192, R, C); const int Rb = Epi::PERM ? ((R & ~31) + perm32(R & 31)) : R;
        voffA[i] = (unsigned)(R * K + C) * 2u; voffB[i] = (unsigned)(Rb * K + C) * 2u; }
    const size_t kstep = (size_t)(BK * 2);
    const size_t hstep = (size_t)HALF * K * 2;
    const size_t tstep = 2 * hstep;
    const unsigned ldsw = (unsigned)wid * 1024u;
    const int aoff = lds_byte(wr * 64 + fr, fq * 8), boff = lds_byte(wc * 32 + fr, fq * 8);
#define PG8_SA(b, h) (((b) * 2 + (h)) * HTB)
#define PG8_SB(b, h) ((4 + (b) * 2 + (h)) * HTB)
#define PG8_STAGE(bufoff, gbase, voff) do { _Pragma("unroll") for (int _i = 0; _i < 2; ++_i) \
        __builtin_amdgcn_global_load_lds((const unsigned*)((const char*)(gbase) + (voff)[_i]), (PG8_LAS unsigned*)(lds + (bufoff) + ldsw + _i * 8192), 16, 0, 0); } while (0)
#define PG8_LDA(dst, b, h) do { _Pragma("unroll") for (int m = 0; m < 4; ++m) _Pragma("unroll") for (int k = 0; k < 2; ++k) dst[m][k] = *(const PG8_LAS bf16x8*)(lds + PG8_SA(b, h) + aoff + m * 2048 + k * 1024); } while (0)
#define PG8_LDB(dst, b, h) do { _Pragma("unroll") for (int n = 0; n < 2; ++n) _Pragma("unroll") for (int k = 0; k < 2; ++k) dst[n][k] = *(const PG8_LAS bf16x8*)(lds + PG8_SB(b, h) + boff + n * 2048 + k * 1024); } while (0)
#define PG8_MMA(ai, bj, At, Bt) do { __builtin_amdgcn_s_setprio(1); _Pragma("unroll") for (int m = 0; m < 4; ++m) _Pragma("unroll") for (int n = 0; n < 2; ++n) _Pragma("unroll") for (int k = 0; k < 2; ++k) \
        acc[ai][bj][m][n] = __builtin_amdgcn_mfma_f32_16x16x32_bf16(Bt[n][k], At[m][k], acc[ai][bj][m][n], 0, 0, 0); __builtin_amdgcn_s_setprio(0); } while (0)
#define PG8_WAIT_V(n) asm volatile("s_waitcnt vmcnt(" #n ")" ::: "memory")
#define PG8_WAIT_L(n) asm volatile("s_waitcnt lgkmcnt(" #n ")" ::: "memory")
#define PG8_BAR __builtin_amdgcn_s_barrier()
#define PG8_SCHED __builtin_amdgcn_sched_barrier(0)
    Unit cur, nxt; int ui = 0;
    if (!S.next(0, cur)) return;
    f32x4 acc[2][2][4][2];
#pragma unroll
    for (int a = 0; a < 2; ++a)
#pragma unroll
        for (int b = 0; b < 2; ++b)
#pragma unroll
            for (int m = 0; m < 4; ++m)
#pragma unroll
                for (int n = 0; n < 2; ++n) acc[a][b][m][n] = (f32x4){0.f, 0.f, 0.f, 0.f};
    bf16x8 At[4][2], B0[2][2], B1[2][2];
    const char* cA = (const char*)g.A + (size_t)cur.pm * tstep; const char* cB = (const char*)g.Bt + (size_t)cur.pn * tstep;
    S.a_ready(cur);
    if constexpr (SP2) {
        PG8_STAGE(PG8_SB(0, 0), cB, voffB); PG8_STAGE(PG8_SB(0, 1), cB + hstep, voffB); PG8_STAGE(PG8_SA(0, 0), cA, voffA); PG8_STAGE(PG8_SA(0, 1), cA + hstep, voffA);
        if (wr == 1) PG8_BAR;
        PG8_WAIT_V(2); PG8_BAR;
        PG8_STAGE(PG8_SB(1, 0), cB + kstep, voffB); PG8_STAGE(PG8_SA(1, 0), cA + kstep, voffA); PG8_STAGE(PG8_SB(1, 1), cB + hstep + kstep, voffB);
        PG8_WAIT_V(6); PG8_BAR;
    } else {
        PG8_STAGE(PG8_SB(0, 0), cB, voffB); PG8_STAGE(PG8_SA(0, 0), cA, voffA); PG8_STAGE(PG8_SB(0, 1), cB + hstep, voffB); PG8_STAGE(PG8_SA(0, 1), cA + hstep, voffA);
        if (wr == 1) PG8_BAR;
        PG8_WAIT_V(4); PG8_BAR;
        PG8_STAGE(PG8_SB(1, 0), cB + kstep, voffB); PG8_STAGE(PG8_SA(1, 0), cA + kstep, voffA); PG8_STAGE(PG8_SB(1, 1), cB + hstep + kstep, voffB);
        PG8_WAIT_V(6); PG8_BAR;
    }
    for (;;) {
        const bool has_next = S.next(ui + 1, nxt);
        const char* nA = has_next ? (const char*)g.A + (size_t)nxt.pm * tstep : cA; const char* nB = has_next ? (const char*)g.Bt + (size_t)nxt.pn * tstep : cB;
        for (int t = 0; t < nt; t += 2) {
            const bool last = (t == nt - 2);
            const char* a1 = cA + (size_t)(t + 1) * kstep;
            const char* a2 = last ? nA : cA + (size_t)(t + 2) * kstep; const char* b2 = last ? nB : cB + (size_t)(t + 2) * kstep;
            const char* a3 = a2 + kstep; const char* b3 = b2 + kstep;
            if (last && has_next) S.a_ready(nxt);
            if constexpr (SP2) {
            PG8_LDB(B0, 0, 0); PG8_LDB(B1, 0, 1); PG8_SCHED; PG8_LDA(At, 0, 0); PG8_STAGE(PG8_SA(1, 1), a1 + hstep, voffA);
            PG8_WAIT_V(8); PG8_WAIT_L(0); PG8_BAR; PG8_MMA(0, 0, At, B0); PG8_MMA(0, 1, At, B1); PG8_BAR; PG8_SCHED;
            PG8_LDA(At, 0, 1); PG8_STAGE(PG8_SB(0, 0), b2, voffB); PG8_STAGE(PG8_SB(0, 1), b2 + hstep, voffB); PG8_STAGE(PG8_SA(0, 0), a2, voffA);
            PG8_WAIT_V(8); PG8_WAIT_L(0); PG8_BAR; PG8_MMA(1, 0, At, B0); PG8_MMA(1, 1, At, B1); PG8_BAR; PG8_SCHED;
            PG8_LDB(B0, 1, 0); PG8_LDB(B1, 1, 1); PG8_SCHED; PG8_LDA(At, 1, 0); PG8_STAGE(PG8_SA(0, 1), a2 + hstep, voffA);
            PG8_WAIT_V(8); PG8_WAIT_L(0); PG8_BAR; PG8_MMA(0, 0, At, B0); PG8_MMA(0, 1, At, B1); PG8_BAR; PG8_SCHED;
            PG8_LDA(At, 1, 1); PG8_STAGE(PG8_SB(1, 0), b3, voffB); PG8_STAGE(PG8_SB(1, 1), b3 + hstep, voffB); PG8_STAGE(PG8_SA(1, 0), a3, voffA);
            PG8_WAIT_V(8); PG8_WAIT_L(0); PG8_BAR; PG8_MMA(1, 0, At, B0); PG8_MMA(1, 1, At, B1); PG8_BAR; PG8_SCHED;
            } else {
            PG8_LDB(B0, 0, 0); PG8_SCHED; PG8_LDA(At, 0, 0); PG8_STAGE(PG8_SA(1, 1), a1 + hstep, voffA);
            PG8_WAIT_L(8); PG8_BAR; PG8_WAIT_L(0); PG8_MMA(0, 0, At, B0); PG8_BAR; PG8_SCHED;
            PG8_LDB(B1, 0, 1); PG8_STAGE(PG8_SB(0, 0), b2, voffB);
            PG8_BAR; PG8_WAIT_L(0); PG8_MMA(0, 1, At, B1); PG8_BAR;
            PG8_LDA(At, 0, 1); PG8_STAGE(PG8_SA(0, 0), a2, voffA);
            PG8_BAR; PG8_WAIT_L(0); PG8_MMA(1, 0, At, B0); PG8_BAR; PG8_SCHED;
            PG8_STAGE(PG8_SB(0, 1), b2 + hstep, voffB);
            PG8_WAIT_V(6); PG8_BAR; PG8_MMA(1, 1, At, B1); PG8_BAR;
            PG8_LDB(B0, 1, 0); PG8_SCHED; PG8_LDA(At, 1, 0); PG8_STAGE(PG8_SA(0, 1), a2 + hstep, voffA);
            PG8_WAIT_L(8); PG8_BAR; PG8_WAIT_L(0); PG8_MMA(0, 0, At, B0); PG8_BAR; PG8_SCHED;
            PG8_LDB(B1, 1, 1); PG8_STAGE(PG8_SB(1, 0), b3, voffB);
            PG8_BAR; PG8_WAIT_L(0); PG8_MMA(0, 1, At, B1); PG8_BAR;
            PG8_LDA(At, 1, 1); PG8_STAGE(PG8_SA(1, 0), a3, voffA);
            PG8_BAR; PG8_WAIT_L(0); PG8_MMA(1, 0, At, B0); PG8_BAR; PG8_SCHED;
            PG8_STAGE(PG8_SB(1, 1), b3 + hstep, voffB);
            PG8_WAIT_V(6); PG8_BAR; PG8_MMA(1, 1, At, B1); PG8_BAR;
            }
        }
        if constexpr (ALIGN_EPI) { if (wr == 0) PG8_BAR; }
        if constexpr (!Epi::AFTER_DRAIN) { E(acc, cur, wr, wc, fr, fq); S.done(cur); }
        if (!has_next) break;
#pragma unroll
        for (int a = 0; a < 2; ++a)
#pragma unroll
            for (int b = 0; b < 2; ++b)
#pragma unroll
                for (int m = 0; m < 4; ++m)
#pragma unroll
                    for (int n = 0; n < 2; ++n) acc[a][b][m][n] = (f32x4){0.f, 0.f, 0.f, 0.f};
        cur = nxt; cA = nA; cB = nB; ++ui;
        if constexpr (ALIGN_EPI) { if (wr == 1) PG8_BAR; }
    }
    PG8_WAIT_V(0);
    if constexpr (!ALIGN_EPI) { if (wr == 0) PG8_BAR; }
    PG8_BAR;
    if constexpr (Epi::AFTER_DRAIN) { E.fused(acc, cur, wr, wc, fr, fq, lds, wid, lane); S.done(cur); }
#undef PG8_SA
#undef PG8_SB
#undef PG8_STAGE
#undef PG8_LDA
#undef PG8_LDB
#undef PG8_MMA
#undef PG8_WAIT_V
#undef PG8_WAIT_L
#undef PG8_BAR
#undef PG8_SCHED
}
}
#define GAS __attribute__((address_space(1)))
#define LAS __attribute__((address_space(3)))
typedef unsigned short bf16;
typedef unsigned v4u __attribute__((ext_vector_type(4)));
typedef float f32x4 __attribute__((ext_vector_type(4)));
typedef short bf16x8 __attribute__((ext_vector_type(8)));
typedef GAS unsigned gu32;
typedef GAS unsigned long long gu64;
#define RLX_AGENT __ATOMIC_RELAXED, __HIP_MEMORY_SCOPE_AGENT
#define LDS_WAIT() asm volatile("s_waitcnt lgkmcnt(0)" ::: "memory")
#define VM_WAIT() asm volatile("s_waitcnt vmcnt(0)" ::: "memory")
__device__ __forceinline__ unsigned long long rt() { return __builtin_amdgcn_s_memrealtime(); }
__device__ __forceinline__ unsigned f2bf(float f) { unsigned u = __builtin_bit_cast(unsigned, f); return (u + 0x7fffu + ((u >> 16) & 1u)) >> 16; }
__device__ __forceinline__ unsigned pk2(float lo, float hi) { return f2bf(lo) | (f2bf(hi) << 16); }

#define XB_TMO      128
#define XB_XCNT(j)  (256  + 64 * (j))
#define XB_XSUB(j)  (1280 + 64 * (j))
#define XB_XGEN(j)  (2304 + 64 * (j))
#define XB_TOP      3328
#define XB_TOPGEN   3392
#define XCD_BAR_WORDS 3456
#define XB_SPIN_CAP (1u << 18)

__device__ __forceinline__ unsigned xb_ld(unsigned* p)              { return __hip_atomic_load(p, __ATOMIC_RELAXED, __HIP_MEMORY_SCOPE_AGENT); }
__device__ __forceinline__ unsigned xb_add(unsigned* p, unsigned v) { return __hip_atomic_fetch_add(p, v, __ATOMIC_RELAXED, __HIP_MEMORY_SCOPE_AGENT); }
__device__ __forceinline__ unsigned xb_xcc_id() { return (unsigned)__builtin_amdgcn_s_getreg((3 << 11) | 20) & 0xFu; }
#define XB_SPIN(cond, bar) do { unsigned _sp = 0; while (cond) { __builtin_amdgcn_s_sleep(1); \
    if ((++_sp & 255u) == 0u) { if (xb_ld(&(bar)[XB_TMO])) break; if (_sp > XB_SPIN_CAP) { atomicAdd(&(bar)[XB_TMO], 1u); break; } } } } while (0)

struct XcdBarrier {
    unsigned* bar; unsigned x;
    volatile LAS unsigned* st;
};

__device__ __forceinline__ XcdBarrier xcd_barrier_post(unsigned* bar, volatile LAS unsigned* st) {
    XcdBarrier b; b.bar = bar; b.x = xb_xcc_id(); b.st = st;
    if (threadIdx.x == 0) (void)xb_add(&bar[XB_XCNT(b.x)], 1u);
    return b;
}
__device__ __forceinline__ void xcd_barrier_complete(unsigned* bar, unsigned x, unsigned& nloc, unsigned& nx) {
    const unsigned G = gridDim.x * gridDim.y * gridDim.z;
    unsigned sum, cnt, mine, sp = 0u;
    for (;;) {
        sum = 0u; cnt = 0u; mine = 0u;
#pragma unroll
        for (unsigned j = 0; j < 16; ++j) { const unsigned c = xb_ld(&bar[XB_XCNT(j)]); sum += c; cnt += (c > 0u) ? 1u : 0u; mine = (j == x) ? c : mine; }
        if (sum == G) break;
        __builtin_amdgcn_s_sleep(1);
        if ((++sp & 255u) == 0u) { if (xb_ld(&bar[XB_TMO])) break; if (sp > XB_SPIN_CAP) { atomicAdd(&bar[XB_TMO], 1u); break; } }
    }
    nloc = mine > 0u ? mine : 1u; nx = cnt > 0u ? cnt : 1u;
}

__device__ __forceinline__ void xcd_barrier(const XcdBarrier& b) {
    asm volatile("s_waitcnt vmcnt(0)" ::: "memory");
    __syncthreads();
    if (threadIdx.x == 0) {
        unsigned* bar = b.bar;
        __builtin_amdgcn_s_waitcnt(0);
        unsigned nloc = b.st[0], nx = b.st[1];
        if (nloc == 0u) { xcd_barrier_complete(bar, b.x, nloc, nx); b.st[0] = nloc; b.st[1] = nx; }
        const unsigned old = xb_add(&bar[XB_XSUB(b.x)], 1u);
        const unsigned gen = old / nloc;
        if (old + 1u == (gen + 1u) * nloc) {
            __builtin_amdgcn_fence(__ATOMIC_RELEASE, "agent");
            asm volatile("s_waitcnt vmcnt(0)" ::: "memory");
            const unsigned og = xb_add(&bar[XB_TOP], 1u);
            const unsigned tg = og / nx;
            if (og + 1u == (tg + 1u) * nx) xb_add(&bar[XB_TOPGEN], 1u);
            else XB_SPIN(xb_ld(&bar[XB_TOPGEN]) == tg, bar);
            __builtin_amdgcn_fence(__ATOMIC_ACQUIRE, "agent");
            xb_add(&bar[XB_XGEN(b.x)], 1u);
            asm volatile("s_waitcnt vmcnt(0)" ::: "memory");
        } else {
            XB_SPIN(xb_ld(&bar[XB_XGEN(b.x)]) == gen, bar);
            __builtin_amdgcn_fence(__ATOMIC_ACQUIRE, "agent");
            asm volatile("s_waitcnt vmcnt(0)" ::: "memory");
        }
    }
    __syncthreads();
}
constexpr int NWAVES = 8;
constexpr int D = 2048, NB = 2, SEQ = 4096, T = NB * SEQ;
constexpr int SG = 128, SP = 64, SC = 16;
constexpr int NH = 16, HD = 128, NKV = 4, NGRP = 3;
constexpr int FF = 5632;
constexpr int NQ = NGRP * NH * HD, NKVC = NKV * HD;
constexpr int NQKV = NQ + 2 * NKVC;
constexpr float EPS = 1e-6f;
constexpr float QSCALE = 0.08838834764831845f * 1.4426950408889634f;

constexpr size_t MiB = 1u << 20;
constexpr size_t WS_CTL = 0, CTL_ZERO_BYTES = 1 * MiB;
constexpr size_t WS_RSTD0 = 1 * MiB;
constexpr size_t WS_WGLU = 2 * MiB, WS_WIN0 = 18 * MiB, WS_WOUT0 = 62 * MiB, WS_WQKV = 84 * MiB, WS_WO = 112 * MiB, WS_WIN1 = 120 * MiB, WS_WOUT1 = 164 * MiB;
constexpr size_t WS_XA = 186 * MiB;
constexpr size_t WS_XB = 250 * MiB;
constexpr size_t WS_ZO = 282 * MiB;
constexpr size_t WS_HQ = 314 * MiB;
constexpr size_t WS_K = 410 * MiB, WS_V = 418 * MiB;
constexpr size_t WS_OG = 426 * MiB;
constexpr size_t WS_LSE = 522 * MiB;
constexpr size_t WS_END = 524 * MiB;
constexpr int CW_TMO = 0, CW_CODE = 1, CW_BAR = 4096;
constexpr int CW_ROWSQ = 16384;
static_assert((CW_ROWSQ + 4 * T) * 4 <= (int)CTL_ZERO_BYTES, "ctl");

constexpr int RING_OFF = 0, RING_BYTES = 131072;
constexpr int LDSCTL_OFF = 155648, MISC_OFF = LDSCTL_OFF + 320;
constexpr int LDS_BYTES = 163840;

struct Frame {
    LAS unsigned char* lds;
    volatile LAS unsigned* MISC;
    gu32* ctl;
    int tid, lane, wave;
    int vcu, G;
};

__device__ __forceinline__ float wave_sum(float v) {
#pragma unroll
    for (int o = 1; o < 64; o <<= 1) v += __shfl_xor(v, o);
    return v;
}
__device__ __forceinline__ float wave_max(float v) {
#pragma unroll
    for (int o = 1; o < 64; o <<= 1) v = fmaxf(v, __shfl_xor(v, o));
    return v;
}
__device__ __forceinline__ void p0_transpose_item(const float* W, int K, int N, const float* gain, bf16* WT, int Nh, int row_off, LAS float* scr, int item, int lane) {
    const int nblk = N / 32, kb = item / nblk, nb = item % nblk, k0 = 64 * kb, n0 = 32 * nb;
#pragma unroll 8
    for (int i = 0; i < 32; ++i) { const int kk = 2 * i + (lane >> 5); float v = W[(size_t)(k0 + kk) * N + n0 + (lane & 31)]; if (gain) v *= gain[k0 + kk]; scr[kk * 33 + (lane & 31)] = v; }
    LDS_WAIT(); asm volatile("" ::: "memory");
    const int c = lane & 7;
    int drow0 = row_off + n0;
    if (Nh) { const int nn = n0 % Nh; drow0 = 256 * (nn / 128) + 128 * (n0 / Nh) + (nn % 128); }
#pragma unroll
    for (int j = 0; j < 4; ++j) { const int n = (lane >> 3) + 8 * j; const LAS float* s = scr + (8 * c) * 33 + n;
        v4u o; o.x = pk2(s[0 * 33], s[1 * 33]); o.y = pk2(s[2 * 33], s[3 * 33]); o.z = pk2(s[4 * 33], s[5 * 33]); o.w = pk2(s[6 * 33], s[7 * 33]);
        *(GAS v4u*)(WT + (size_t)(drow0 + n) * K + k0 + 8 * c) = o; }
    LDS_WAIT(); asm volatile("" ::: "memory");
}

namespace s5 {
typedef float f32x16 __attribute__((ext_vector_type(16)));
constexpr int L = 8, NCH = 32, BLK = 256, NBLK = SEQ / BLK;
constexpr int O_PW = 0;
constexpr int O_A256 = 4608;
constexpr int O_KT = 5120;
constexpr int O_ET = O_KT + 4608;
constexpr int O_FT = O_ET + 32768;
constexpr int O_EB = O_FT + 32768;
constexpr int O_XT = O_EB + 8192;
constexpr int XT_ROW = 272, XT_WAVE = 32 * XT_ROW;
constexpr int O_BB = O_XT;
constexpr int O_CC = O_XT + 8192;
constexpr int O_KP = O_XT + 16384;
constexpr int LDS_END = O_XT + 8 * XT_WAVE;
static_assert(O_KP + 16384 <= LDS_END, "s5 lds");

__device__ __forceinline__ float dpp_x1(float v) { return __builtin_bit_cast(float, __builtin_amdgcn_mov_dpp(__builtin_bit_cast(int, v), 0xB1, 0xF, 0xF, true)); }
__device__ __forceinline__ float gelu_t(float y) {
    const float inner = y * (1.0f + 0.044715f * y * y);
    return y * __builtin_amdgcn_rcpf(1.0f + __builtin_amdgcn_exp2f(-2.3022081981f * inner));
}
__device__ __forceinline__ void disc(const float* lam_re, const float* lam_im, const float* log_dt, int g, int p, float& lbr, float& lbi, float& fr, float& fi) {
    const float lr = lam_re[g * SP + p], li = lam_im[g * SP + p], dt = expf(log_dt[g]);
    const float mag = expf(lr * dt), ang = li * dt;
    lbr = mag * cosf(ang); lbi = mag * sinf(ang);
    const float nr = lbr - 1.f, den = lr * lr + li * li;
    fr = (nr * lr + lbi * li) / den; fi = (lbi * lr - nr * li) / den;
}

struct Params { const float *x, *rstd0, *gn, *lam_re, *lam_im, *log_dt, *b_re, *b_im, *c_re, *c_im, *dsk; bf16* z; };

__device__ __forceinline__ void load_ufrag(bf16x8 (&uf)[8], const Params& P, size_t tok0  , int g, int n, int h, const float (&gnr)[8]) {
    const float* xp = P.x + (tok0 + 8 * n) * D + g * SC + 8 * h;
    const f32x4 r0 = *(const f32x4*)(P.rstd0 + tok0 + 8 * n), r1 = *(const f32x4*)(P.rstd0 + tok0 + 8 * n + 4);
    const float rs[8] = {r0[0], r0[1], r0[2], r0[3], r1[0], r1[1], r1[2], r1[3]};
#pragma unroll
    for (int s = 0; s < 8; ++s) {
        const f32x4 a = *(const f32x4*)(xp + (size_t)s * D), c = *(const f32x4*)(xp + (size_t)s * D + 4);
        v4u w;
        w.x = pg8::cvt_pk_bf16(a[0] * rs[s] * gnr[0], a[1] * rs[s] * gnr[1]); w.y = pg8::cvt_pk_bf16(a[2] * rs[s] * gnr[2], a[3] * rs[s] * gnr[3]);
        w.z = pg8::cvt_pk_bf16(c[0] * rs[s] * gnr[4], c[1] * rs[s] * gnr[5]); w.w = pg8::cvt_pk_bf16(c[2] * rs[s] * gnr[6], c[3] * rs[s] * gnr[7]);
        uf[s] = __builtin_bit_cast(bf16x8, w);
    }
}
__device__ __forceinline__ f32x16 stage_a(int cb, const bf16x8 (&uf)[8], const LAS unsigned char* lds, int lane) {
    f32x16 acc = (f32x16){0.f, 0.f, 0.f, 0.f, 0.f, 0.f, 0.f, 0.f, 0.f, 0.f, 0.f, 0.f, 0.f, 0.f, 0.f, 0.f};
#pragma unroll
    for (int s = 0; s < 8; ++s) {
        const bf16x8 e = *(const LAS bf16x8*)(lds + O_ET + ((s * 4 + cb) * 32 + (lane & 31)) * 32 + (lane >> 5) * 16);
        acc = __builtin_amdgcn_mfma_f32_32x32x16_bf16(uf[s], e, acc, 0, 0, 0);
    }
    return acc;
}

__device__ __forceinline__ void item(const Params& P, LAS unsigned char* lds, int b, int g, int tid, int wave, int lane) {
    const int rl = lane & 31, h = lane >> 5;
    __syncthreads();
    if (tid < SP) {
        float lbr, lbi, fr, fi; disc(P.lam_re, P.lam_im, P.log_dt, g, tid, lbr, lbi, fr, fi);
        LAS float* pw = (LAS float*)(lds + O_PW);
        float pr = 1.f, pi = 0.f;
#pragma unroll
        for (int m = 0; m <= 8; ++m) { pw[(m * SP + tid) * 2] = pr; pw[(m * SP + tid) * 2 + 1] = pi; const float nr = pr * lbr - pi * lbi, ni = pr * lbi + pi * lbr; pr = nr; pi = ni; }
        float ar = pw[(8 * SP + tid) * 2], ai = pw[(8 * SP + tid) * 2 + 1];
#pragma unroll
        for (int k = 0; k < 5; ++k) { const float nr = ar * ar - ai * ai, ni = 2.f * ar * ai; ar = nr; ai = ni; }
        LAS float* a256 = (LAS float*)(lds + O_A256); a256[tid * 2] = ar; a256[tid * 2 + 1] = ai;
    }
    {
        LAS float* BB = (LAS float*)(lds + O_BB); LAS float* CC = (LAS float*)(lds + O_CC);
#pragma unroll
        for (int k = 0; k < 2; ++k) {
            const int idx = tid + 512 * k, p = idx >> 4, ci = idx & 15;
            float lbr, lbi, fr, fi; disc(P.lam_re, P.lam_im, P.log_dt, g, p, lbr, lbi, fr, fi);
            const float br = P.b_re[(g * SP + p) * SC + ci], bi = P.b_im[(g * SP + p) * SC + ci];
            BB[idx * 2] = fr * br - fi * bi; BB[idx * 2 + 1] = fr * bi + fi * br;
            CC[idx * 2] = P.c_re[(size_t)g * SC * SP + idx]; CC[idx * 2 + 1] = P.c_im[(size_t)g * SC * SP + idx];
        }
    }
    __syncthreads();
    {
        const LAS float* pw = (const LAS float*)(lds + O_PW); const LAS float* BB = (const LAS float*)(lds + O_BB); const LAS float* CC = (const LAS float*)(lds + O_CC);
        {
            const int ph = tid >> 8, co = (tid >> 4) & 15, ci = tid & 15;
            float kd[8];
#pragma unroll
            for (int d = 0; d < 8; ++d) kd[d] = 0.f;
            for (int pp = 0; pp < 32; ++pp) {
                const int p = ph * 32 + pp;
                const float cr = CC[(co * SP + p) * 2], cim = CC[(co * SP + p) * 2 + 1], lbr = pw[(SP + p) * 2], lbi = pw[(SP + p) * 2 + 1];
                float wr = BB[(p * SC + ci) * 2], wi = BB[(p * SC + ci) * 2 + 1];
#pragma unroll
                for (int d = 0; d < 8; ++d) { kd[d] += cr * wr - cim * wi; const float nr = wr * lbr - wi * lbi, ni = wr * lbi + wi * lbr; wr = nr; wi = ni; }
            }
            LAS float* KP = (LAS float*)(lds + O_KP);
#pragma unroll
            for (int d = 0; d < 8; ++d) KP[(ph * 8 + d) * 256 + co * 16 + ci] = kd[d];
        }
        {
#pragma unroll
            for (int k = 0; k < 2; ++k) {
                const int pair = tid + 512 * k, s = pair >> 7, rho = pair & 127, p = rho >> 1, part = rho & 1;
                const float qr = pw[((7 - s) * SP + p) * 2], qi = pw[((7 - s) * SP + p) * 2 + 1];
                float v[16];
#pragma unroll
                for (int ci = 0; ci < 16; ++ci) { const float br = BB[(p * SC + ci) * 2], bi = BB[(p * SC + ci) * 2 + 1]; v[ci] = part ? (qr * bi + qi * br) : (qr * br - qi * bi); }
                LAS v4u* dst = (LAS v4u*)(lds + O_ET + (s * 128 + rho) * 32);
                v4u w0, w1;
                w0.x = pg8::cvt_pk_bf16(v[0], v[1]); w0.y = pg8::cvt_pk_bf16(v[2], v[3]); w0.z = pg8::cvt_pk_bf16(v[4], v[5]); w0.w = pg8::cvt_pk_bf16(v[6], v[7]);
                w1.x = pg8::cvt_pk_bf16(v[8], v[9]); w1.y = pg8::cvt_pk_bf16(v[10], v[11]); w1.z = pg8::cvt_pk_bf16(v[12], v[13]); w1.w = pg8::cvt_pk_bf16(v[14], v[15]);
                dst[0] = w0; dst[1] = w1;
            }
        }
        {
#pragma unroll
            for (int k = 0; k < 4; ++k) {
                const int tup = tid + 512 * k, hh = tup & 1, r = (tup >> 1) & 31, i = (tup >> 6) & 3, ks = tup >> 8;
                const int t = 2 * i + (r >> 4), co = r & 15;
                float v[8];
#pragma unroll
                for (int jj = 0; jj < 4; ++jj) {
                    const int p = 8 * ks + 4 * hh + jj;
                    const float cr = CC[(co * SP + p) * 2], cim = CC[(co * SP + p) * 2 + 1], qr = pw[((t + 1) * SP + p) * 2], qi = pw[((t + 1) * SP + p) * 2 + 1];
                    v[2 * jj] = cr * qr - cim * qi; v[2 * jj + 1] = -(cr * qi + cim * qr);
                }
                v4u w; w.x = pg8::cvt_pk_bf16(v[0], v[1]); w.y = pg8::cvt_pk_bf16(v[2], v[3]); w.z = pg8::cvt_pk_bf16(v[4], v[5]); w.w = pg8::cvt_pk_bf16(v[6], v[7]);
                *(LAS v4u*)(lds + O_FT + tup * 16) = w;
            }
        }
    }
    __syncthreads();
    {
        const LAS float* KP = (const LAS float*)(lds + O_KP);
        LAS unsigned short* KT = (LAS unsigned short*)(lds + O_KT);
#pragma unroll
        for (int k = 0; k < 4; ++k) { const int idx = tid + 512 * k; KT[256 + idx] = (unsigned short)f2bf(KP[idx] + KP[2048 + idx]); }
        if (tid < 256) KT[tid] = 0;
    }
    float c1[4], c2[4], d1[4], d2[4];
    {
        const LAS float* pw = (const LAS float*)(lds + O_PW); const LAS float* a256 = (const LAS float*)(lds + O_A256);
#pragma unroll
        for (int cb = 0; cb < 4; ++cb) { const int p = 16 * cb + (rl >> 1); const float ar = pw[(8 * SP + p) * 2], ai = pw[(8 * SP + p) * 2 + 1], br = a256[p * 2], bi = a256[p * 2 + 1];
            c1[cb] = ar; c2[cb] = (rl & 1) ? ai : -ai; d1[cb] = br; d2[cb] = (rl & 1) ? bi : -bi; }
    }
    float gnr[8];
#pragma unroll
    for (int j = 0; j < 8; ++j) gnr[j] = P.gn[g * SC + 8 * h + j];
    __syncthreads();
#pragma unroll 1
    for (int pass = 0; pass < 2; ++pass) {
        const int blk = wave + 8 * pass;
        bf16x8 uf[8]; load_ufrag(uf, P, (size_t)b * SEQ + (size_t)blk * BLK, g, rl, h, gnr);
#pragma unroll
        for (int cb = 0; cb < 4; ++cb) {
            const f32x16 acc = stage_a(cb, uf, lds, lane);
            float c = 0.f;
#pragma unroll
            for (int g4 = 0; g4 < 8; ++g4) {
                float cc = c;
#pragma unroll
                for (int r4 = 0; r4 < 4; ++r4) cc = c1[cb] * cc + (c2[cb] * dpp_x1(cc) + acc[4 * (g4 >> 1) + r4]);
                const float oth = __shfl_xor(cc, 32);
                c = (h == (g4 & 1)) ? cc : oth;
            }
            if (h == 0) ((LAS float*)(lds + O_EB))[blk * 128 + 32 * cb + rl] = c;
        }
    }
    __syncthreads();
    float cin[4] = {0.f, 0.f, 0.f, 0.f};
    LAS unsigned char* xt = lds + O_XT + wave * XT_WAVE;
#pragma unroll 1
    for (int pass = 0; pass < 2; ++pass) {
        const int blk = wave + 8 * pass;
        {
            const int b0 = pass ? wave : 0;
            for (int bb = b0; bb < blk; ++bb) {
#pragma unroll
                for (int cb = 0; cb < 4; ++cb) cin[cb] = d1[cb] * cin[cb] + (d2[cb] * dpp_x1(cin[cb]) + ((const LAS float*)(lds + O_EB))[bb * 128 + 32 * cb + rl]);
            }
        }
        const size_t tok0 = (size_t)b * SEQ + (size_t)blk * BLK;
        bf16x8 uf[8]; load_ufrag(uf, P, tok0, g, rl, h, gnr);
#pragma unroll
        for (int cb = 0; cb < 4; ++cb) {
            f32x16 acc = stage_a(cb, uf, lds, lane);
            float c = cin[cb];
#pragma unroll
            for (int g4 = 0; g4 < 8; ++g4) {
                float cc = c;
#pragma unroll
                for (int r4 = 0; r4 < 4; ++r4) { const int q = 4 * (g4 >> 1) + r4; const float sv = acc[q]; if (h == (g4 & 1)) acc[q] = cc; cc = c1[cb] * cc + (c2[cb] * dpp_x1(cc) + sv); }
                const float oth = __shfl_xor(cc, 32);
                c = (h == (g4 & 1)) ? cc : oth;
            }
#pragma unroll
            for (int q = 0; q < 16; ++q) { const int n = (q & 3) + 8 * (q >> 2) + 4 * h; *(LAS unsigned short*)(xt + n * XT_ROW + (32 * cb + rl) * 2) = (unsigned short)f2bf(acc[q]); }
        }
        LDS_WAIT(); asm volatile("" ::: "memory");
        bf16x8 xf[8];
#pragma unroll
        for (int ks = 0; ks < 8; ++ks) xf[ks] = *(const LAS bf16x8*)(xt + rl * XT_ROW + ks * 32 + h * 16);
#pragma unroll 1
        for (int i = 0; i < 4; ++i) {
            f32x16 y = (f32x16){0.f, 0.f, 0.f, 0.f, 0.f, 0.f, 0.f, 0.f, 0.f, 0.f, 0.f, 0.f, 0.f, 0.f, 0.f, 0.f};
#pragma unroll
            for (int s = 0; s < 8; ++s) {
                if (s < 2 * i + 2) {
                    const int j0 = 2 * i - s + 1;
                    const bf16x8 ph = *(const LAS bf16x8*)(lds + O_KT + ((j0 + (rl >> 4)) * 16 + (rl & 15)) * 32 + h * 16);
                    y = __builtin_amdgcn_mfma_f32_32x32x16_bf16(ph, uf[s], y, 0, 0, 0);
                }
            }
#pragma unroll
            for (int ks = 0; ks < 8; ++ks) {
                const bf16x8 ff = *(const LAS bf16x8*)(lds + O_FT + (((ks * 4 + i) * 32 + rl) * 2 + h) * 16);
                y = __builtin_amdgcn_mfma_f32_32x32x16_bf16(ff, xf[ks], y, 0, 0, 0);
            }
#pragma unroll
            for (int ts = 0; ts < 2; ++ts) {
                const size_t tok = tok0 + 8 * rl + 2 * i + ts;
                const float rs = P.rstd0[tok];
#pragma unroll
                for (int h8 = 0; h8 < 2; ++h8) {
                    const int c0 = 8 * h8 + 4 * h;
                    const f32x4 xv = *(const f32x4*)(P.x + tok * D + g * SC + c0), gv = *(const f32x4*)(P.gn + g * SC + c0), dv = *(const f32x4*)(P.dsk + g * SC + c0);
                    float o[4];
#pragma unroll
                    for (int e = 0; e < 4; ++e) o[e] = gelu_t(y[8 * ts + 4 * h8 + e] + dv[e] * (xv[e] * rs * gv[e]));
                    uint2 w; w.x = pg8::cvt_pk_bf16(o[0], o[1]); w.y = pg8::cvt_pk_bf16(o[2], o[3]);
                    *(uint2*)(P.z + tok * D + g * SC + c0) = w;
                }
            }
        }
        LDS_WAIT(); asm volatile("" ::: "memory");
    }
}
}
__device__ __forceinline__ float bf2f(bf16 v) { return __builtin_bit_cast(float, (unsigned)v << 16); }
__device__ __forceinline__ float gelu_tanh(float y) {
    const float k0 = 0.7978845608028654f, k1 = 0.044715f;
    return 0.5f * y * (1.f + tanhf(k0 * (y + k1 * y * y * y)));
}
__device__ __forceinline__ void s5_simple_item(int bg, int p, const float* __restrict__ x, const float* __restrict__ rstd, const float* __restrict__ gn,
        const float* __restrict__ lam_re, const float* __restrict__ lam_im, const float* __restrict__ log_dt,
        const float* __restrict__ b_re, const float* __restrict__ b_im, const float* __restrict__ c_re, const float* __restrict__ c_im,
        const float* __restrict__ d_skip, bf16* __restrict__ z) {
    constexpr int G = SG, P = SP, C = SC, S = SEQ;
    const int b = bg / G, g = bg % G;
    const float lr = lam_re[g * P + p], li = lam_im[g * P + p];
    const float dt = expf(log_dt[g]);
    const float mag = expf(lr * dt), ang = li * dt;
    const float lbr = mag * cosf(ang), lbi = mag * sinf(ang);
    const float nr = lbr - 1.f, den = lr * lr + li * li;
    const float fr = (nr * lr + lbi * li) / den, fi = (lbi * lr - nr * li) / den;
    float bbr[C], bbi[C], cr[C], ci[C];
#pragma unroll
    for (int c = 0; c < C; ++c) {
        const float br = b_re[(g * P + p) * C + c], bi = b_im[(g * P + p) * C + c];
        bbr[c] = fr * br - fi * bi; bbi[c] = fr * bi + fi * br;
        cr[c] = c_re[(g * C + c) * P + p]; ci[c] = c_im[(g * C + c) * P + p];
    }
    const int pc = p & 15;
    const float gnp = gn[g * C + pc], dp = d_skip[g * C + pc];
    float gnc[C];
#pragma unroll
    for (int c = 0; c < C; ++c) gnc[c] = gn[g * C + c];
    float xr = 0.f, xi = 0.f;
    for (int t = 0; t < S; ++t) {
        const size_t row = (size_t)b * S + t;
        const float* xp = x + row * D + g * C;
        const float r = rstd[row];
        float bur = 0.f, bui = 0.f;
#pragma unroll
        for (int c = 0; c < C; ++c) { const float u = xp[c] * r * gnc[c]; bur += bbr[c] * u; bui += bbi[c] * u; }
        const float nxr = lbr * xr - lbi * xi + bur, nxi = lbr * xi + lbi * xr + bui;
        xr = nxr; xi = nxi;
        float myy = 0.f;
#pragma unroll
        for (int c = 0; c < C; ++c) { float v = cr[c] * xr - ci[c] * xi; v = wave_sum(v); if (p == c) myy = v; }
        if (p < C) { const float up = xp[pc] * r * gnp; z[row * D + g * C + p] = (bf16)f2bf(gelu_tanh(myy + dp * up)); }
    }
}
__device__ __forceinline__ void attn_simple_item(int idx, int lane, LAS float* qs, const bf16* __restrict__ q, const bf16* __restrict__ kk, const bf16* __restrict__ vv, bf16* __restrict__ o) {
    const int row = idx / NH, h = idx % NH, b = row / SEQ, t = row % SEQ, kvh = h / (NH / NKV);
    float og[NGRP][2], lse[NGRP];
#pragma unroll
    for (int g = 0; g < NGRP; ++g) {
        const int dil = (g == 0) ? 1 : (g == 1 ? 4 : 16);
        const bf16* qp = q + (size_t)row * NQ + g * (NH * HD) + h * HD;
        LDS_WAIT(); asm volatile("" ::: "memory");
        qs[lane] = bf2f(qp[lane]); qs[lane + 64] = bf2f(qp[lane + 64]);
        LDS_WAIT(); asm volatile("" ::: "memory");
        float sc[3];
#pragma unroll
        for (int pass = 0; pass < 3; ++pass) {
            const int j = pass * 64 + lane;
            const int tk = t - j * dil;
            float s = -1e30f;
            if (j <= 128 && tk >= 0) {
                const bf16* kp = kk + (size_t)(b * SEQ + tk) * NKVC + kvh * HD;
                float a = 0.f;
#pragma unroll 8
                for (int e = 0; e < HD; ++e) a += qs[e] * bf2f(kp[e]);
                s = a;
            }
            sc[pass] = s;
        }
        const float m = wave_max(fmaxf(fmaxf(sc[0], sc[1]), sc[2]));
        float pr[3]; float l = 0.f;
#pragma unroll
        for (int pass = 0; pass < 3; ++pass) { pr[pass] = (sc[pass] > -1e29f) ? exp2f(sc[pass] - m) : 0.f; l += pr[pass]; }
        l = wave_sum(l);
        lse[g] = m + log2f(l);
        float a0 = 0.f, a1 = 0.f;
#pragma unroll
        for (int pass = 0; pass < 3; ++pass) {
            const int jn = (pass < 2) ? 64 : 1;
            for (int jj = 0; jj < jn; ++jj) {
                const float pj = __shfl(pr[pass], jj);
                const int j = pass * 64 + jj; const int tk = t - j * dil;
                if (tk >= 0) {
                    const bf16* vp = vv + (size_t)(b * SEQ + tk) * NKVC + kvh * HD;
                    a0 += pj * bf2f(vp[lane]); a1 += pj * bf2f(vp[lane + 64]);
                }
            }
        }
        og[g][0] = a0 / l; og[g][1] = a1 / l;
    }
    const float mx = fmaxf(fmaxf(lse[0], lse[1]), lse[2]);
    const float w0 = exp2f(lse[0] - mx), w1 = exp2f(lse[1] - mx), w2 = exp2f(lse[2] - mx), wsum = w0 + w1 + w2;
    bf16* op = o + (size_t)row * D + h * HD;
    op[lane] = (bf16)f2bf((w0 * og[0][0] + w1 * og[1][0] + w2 * og[2][0]) / wsum);
    op[lane + 64] = (bf16)f2bf((w0 * og[0][1] + w1 * og[1][1] + w2 * og[2][1]) / wsum);
}

struct Args { const float* in[20]; float* out; unsigned char* ws; int ph_lo, ph_hi; };

__global__ void __launch_bounds__(NWAVES * 64, 2) mk_fwd(Args args) {
    extern __shared__ __attribute__((aligned(16))) unsigned char lds[];
    Frame F;
    F.lds = (LAS unsigned char*)lds;
    F.MISC = (volatile LAS unsigned*)(F.lds + MISC_OFF);
    F.tid = threadIdx.x; F.lane = F.tid & 63; F.wave = __builtin_amdgcn_readfirstlane(F.tid >> 6);
    F.G = gridDim.x; { const int bx = blockIdx.x; F.vcu = (F.G % 8 == 0) ? (bx % 8) * (F.G / 8) + bx / 8 : bx; }
    unsigned char* ws = args.ws;
    F.ctl = (gu32*)(ws + WS_CTL);
    const float* x = args.in[0];
    bf16* WgluT = (bf16*)(ws + WS_WGLU); bf16* Win0T = (bf16*)(ws + WS_WIN0); bf16* Wout0T = (bf16*)(ws + WS_WOUT0); bf16* WqkvT = (bf16*)(ws + WS_WQKV);
    bf16* WoT = (bf16*)(ws + WS_WO); bf16* Win1T = (bf16*)(ws + WS_WIN1); bf16* Wout1T = (bf16*)(ws + WS_WOUT1);
    float* XA = (float*)(ws + WS_XA); bf16* XB = (bf16*)(ws + WS_XB); bf16* ZO = (bf16*)(ws + WS_ZO); bf16* HQ = (bf16*)(ws + WS_HQ);
    bf16* KB = (bf16*)(ws + WS_K); bf16* VB = (bf16*)(ws + WS_V);
    float* rstd0 = (float*)(ws + WS_RSTD0);
    float* rowsq = (float*)(ws + WS_CTL) + CW_ROWSQ;
    for (int u = F.tid; u < (LDS_BYTES - LDSCTL_OFF) / 4; u += NWAVES * 64) ((LAS unsigned*)(F.lds + LDSCTL_OFF))[u] = 0u;
    __syncthreads();
    XcdBarrier bar = xcd_barrier_post((unsigned*)(F.ctl + CW_BAR), F.MISC + 8);
    const int lo = args.ph_lo, hi = args.ph_hi;
#define IN(k) (lo <= (k) && (k) < hi)
#define BOTH(k) (IN(k) && IN((k) + 1))
#define GRID_BAR() xcd_barrier(bar)

    if (IN(0)) {
        LAS float* scr = (LAS float*)(F.lds + RING_OFF + F.wave * 16384);
        const int gw = F.vcu * NWAVES + F.wave, NGW = F.G * NWAVES;
        constexpr int I0 = (D / 64) * (2 * D / 32), I1 = (D / 64) * (2 * FF / 32), I2 = (FF / 64) * (D / 32), I3 = (D / 64) * (NQ / 32), I4 = (D / 64) * (2 * NKVC / 32), I5 = (D / 64) * (D / 32);
        constexpr int NITEMS = I0 + 2 * I1 + 2 * I2 + I3 + I4 + I5;
        for (int it = gw; it < NITEMS; it += NGW) {
            int r = it;
            if (r < I0) { p0_transpose_item(args.in[9], D, 2 * D, nullptr, WgluT, D, 0, scr, r, F.lane); continue; } r -= I0;
            if (r < I1) { p0_transpose_item(args.in[12], D, 2 * FF, args.in[11], Win0T, FF, 0, scr, r, F.lane); continue; } r -= I1;
            if (r < I2) { p0_transpose_item(args.in[13], FF, D, nullptr, Wout0T, 0, 0, scr, r, F.lane); continue; } r -= I2;
            if (r < I3) { p0_transpose_item(args.in[15], D, NQ, args.in[14], WqkvT, 0, 0, scr, r, F.lane); continue; } r -= I3;
            if (r < I4) { p0_transpose_item(args.in[18], D, 2 * NKVC, args.in[17], WqkvT, 0, NQ, scr, r, F.lane); continue; } r -= I4;
            if (r < I5) { p0_transpose_item(args.in[16], D, D, nullptr, WoT, 0, 0, scr, r, F.lane); continue; } r -= I5;
            if (r < I1) { p0_transpose_item(args.in[12] + (size_t)D * 2 * FF, D, 2 * FF, args.in[11] + D, Win1T, FF, 0, scr, r, F.lane); continue; } r -= I1;
            p0_transpose_item(args.in[13] + (size_t)FF * D, FF, D, nullptr, Wout1T, 0, 0, scr, r, F.lane);
        }
        for (int m = gw; m < T; m += NGW) {
            const GAS f32x4* xr = (const GAS f32x4*)(x + (size_t)m * D) + F.lane; float s = 0.f;
#pragma unroll
            for (int j = 0; j < D / 256; ++j) { const f32x4 v = xr[64 * j]; s += (v.x * v.x + v.y * v.y) + (v.z * v.z + v.w * v.w); }
            s = wave_sum(s);
            if (F.lane == 0) rstd0[m] = 1.0f / sqrtf(s * (1.0f / D) + EPS);
        }
        if (BOTH(0)) GRID_BAR();
    }
    if (IN(1)) {
        static_assert(s5::LDS_END <= LDSCTL_OFF, "s5 LDS map");
        const s5::Params SPm{x, rstd0, args.in[10], args.in[1], args.in[2], args.in[3], args.in[4], args.in[5], args.in[6], args.in[7], args.in[8], ZO};
        for (int it = F.vcu; it < NB * SG; it += F.G) s5::item(SPm, F.lds, it / SG, it % SG, F.tid, F.wave, F.lane);
        if (BOTH(1)) GRID_BAR();
    }
    if (IN(2)) {
        pg8::Gemm g{ZO, WgluT, T, 2 * D, D}; pg8::StaticOrder S; S.init(T, 2 * D, F.G, (int)blockIdx.x);
        pg8::EpiGluRes E{x, XA, XB, rowsq};
        pg8::gemm_phase<pg8::EpiGluRes, pg8::StaticOrder, true, true>(F.lds + RING_OFF, g, S, E);
        if (BOTH(2)) GRID_BAR();
    }
    if (IN(3)) {
        pg8::Gemm g{XB, Win0T, T, 2 * FF, D}; pg8::StaticOrder S; S.init(T, 2 * FF, F.G, (int)blockIdx.x);
        pg8::EpiSwiGlu E{rowsq, HQ, FF};
        pg8::gemm_phase<pg8::EpiSwiGlu, pg8::StaticOrder, true, true>(F.lds + RING_OFF, g, S, E);
        if (BOTH(3)) GRID_BAR();
    }
    if (IN(4)) {
        pg8::Gemm g{HQ, Wout0T, T, D, FF}; pg8::StaticOrder S; S.init(T, D, F.G, (int)blockIdx.x);
        pg8::EpiRes<true> E{XA, XB, rowsq + T};
        pg8::gemm_phase<pg8::EpiRes<true>, pg8::StaticOrder, true, true>(F.lds + RING_OFF, g, S, E);
        if (BOTH(4)) GRID_BAR();
    }
    if (IN(5)) {
        pg8::Gemm g{XB, WqkvT, T, NQKV, D}; pg8::StaticOrder S; S.init(T, NQKV, F.G, (int)blockIdx.x);
        pg8::EpiQKV E{rowsq + T, HQ, KB, VB, QSCALE};
        pg8::gemm_phase<pg8::EpiQKV, pg8::StaticOrder, true, true>(F.lds + RING_OFF, g, S, E);
        if (BOTH(5)) GRID_BAR();
    }
    if (IN(6)) {
        LAS float* qs = (LAS float*)(F.lds + RING_OFF + F.wave * 1024);
        const int gw = F.vcu * NWAVES + F.wave, NGW = F.G * NWAVES;
        for (int idx = gw; idx < T * NH; idx += NGW) attn_simple_item(idx, F.lane, qs, HQ, KB, VB, ZO);
        if (BOTH(6)) GRID_BAR();
    }
    if (IN(7)) {
        pg8::Gemm g{ZO, WoT, T, D, D}; pg8::StaticOrder S; S.init(T, D, F.G, (int)blockIdx.x);
        pg8::EpiRes<true> E{XA, XB, rowsq + 2 * T};
        pg8::gemm_phase<pg8::EpiRes<true>, pg8::StaticOrder, true, true>(F.lds + RING_OFF, g, S, E);
        if (BOTH(7)) GRID_BAR();
    }
    if (IN(8)) {
        pg8::Gemm g{XB, Win1T, T, 2 * FF, D}; pg8::StaticOrder S; S.init(T, 2 * FF, F.G, (int)blockIdx.x);
        pg8::EpiSwiGlu E{rowsq + 2 * T, HQ, FF};
        pg8::gemm_phase<pg8::EpiSwiGlu, pg8::StaticOrder, true, true>(F.lds + RING_OFF, g, S, E);
        if (BOTH(8)) GRID_BAR();
    }
    if (IN(9)) {
        pg8::Gemm g{HQ, Wout1T, T, D, FF}; pg8::StaticOrder S; S.init(T, D, F.G, (int)blockIdx.x);
        pg8::EpiRes<true> E{XA, XB, rowsq + 3 * T};
        pg8::gemm_phase<pg8::EpiRes<true>, pg8::StaticOrder, true, true>(F.lds + RING_OFF, g, S, E);
        if (BOTH(9)) GRID_BAR();
    }
    if (IN(10)) {
        const int gw = F.vcu * NWAVES + F.wave, NGW = F.G * NWAVES;
        const GAS f32x4* gr = (const GAS f32x4*)args.in[19] + F.lane;
        for (int m = gw; m < T; m += NGW) {
            const GAS f32x4* xr = (const GAS f32x4*)(XA + (size_t)m * D) + F.lane; GAS f32x4* orow = (GAS f32x4*)(args.out + (size_t)m * D) + F.lane;
            f32x4 v[D / 256]; float s = 0.f;
#pragma unroll
            for (int j = 0; j < D / 256; ++j) { v[j] = xr[64 * j]; s += (v[j].x * v[j].x + v[j].y * v[j].y) + (v[j].z * v[j].z + v[j].w * v[j].w); }
            s = wave_sum(s);
            const float r = 1.0f / sqrtf(s * (1.0f / D) + EPS);
#pragma unroll
            for (int j = 0; j < D / 256; ++j) orow[64 * j] = v[j] * r * gr[64 * j];
        }
    }
#undef IN
#undef BOTH
#undef GRID_BAR
}

extern "C" void kernel_launch(void* const* d_in, const int* in_sizes, int n_in, void* d_out, int out_size, void* d_ws, size_t ws_size, hipStream_t stream) {
    static int grid = 0;
    if (grid == 0) {
        if (n_in != 20 || out_size != T * D || ws_size < WS_END) { fprintf(stderr, "kernel_launch: unexpected shapes/ws (n_in %d out %d ws %zu)\n", n_in, out_size, ws_size); grid = -1; return; }
        int dev = 0, cus = 0;
        if (hipGetDevice(&dev) != hipSuccess || hipDeviceGetAttribute(&cus, hipDeviceAttributeMultiprocessorCount, dev) != hipSuccess) { grid = -1; return; }
        if (hipFuncSetAttribute((const void*)mk_fwd, hipFuncAttributeMaxDynamicSharedMemorySize, LDS_BYTES) != hipSuccess) { fprintf(stderr, "kernel_launch: hipFuncSetAttribute failed\n"); grid = -1; return; }
        (void)hipGetLastError();
        grid = cus;
    }
    if (grid < 0) return;
    (void)hipMemsetAsync((char*)d_ws + WS_CTL, 0, CTL_ZERO_BYTES, stream);
    Args a{};
    for (int i = 0; i < 20; ++i) a.in[i] = (const float*)d_in[i];
    a.out = (float*)d_out; a.ws = (unsigned char*)d_ws;
    unsigned char* ws = (unsigned char*)d_ws;
#define LAUNCH(lo_, hi_) do { a.ph_lo = (lo_); a.ph_hi = (hi_); hipLaunchKernelGGL(mk_fwd, dim3(grid), dim3(NWAVES * 64), LDS_BYTES, stream, a); } while (0)
    LAUNCH(0, 11);
#undef LAUNCH
}
```

```cpp
#include <hip/hip_runtime.h>
#include <cstdint>
#include <cstdio>
namespace pg8 {
#define PG8_LAS __attribute__((address_space(3)))
typedef unsigned short bf16_t;
typedef short bf16x8 __attribute__((ext_vector_type(8)));
typedef float f32x4 __attribute__((ext_vector_type(4)));
typedef unsigned u32x4 __attribute__((ext_vector_type(4)));
constexpr int BM = 256, BK = 64, HALF = 128, HTB = HALF * BK * 2  , STAGE_BYTES = 8 * HTB, NXCD = 8, WGM = 8;

__host__ __device__ __forceinline__ int lds_byte(int r, int c) { const int st = (r >> 4) * 2 + (c >> 5), rr = r & 15, cc = c & 31, ob = rr * 64 + cc * 2; return st * 1024 + (ob ^ (((ob >> 9) & 1) << 5)); }
__host__ __device__ __forceinline__ void stage_rc(int b, int& R, int& C) { const int st = b / 1024, sb = b % 1024, swz = sb ^ (((sb >> 9) & 1) << 5); R = (st >> 1) * 16 + swz / 64; C = (st & 1) * 32 + (swz % 64) / 2; }
__host__ __device__ __forceinline__ int perm32(int rho) { const int n = rho >> 4, i = rho & 15; return 8 * (i >> 2) + 4 * n + (i & 3); }

struct Unit { int pm, pn; };
struct Gemm { const bf16_t* A; const bf16_t* Bt; int M, N, K; };

struct StaticOrder {
    int nM, nN, nwg, G, c;
    __host__ __device__ void init(int M, int N, int G_, int c_) { nM = M / BM; nN = N / BM; nwg = nM * nN; G = G_; c = c_; }
    __host__ __device__ bool next(int i, Unit& u) const {
        const long L = (long)i * G + c; if (L >= nwg) return false;
        int wgid = (int)L; { const int q = nwg / NXCD, r = nwg % NXCD, xcd = wgid % NXCD, off = wgid / NXCD; wgid = (xcd < r ? xcd * (q + 1) : r * (q + 1) + (xcd - r) * q) + off; }
        const int nig = WGM * nN, gid = wgid / nig, fm = gid * WGM, gsz = (nM - fm) < WGM ? (nM - fm) : WGM;
        u.pm = fm + ((wgid % nig) % gsz); u.pn = (wgid % nig) / gsz; return true;
    }
    __device__ __forceinline__ void a_ready(const Unit&) const {}
    __device__ __forceinline__ void done(const Unit&) const {}
};

__device__ __forceinline__ unsigned cvt_pk_bf16(float lo, float hi) { unsigned r; asm volatile("v_cvt_pk_bf16_f32 %0, %1, %2" : "=v"(r) : "v"(lo), "v"(hi)); return r; }
__device__ __forceinline__ float sigm(float v) { return __builtin_amdgcn_rcpf(1.0f + __builtin_amdgcn_exp2f(v * -1.4426950408889634f)); }
__device__ __forceinline__ u32x4 pack8(const f32x4& a, const f32x4& b) { u32x4 w; w.x = cvt_pk_bf16(a[0], a[1]); w.y = cvt_pk_bf16(a[2], a[3]); w.z = cvt_pk_bf16(b[0], b[1]); w.w = cvt_pk_bf16(b[2], b[3]); return w; }
constexpr int DM = 2048;
constexpr float NORM_EPS = 1e-6f;

struct EpiGluRes {
    static constexpr bool PERM = true, AFTER_DRAIN = false;
    const float* res; float* XA; bf16_t* XB; float* rowsq;
    __device__ __forceinline__ void operator()(const f32x4 (&acc)[2][2][4][2], const Unit& u, int wr, int wc, int fr, int fq) const {
        const int row0 = u.pm * BM + wr * 64 + fr, col0 = u.pn * HALF + wc * 32 + 8 * fq;
#pragma unroll
        for (int ai = 0; ai < 2; ++ai)
#pragma unroll
            for (int m = 0; m < 4; ++m) {
                const int row = row0 + ai * HALF + m * 16; const size_t off = (size_t)row * DM + col0;
                const f32x4 r0 = *(const f32x4*)(res + off), r1 = *(const f32x4*)(res + off + 4);
                f32x4 v0, v1;
#pragma unroll
                for (int j = 0; j < 4; ++j) { v0[j] = r0[j] + acc[ai][0][m][0][j] * sigm(acc[ai][1][m][0][j]); v1[j] = r1[j] + acc[ai][0][m][1][j] * sigm(acc[ai][1][m][1][j]); }
                *(f32x4*)(XA + off) = v0; *(f32x4*)(XA + off + 4) = v1;
                *(u32x4*)(XB + off) = pack8(v0, v1);
                float s = (v0[0] * v0[0] + v0[1] * v0[1]) + (v0[2] * v0[2] + v0[3] * v0[3]) + (v1[0] * v1[0] + v1[1] * v1[1]) + (v1[2] * v1[2] + v1[3] * v1[3]);
                s += __shfl_xor(s, 16); s += __shfl_xor(s, 32);
                if (fq == 0) atomicAdd(rowsq + row, s);
            }
    }
};
struct EpiSwiGlu {
    static constexpr bool PERM = true, AFTER_DRAIN = false;
    const float* rowsq; bf16_t* H; int ldh;
    __device__ __forceinline__ void operator()(const f32x4 (&acc)[2][2][4][2], const Unit& u, int wr, int wc, int fr, int fq) const {
        const int row0 = u.pm * BM + wr * 64 + fr, col0 = u.pn * HALF + wc * 32 + 8 * fq;
#pragma unroll
        for (int ai = 0; ai < 2; ++ai)
#pragma unroll
            for (int m = 0; m < 4; ++m) {
                const int row = row0 + ai * HALF + m * 16;
                const float rs = __builtin_amdgcn_rsqf(rowsq[row] * (1.0f / DM) + NORM_EPS);
                f32x4 v0, v1;
#pragma unroll
                for (int j = 0; j < 4; ++j) { const float g0 = acc[ai][0][m][0][j] * rs, g1 = acc[ai][0][m][1][j] * rs;
                    v0[j] = g0 * sigm(g0) * (acc[ai][1][m][0][j] * rs); v1[j] = g1 * sigm(g1) * (acc[ai][1][m][1][j] * rs); }
                *(u32x4*)(H + (size_t)row * ldh + col0) = pack8(v0, v1);
            }
    }
};
template <bool WRITE_XB> struct EpiRes {
    static constexpr bool PERM = true, AFTER_DRAIN = false;
    float* XA; bf16_t* XB; float* rowsq;
    __device__ __forceinline__ void operator()(const f32x4 (&acc)[2][2][4][2], const Unit& u, int wr, int wc, int fr, int fq) const {
        const int row0 = u.pm * BM + wr * 64 + fr, col0 = u.pn * BM + wc * 32 + 8 * fq;
#pragma unroll
        for (int ai = 0; ai < 2; ++ai)
#pragma unroll
            for (int m = 0; m < 4; ++m) {
                const int row = row0 + ai * HALF + m * 16; float s = 0.f;
#pragma unroll
                for (int bj = 0; bj < 2; ++bj) {
                    const size_t off = (size_t)row * DM + col0 + bj * HALF;
                    const f32x4 v0 = *(const f32x4*)(XA + off) + acc[ai][bj][m][0], v1 = *(const f32x4*)(XA + off + 4) + acc[ai][bj][m][1];
                    *(f32x4*)(XA + off) = v0; *(f32x4*)(XA + off + 4) = v1;
                    if (WRITE_XB) *(u32x4*)(XB + off) = pack8(v0, v1);
                    s += (v0[0] * v0[0] + v0[1] * v0[1]) + (v0[2] * v0[2] + v0[3] * v0[3]) + (v1[0] * v1[0] + v1[1] * v1[1]) + (v1[2] * v1[2] + v1[3] * v1[3]);
                }
                s += __shfl_xor(s, 16); s += __shfl_xor(s, 32);
                if (fq == 0) atomicAdd(rowsq + row, s);
            }
    }
};
struct EpiQKV {
    static constexpr bool PERM = true, AFTER_DRAIN = false;
    const float* rowsq; bf16_t* Q; bf16_t* K; bf16_t* V; float qscale;
    __device__ __forceinline__ void operator()(const f32x4 (&acc)[2][2][4][2], const Unit& u, int wr, int wc, int fr, int fq) const {
        const int row0 = u.pm * BM + wr * 64 + fr;
        bf16_t* base; int ld, colt; float sc = 1.f;
        if (u.pn < 24) { base = Q; ld = 6144; colt = u.pn * BM; sc = qscale; }
        else if (u.pn < 26) { base = K; ld = 512; colt = (u.pn - 24) * BM; }
        else { base = V; ld = 512; colt = (u.pn - 26) * BM; }
        const int col0 = colt + wc * 32 + 8 * fq;
#pragma unroll
        for (int ai = 0; ai < 2; ++ai)
#pragma unroll
            for (int m = 0; m < 4; ++m) {
                const int row = row0 + ai * HALF + m * 16;
                const float rs = __builtin_amdgcn_rsqf(rowsq[row] * (1.0f / DM) + NORM_EPS) * sc;
#pragma unroll
                for (int bj = 0; bj < 2; ++bj) *(u32x4*)(base + (size_t)row * ld + col0 + bj * HALF) = pack8(acc[ai][bj][m][0] * rs, acc[ai][bj][m][1] * rs);
            }
    }
};
template <class Epi, class Sched, bool ALIGN_EPI = false, bool SP2 = false>
__device__ __forceinline__ void gemm_phase(PG8_LAS unsigned char* lds, const Gemm g, const Sched& S, const Epi& E) {
    const int tid = threadIdx.x, wid = __builtin_amdgcn_readfirstlane(tid >> 6), lane = tid & 63, wr = wid >> 2, wc = wid & 3, fr = lane & 15, fq = lane >> 4;
    const int K = g.K, nt = K / BK;
    unsigned voffA[2], voffB[2];
#pragma unroll
    for (int i = 0; i < 2; ++i) { int R, C; stage_rc(tid * 16 + i * 8192, R, C); const int Rb = Epi::PERM ? ((R & ~31) + perm32(R & 31)) : R;
        voffA[i] = (unsigned)(R * K + C) * 2u; voffB[i] = (unsigned)(Rb * K + C) * 2u; }
    const size_t kstep = (size_t)(BK * 2);
    const size_t hstep = (size_t)HALF * K * 2;
    const size_t tstep = 2 * hstep;
    const unsigned ldsw = (unsigned)wid * 1024u;
    const int aoff = lds_byte(wr * 64 + fr, fq * 8), boff = lds_byte(wc * 32 + fr, fq * 8);
#define PG8_SA(b, h) (((b) * 2 + (h)) * HTB)
#define PG8_SB(b, h) ((4 + (b) * 2 + (h)) * HTB)
#define PG8_STAGE(bufoff, gbase, voff) do { _Pragma("unroll") for (int _i = 0; _i < 2; ++_i) \
        __builtin_amdgcn_global_load_lds((const unsigned*)((const char*)(gbase) + (voff)[_i]), (PG8_LAS unsigned*)(lds + (bufoff) + ldsw + _i * 8192), 16, 0, 0); } while (0)
#define PG8_LDA(dst, b, h) do { _Pragma("unroll") for (int m = 0; m < 4; ++m) _Pragma("unroll") for (int k = 0; k < 2; ++k) dst[m][k] = *(const PG8_LAS bf16x8*)(lds + PG8_SA(b, h) + aoff + m * 2048 + k * 1024); } while (0)
#define PG8_LDB(dst, b, h) do { _Pragma("unroll") for (int n = 0; n < 2; ++n) _Pragma("unroll") for (int k = 0; k < 2; ++k) dst[n][k] = *(const PG8_LAS bf16x8*)(lds + PG8_SB(b, h) + boff + n * 2048 + k * 1024); } while (0)
#define PG8_MMA(ai, bj, At, Bt) do { __builtin_amdgcn_s_setprio(1); _Pragma("unroll") for (int m = 0; m < 4; ++m) _Pragma("unroll") for (int n = 0; n < 2; ++n) _Pragma("unroll") for (int k = 0; k < 2; ++k) \
        acc[ai][bj][m][n] = __builtin_amdgcn_mfma_f32_16x16x32_bf16(Bt[n][k], At[m][k], acc[ai][bj][m][n], 0, 0, 0); __builtin_amdgcn_s_setprio(0); } while (0)
#define PG8_WAIT_V(n) asm volatile("s_waitcnt vmcnt(" #n ")" ::: "memory")
#define PG8_WAIT_L(n) asm volatile("s_waitcnt lgkmcnt(" #n ")" ::: "memory")
#define PG8_BAR __builtin_amdgcn_s_barrier()
#define PG8_SCHED __builtin_amdgcn_sched_barrier(0)
    Unit cur, nxt; int ui = 0;
    if (!S.next(0, cur)) return;
    f32x4 acc[2][2][4][2];
#pragma unroll
    for (int a = 0; a < 2; ++a)
#pragma unroll
        for (int b = 0; b < 2; ++b)
#pragma unroll
            for (int m = 0; m < 4; ++m)
#pragma unroll
                for (int n = 0; n < 2; ++n) acc[a][b][m][n] = (f32x4){0.f, 0.f, 0.f, 0.f};
    bf16x8 At[4][2], B0[2][2], B1[2][2];
    const char* cA = (const char*)g.A + (size_t)cur.pm * tstep; const char* cB = (const char*)g.Bt + (size_t)cur.pn * tstep;
    S.a_ready(cur);
    if constexpr (SP2) {
        PG8_STAGE(PG8_SB(0, 0), cB, voffB); PG8_STAGE(PG8_SB(0, 1), cB + hstep, voffB); PG8_STAGE(PG8_SA(0, 0), cA, voffA); PG8_STAGE(PG8_SA(0, 1), cA + hstep, voffA);
        if (wr == 1) PG8_BAR;
        PG8_WAIT_V(2); PG8_BAR;
        PG8_STAGE(PG8_SB(1, 0), cB + kstep, voffB); PG8_STAGE(PG8_SA(1, 0), cA + kstep, voffA); PG8_STAGE(PG8_SB(1, 1), cB + hstep + kstep, voffB);
        PG8_WAIT_V(6); PG8_BAR;
    } else {
        PG8_STAGE(PG8_SB(0, 0), cB, voffB); PG8_STAGE(PG8_SA(0, 0), cA, voffA); PG8_STAGE(PG8_SB(0, 1), cB + hstep, voffB); PG8_STAGE(PG8_SA(0, 1), cA + hstep, voffA);
        if (wr == 1) PG8_BAR;
        PG8_WAIT_V(4); PG8_BAR;
        PG8_STAGE(PG8_SB(1, 0), cB + kstep, voffB); PG8_STAGE(PG8_SA(1, 0), cA + kstep, voffA); PG8_STAGE(PG8_SB(1, 1), cB + hstep + kstep, voffB);
        PG8_WAIT_V(6); PG8_BAR;
    }
    for (;;) {
        const bool has_next = S.next(ui + 1, nxt);
        const char* nA = has_next ? (const char*)g.A + (size_t)nxt.pm * tstep : cA; const char* nB = has_next ? (const char*)g.Bt + (size_t)nxt.pn * tstep : cB;
        for (int t = 0; t < nt; t += 2) {
            const bool last = (t == nt - 2);
            const char* a1 = cA + (size_t)(t + 1) * kstep;
            const char* a2 = last ? nA : cA + (size_t)(t + 2) * kstep; const char* b2 = last ? nB : cB + (size_t)(t + 2) * kstep;
            const char* a3 = a2 + kstep; const char* b3 = b2 + kstep;
            if (last && has_next) S.a_ready(nxt);
            if constexpr (SP2) {
            PG8_LDB(B0, 0, 0); PG8_LDB(B1, 0, 1); PG8_SCHED; PG8_LDA(At, 0, 0); PG8_STAGE(PG8_SA(1, 1), a1 + hstep, voffA);
            PG8_WAIT_V(8); PG8_WAIT_L(0); PG8_BAR; PG8_MMA(0, 0, At, B0); PG8_MMA(0, 1, At, B1); PG8_BAR; PG8_SCHED;
            PG8_LDA(At, 0, 1); PG8_STAGE(PG8_SB(0, 0), b2, voffB); PG8_STAGE(PG8_SB(0, 1), b2 + hstep, voffB); PG8_STAGE(PG8_SA(0, 0), a2, voffA);
            PG8_WAIT_V(8); PG8_WAIT_L(0); PG8_BAR; PG8_MMA(1, 0, At, B0); PG8_MMA(1, 1, At, B1); PG8_BAR; PG8_SCHED;
            PG8_LDB(B0, 1, 0); PG8_LDB(B1, 1, 1); PG8_SCHED; PG8_LDA(At, 1, 0); PG8_STAGE(PG8_SA(0, 1), a2 + hstep, voffA);
            PG8_WAIT_V(8); PG8_WAIT_L(0); PG8_BAR; PG8_MMA(0, 0, At, B0); PG8_MMA(0, 1, At, B1); PG8_BAR; PG8_SCHED;
            PG8_LDA(At, 1, 1); PG8_STAGE(PG8_SB(1, 0), b3, voffB); PG8_STAGE(PG8_SB(1, 1), b3 + hstep, voffB); PG8_STAGE(PG8_SA(1, 0), a3, voffA);
            PG8_WAIT_V(8); PG8_WAIT_L(0); PG8_BAR; PG8_MMA(1, 0, At, B0); PG8_MMA(1, 1, At, B1); PG8_BAR; PG8_SCHED;
            } else {
            PG8_LDB(B0, 0, 0); PG8_SCHED; PG8_LDA(At, 0, 0); PG8_STAGE(PG8_SA(1, 1), a1 + hstep, voffA);
            PG8_WAIT_L(8); PG8_BAR; PG8_WAIT_L(0); PG8_MMA(0, 0, At, B0); PG8_BAR; PG8_SCHED;
            PG8_LDB(B1, 0, 1); PG8_STAGE(PG8_SB(0, 0), b2, voffB);
            PG8_BAR; PG8_WAIT_L(0); PG8_MMA(0, 1, At, B1); PG8_BAR;
            PG8_LDA(At, 0, 1); PG8_STAGE(PG8_SA(0, 0), a2, voffA);
            PG8_BAR; PG8_WAIT_L(0); PG8_MMA(1, 0, At, B0); PG8_BAR; PG8_SCHED;
            PG8_STAGE(PG8_SB(0, 1), b2 + hstep, voffB);
            PG8_WAIT_V(6); PG8_BAR; PG8_MMA(1, 1, At, B1); PG8_BAR;
            PG8_LDB(B0, 1, 0); PG8_SCHED; PG8_LDA(At, 1, 0); PG8_STAGE(PG8_SA(0, 1), a2 + hstep, voffA);
            PG8_WAIT_L(8); PG8_BAR; PG8_WAIT_L(0); PG8_MMA(0, 0, At, B0); PG8_BAR; PG8_SCHED;
            PG8_LDB(B1, 1, 1); PG8_STAGE(PG8_SB(1, 0), b3, voffB);
            PG8_BAR; PG8_WAIT_L(0); PG8_MMA(0, 1, At, B1); PG8_BAR;
            PG8_LDA(At, 1, 1); PG8_STAGE(PG8_SA(1, 0), a3, voffA);
            PG8_BAR; PG8_WAIT_L(0); PG8_MMA(1, 0, At, B0); PG8_BAR; PG8_SCHED;
            PG8_STAGE(PG8_SB(1, 1), b3 + hstep, voffB);
            PG8_WAIT_V(6); PG8_BAR; PG8_MMA(1, 1, At, B1); PG8_BAR;
            }
        }
        if constexpr (ALIGN_EPI) { if (wr == 0) PG8_BAR; }
        if constexpr (!Epi::AFTER_DRAIN) { E(acc, cur, wr, wc, fr, fq); S.done(cur); }
        if (!has_next) break;
#pragma unroll
        for (int a = 0; a < 2; ++a)
#pragma unroll
            for (int b = 0; b < 2; ++b)
#pragma unroll
                for (int m = 0; m < 4; ++m)
#pragma unroll
                    for (int n = 0; n < 2; ++n) acc[a][b][m][n] = (f32x4){0.f, 0.f, 0.f, 0.f};
        cur = nxt; cA = nA; cB = nB; ++ui;
        if constexpr (ALIGN_EPI) { if (wr == 1) PG8_BAR; }
    }
    PG8_WAIT_V(0);
    if constexpr (!ALIGN_EPI) { if (wr == 0) PG8_BAR; }
    PG8_BAR;
    if constexpr (Epi::AFTER_DRAIN) { E.fused(acc, cur, wr, wc, fr, fq, lds, wid, lane); S.done(cur); }
#undef PG8_SA
#undef PG8_SB
#undef PG8_STAGE
#undef PG8_LDA
#undef PG8_LDB
#undef PG8_MMA
#undef PG8_WAIT_V
#undef PG8_WAIT_L
#undef PG8_BAR
#undef PG8_SCHED
}
}
#define GAS __attribute__((address_space(1)))
#define LAS __attribute__((address_space(3)))
typedef unsigned short bf16;
typedef unsigned v4u __attribute__((ext_vector_type(4)));
typedef float f32x4 __attribute__((ext_vector_type(4)));
typedef short bf16x8 __attribute__((ext_vector_type(8)));
typedef GAS unsigned gu32;
typedef GAS unsigned long long gu64;
#define RLX_AGENT __ATOMIC_RELAXED, __HIP_MEMORY_SCOPE_AGENT
#define LDS_WAIT() asm volatile("s_waitcnt lgkmcnt(0)" ::: "memory")
#define VM_WAIT() asm volatile("s_waitcnt vmcnt(0)" ::: "memory")
__device__ __forceinline__ unsigned long long rt() { return __builtin_amdgcn_s_memrealtime(); }
__device__ __forceinline__ unsigned f2bf(float f) { unsigned u = __builtin_bit_cast(unsigned, f); return (u + 0x7fffu + ((u >> 16) & 1u)) >> 16; }
__device__ __forceinline__ unsigned pk2(float lo, float hi) { return f2bf(lo) | (f2bf(hi) << 16); }

#define XB_TMO      128
#define XB_XCNT(j)  (256  + 64 * (j))
#define XB_XSUB(j)  (1280 + 64 * (j))
#define XB_XGEN(j)  (2304 + 64 * (j))
#define XB_TOP      3328
#define XB_TOPGEN   3392
#define XCD_BAR_WORDS 3456
#define XB_SPIN_CAP (1u << 18)

__device__ __forceinline__ unsigned xb_ld(unsigned* p)              { return __hip_atomic_load(p, __ATOMIC_RELAXED, __HIP_MEMORY_SCOPE_AGENT); }
__device__ __forceinline__ unsigned xb_add(unsigned* p, unsigned v) { return __hip_atomic_fetch_add(p, v, __ATOMIC_RELAXED, __HIP_MEMORY_SCOPE_AGENT); }
__device__ __forceinline__ unsigned xb_xcc_id() { return (unsigned)__builtin_amdgcn_s_getreg((3 << 11) | 20) & 0xFu; }
#define XB_SPIN(cond, bar) do { unsigned _sp = 0; while (cond) { __builtin_amdgcn_s_sleep(1); \
    if ((++_sp & 255u) == 0u) { if (xb_ld(&(bar)[XB_TMO])) break; if (_sp > XB_SPIN_CAP) { atomicAdd(&(bar)[XB_TMO], 1u); break; } } } } while (0)

struct XcdBarrier {
    unsigned* bar; unsigned x;
    volatile LAS unsigned* st;
};

__device__ __forceinline__ XcdBarrier xcd_barrier_post(unsigned* bar, volatile LAS unsigned* st) {
    XcdBarrier b; b.bar = bar; b.x = xb_xcc_id(); b.st = st;
    if (threadIdx.x == 0) (void)xb_add(&bar[XB_XCNT(b.x)], 1u);
    return b;
}
__device__ __forceinline__ void xcd_barrier_complete(unsigned* bar, unsigned x, unsigned& nloc, unsigned& nx) {
    const unsigned G = gridDim.x * gridDim.y * gridDim.z;
    unsigned sum, cnt, mine, sp = 0u;
    for (;;) {
        sum = 0u; cnt = 0u; mine = 0u;
#pragma unroll
        for (unsigned j = 0; j < 16; ++j) { const unsigned c = xb_ld(&bar[XB_XCNT(j)]); sum += c; cnt += (c > 0u) ? 1u : 0u; mine = (j == x) ? c : mine; }
        if (sum == G) break;
        __builtin_amdgcn_s_sleep(1);
        if ((++sp & 255u) == 0u) { if (xb_ld(&bar[XB_TMO])) break; if (sp > XB_SPIN_CAP) { atomicAdd(&bar[XB_TMO], 1u); break; } }
    }
    nloc = mine > 0u ? mine : 1u; nx = cnt > 0u ? cnt : 1u;
}

__device__ __forceinline__ void xcd_barrier(const XcdBarrier& b) {
    asm volatile("s_waitcnt vmcnt(0)" ::: "memory");
    __syncthreads();
    if (threadIdx.x == 0) {
        unsigned* bar = b.bar;
        __builtin_amdgcn_s_waitcnt(0);
        unsigned nloc = b.st[0], nx = b.st[1];
        if (nloc == 0u) { xcd_barrier_complete(bar, b.x, nloc, nx); b.st[0] = nloc; b.st[1] = nx; }
        const unsigned old = xb_add(&bar[XB_XSUB(b.x)], 1u);
        const unsigned gen = old / nloc;
        if (old + 1u == (gen + 1u) * nloc) {
            __builtin_amdgcn_fence(__ATOMIC_RELEASE, "agent");
            asm volatile("s_waitcnt vmcnt(0)" ::: "memory");
            const unsigned og = xb_add(&bar[XB_TOP], 1u);
            const unsigned tg = og / nx;
            if (og + 1u == (tg + 1u) * nx) xb_add(&bar[XB_TOPGEN], 1u);
            else XB_SPIN(xb_ld(&bar[XB_TOPGEN]) == tg, bar);
            __builtin_amdgcn_fence(__ATOMIC_ACQUIRE, "agent");
            xb_add(&bar[XB_XGEN(b.x)], 1u);
            asm volatile("s_waitcnt vmcnt(0)" ::: "memory");
        } else {
            XB_SPIN(xb_ld(&bar[XB_XGEN(b.x)]) == gen, bar);
            __builtin_amdgcn_fence(__ATOMIC_ACQUIRE, "agent");
            asm volatile("s_waitcnt vmcnt(0)" ::: "memory");
        }
    }
    __syncthreads();
}
constexpr int NWAVES = 8;
constexpr int D = 2048, NB = 2, SEQ = 4096, T = NB * SEQ;
constexpr int SG = 128, SP = 64, SC = 16;
constexpr int NH = 16, HD = 128, NKV = 4, NGRP = 3;
constexpr int FF = 5632;
constexpr int NQ = NGRP * NH * HD, NKVC = NKV * HD;
constexpr int NQKV = NQ + 2 * NKVC;
constexpr float EPS = 1e-6f;
constexpr float QSCALE = 0.08838834764831845f * 1.4426950408889634f;

constexpr size_t MiB = 1u << 20;
constexpr size_t WS_CTL = 0, CTL_ZERO_BYTES = 1 * MiB;
constexpr size_t WS_RSTD0 = 1 * MiB;
constexpr size_t WS_WGLU = 2 * MiB, WS_WIN0 = 18 * MiB, WS_WOUT0 = 62 * MiB, WS_WQKV = 84 * MiB, WS_WO = 112 * MiB, WS_WIN1 = 120 * MiB, WS_WOUT1 = 164 * MiB;
constexpr size_t WS_XA = 186 * MiB;
constexpr size_t WS_XB = 250 * MiB;
constexpr size_t WS_ZO = 282 * MiB;
constexpr size_t WS_HQ = 314 * MiB;
constexpr size_t WS_K = 410 * MiB, WS_V = 418 * MiB;
constexpr size_t WS_OG = 426 * MiB;
constexpr size_t WS_LSE = 522 * MiB;
constexpr size_t WS_END = 524 * MiB;
constexpr int CW_TMO = 0, CW_CODE = 1, CW_BAR = 4096;
constexpr int CW_ROWSQ = 16384;
static_assert((CW_ROWSQ + 4 * T) * 4 <= (int)CTL_ZERO_BYTES, "ctl");

constexpr int RING_OFF = 0, RING_BYTES = 131072;
constexpr int LDSCTL_OFF = 155648, MISC_OFF = LDSCTL_OFF + 320;
constexpr int LDS_BYTES = 163840;

struct Frame {
    LAS unsigned char* lds;
    volatile LAS unsigned* MISC;
    gu32* ctl;
    int tid, lane, wave;
    int vcu, G;
};

__device__ __forceinline__ float wave_sum(float v) {
#pragma unroll
    for (int o = 1; o < 64; o <<= 1) v += __shfl_xor(v, o);
    return v;
}
__device__ __forceinline__ float wave_max(float v) {
#pragma unroll
    for (int o = 1; o < 64; o <<= 1) v = fmaxf(v, __shfl_xor(v, o));
    return v;
}
__device__ __forceinline__ void p0_transpose_item(const float* W, int K, int N, const float* gain, bf16* WT, int Nh, int row_off, LAS float* scr, int item, int lane) {
    const int nblk = N / 32, kb = item / nblk, nb = item % nblk, k0 = 64 * kb, n0 = 32 * nb;
#pragma unroll 8
    for (int i = 0; i < 32; ++i) { const int kk = 2 * i + (lane >> 5); float v = W[(size_t)(k0 + kk) * N + n0 + (lane & 31)]; if (gain) v *= gain[k0 + kk]; scr[kk * 33 + (lane & 31)] = v; }
    LDS_WAIT(); asm volatile("" ::: "memory");
    const int c = lane & 7;
    int drow0 = row_off + n0;
    if (Nh) { const int nn = n0 % Nh; drow0 = 256 * (nn / 128) + 128 * (n0 / Nh) + (nn % 128); }
#pragma unroll
    for (int j = 0; j < 4; ++j) { const int n = (lane >> 3) + 8 * j; const LAS float* s = scr + (8 * c) * 33 + n;
        v4u o; o.x = pk2(s[0 * 33], s[1 * 33]); o.y = pk2(s[2 * 33], s[3 * 33]); o.z = pk2(s[4 * 33], s[5 * 33]); o.w = pk2(s[6 * 33], s[7 * 33]);
        *(GAS v4u*)(WT + (size_t)(drow0 + n) * K + k0 + 8 * c) = o; }
    LDS_WAIT(); asm volatile("" ::: "memory");
}

namespace s5 {
typedef float f32x16 __attribute__((ext_vector_type(16)));
constexpr int L = 8, NCH = 32, BLK = 256, NBLK = SEQ / BLK;
constexpr int O_PW = 0;
constexpr int O_A256 = 4608;
constexpr int O_KT = 5120;
constexpr int O_ET = O_KT + 4608;
constexpr int O_FT = O_ET + 32768;
constexpr int O_EB = O_FT + 32768;
constexpr int O_XT = O_EB + 8192;
constexpr int XT_ROW = 272, XT_WAVE = 32 * XT_ROW;
constexpr int O_BB = O_XT;
constexpr int O_CC = O_XT + 8192;
constexpr int O_KP = O_XT + 16384;
constexpr int LDS_END = O_XT + 8 * XT_WAVE;
static_assert(O_KP + 16384 <= LDS_END, "s5 lds");

__device__ __forceinline__ float dpp_x1(float v) { return __builtin_bit_cast(float, __builtin_amdgcn_mov_dpp(__builtin_bit_cast(int, v), 0xB1, 0xF, 0xF, true)); }
__device__ __forceinline__ float gelu_t(float y) {
    const float inner = y * (1.0f + 0.044715f * y * y);
    return y * __builtin_amdgcn_rcpf(1.0f + __builtin_amdgcn_exp2f(-2.3022081981f * inner));
}
__device__ __forceinline__ void disc(const float* lam_re, const float* lam_im, const float* log_dt, int g, int p, float& lbr, float& lbi, float& fr, float& fi) {
    const float lr = lam_re[g * SP + p], li = lam_im[g * SP + p], dt = expf(log_dt[g]);
    const float mag = expf(lr * dt), ang = li * dt;
    lbr = mag * cosf(ang); lbi = mag * sinf(ang);
    const float nr = lbr - 1.f, den = lr * lr + li * li;
    fr = (nr * lr + lbi * li) / den; fi = (lbi * lr - nr * li) / den;
}

struct Params { const float *x, *rstd0, *gn, *lam_re, *lam_im, *log_dt, *b_re, *b_im, *c_re, *c_im, *dsk; bf16* z; };

__device__ __forceinline__ void load_ufrag(bf16x8 (&uf)[8], const Params& P, size_t tok0  , int g, int n, int h, const float (&gnr)[8]) {
    const float* xp = P.x + (tok0 + 8 * n) * D + g * SC + 8 * h;
    const f32x4 r0 = *(const f32x4*)(P.rstd0 + tok0 + 8 * n), r1 = *(const f32x4*)(P.rstd0 + tok0 + 8 * n + 4);
    const float rs[8] = {r0[0], r0[1], r0[2], r0[3], r1[0], r1[1], r1[2], r1[3]};
#pragma unroll
    for (int s = 0; s < 8; ++s) {
        const f32x4 a = *(const f32x4*)(xp + (size_t)s * D), c = *(const f32x4*)(xp + (size_t)s * D + 4);
        v4u w;
        w.x = pg8::cvt_pk_bf16(a[0] * rs[s] * gnr[0], a[1] * rs[s] * gnr[1]); w.y = pg8::cvt_pk_bf16(a[2] * rs[s] * gnr[2], a[3] * rs[s] * gnr[3]);
        w.z = pg8::cvt_pk_bf16(c[0] * rs[s] * gnr[4], c[1] * rs[s] * gnr[5]); w.w = pg8::cvt_pk_bf16(c[2] * rs[s] * gnr[6], c[3] * rs[s] * gnr[7]);
        uf[s] = __builtin_bit_cast(bf16x8, w);
    }
}
__device__ __forceinline__ f32x16 stage_a(int cb, const bf16x8 (&uf)[8], const LAS unsigned char* lds, int lane) {
    f32x16 acc = (f32x16){0.f, 0.f, 0.f, 0.f, 0.f, 0.f, 0.f, 0.f, 0.f, 0.f, 0.f, 0.f, 0.f, 0.f, 0.f, 0.f};
#pragma unroll
    for (int s = 0; s < 8; ++s) {
        const bf16x8 e = *(const LAS bf16x8*)(lds + O_ET + ((s * 4 + cb) * 32 + (lane & 31)) * 32 + (lane >> 5) * 16);
        acc = __builtin_amdgcn_mfma_f32_32x32x16_bf16(uf[s], e, acc, 0, 0, 0);
    }
    return acc;
}

__device__ __forceinline__ void item(const Params& P, LAS unsigned char* lds, int b, int g, int tid, int wave, int lane) {
    const int rl = lane & 31, h = lane >> 5;
    __syncthreads();
#ifndef S5_NO_SETUP
    if (tid < SP) {
        float lbr, lbi, fr, fi; disc(P.lam_re, P.lam_im, P.log_dt, g, tid, lbr, lbi, fr, fi);
        LAS float* pw = (LAS float*)(lds + O_PW);
        float pr = 1.f, pi = 0.f;
#pragma unroll
        for (int m = 0; m <= 8; ++m) { pw[(m * SP + tid) * 2] = pr; pw[(m * SP + tid) * 2 + 1] = pi; const float nr = pr * lbr - pi * lbi, ni = pr * lbi + pi * lbr; pr = nr; pi = ni; }
        float ar = pw[(8 * SP + tid) * 2], ai = pw[(8 * SP + tid) * 2 + 1];
#pragma unroll
        for (int k = 0; k < 5; ++k) { const float nr = ar * ar - ai * ai, ni = 2.f * ar * ai; ar = nr; ai = ni; }
        LAS float* a256 = (LAS float*)(lds + O_A256); a256[tid * 2] = ar; a256[tid * 2 + 1] = ai;
    }
    {
        LAS float* BB = (LAS float*)(lds + O_BB); LAS float* CC = (LAS float*)(lds + O_CC);
#pragma unroll
        for (int k = 0; k < 2; ++k) {
            const int idx = tid + 512 * k, p = idx >> 4, ci = idx & 15;
            float lbr, lbi, fr, fi; disc(P.lam_re, P.lam_im, P.log_dt, g, p, lbr, lbi, fr, fi);
            const float br = P.b_re[(g * SP + p) * SC + ci], bi = P.b_im[(g * SP + p) * SC + ci];
            BB[idx * 2] = fr * br - fi * bi; BB[idx * 2 + 1] = fr * bi + fi * br;
            CC[idx * 2] = P.c_re[(size_t)g * SC * SP + idx]; CC[idx * 2 + 1] = P.c_im[(size_t)g * SC * SP + idx];
        }
    }
    __syncthreads();
    {
        const LAS float* pw = (const LAS float*)(lds + O_PW); const LAS float* BB = (const LAS float*)(lds + O_BB); const LAS float* CC = (const LAS float*)(lds + O_CC);
        {
            const int ph = tid >> 8, co = (tid >> 4) & 15, ci = tid & 15;
            float kd[8];
#pragma unroll
            for (int d = 0; d < 8; ++d) kd[d] = 0.f;
#pragma unroll 2
            for (int pp = 0; pp < 32; ++pp) {
                const int p = ph * 32 + pp;
                const float cr = CC[(co * SP + p) * 2], cim = CC[(co * SP + p) * 2 + 1], lbr = pw[(SP + p) * 2], lbi = pw[(SP + p) * 2 + 1];
                float wr = BB[(p * SC + ci) * 2], wi = BB[(p * SC + ci) * 2 + 1];
#pragma unroll
                for (int d = 0; d < 8; ++d) { kd[d] += cr * wr - cim * wi; const float nr = wr * lbr - wi * lbi, ni = wr * lbi + wi * lbr; wr = nr; wi = ni; }
            }
            LAS float* KP = (LAS float*)(lds + O_KP);
#pragma unroll
            for (int d = 0; d < 8; ++d) KP[(ph * 8 + d) * 256 + co * 16 + ci] = kd[d];
        }
        {
#pragma unroll
            for (int k = 0; k < 2; ++k) {
                const int pair = tid + 512 * k, s = pair >> 7, rho = pair & 127, p = rho >> 1, part = rho & 1;
                const float qr = pw[((7 - s) * SP + p) * 2], qi = pw[((7 - s) * SP + p) * 2 + 1];
                float v[16];
#pragma unroll
                for (int ci = 0; ci < 16; ++ci) { const float br = BB[(p * SC + ci) * 2], bi = BB[(p * SC + ci) * 2 + 1]; v[ci] = part ? (qr * bi + qi * br) : (qr * br - qi * bi); }
                LAS v4u* dst = (LAS v4u*)(lds + O_ET + (s * 128 + rho) * 32);
                v4u w0, w1;
                w0.x = pg8::cvt_pk_bf16(v[0], v[1]); w0.y = pg8::cvt_pk_bf16(v[2], v[3]); w0.z = pg8::cvt_pk_bf16(v[4], v[5]); w0.w = pg8::cvt_pk_bf16(v[6], v[7]);
                w1.x = pg8::cvt_pk_bf16(v[8], v[9]); w1.y = pg8::cvt_pk_bf16(v[10], v[11]); w1.z = pg8::cvt_pk_bf16(v[12], v[13]); w1.w = pg8::cvt_pk_bf16(v[14], v[15]);
                dst[0] = w0; dst[1] = w1;
            }
        }
        {
#pragma unroll
            for (int k = 0; k < 4; ++k) {
                const int tup = tid + 512 * k, hh = tup & 1, r = (tup >> 1) & 31, i = (tup >> 6) & 3, ks = tup >> 8;
                const int t = 2 * i + (r >> 4), co = r & 15;
                float v[8];
#pragma unroll
                for (int jj = 0; jj < 4; ++jj) {
                    const int p = 8 * ks + 4 * hh + jj;
                    const float cr = CC[(co * SP + p) * 2], cim = CC[(co * SP + p) * 2 + 1], qr = pw[((t + 1) * SP + p) * 2], qi = pw[((t + 1) * SP + p) * 2 + 1];
                    v[2 * jj] = cr * qr - cim * qi; v[2 * jj + 1] = -(cr * qi + cim * qr);
                }
                v4u w; w.x = pg8::cvt_pk_bf16(v[0], v[1]); w.y = pg8::cvt_pk_bf16(v[2], v[3]); w.z = pg8::cvt_pk_bf16(v[4], v[5]); w.w = pg8::cvt_pk_bf16(v[6], v[7]);
                *(LAS v4u*)(lds + O_FT + tup * 16) = w;
            }
        }
    }
    __syncthreads();
    {
        const LAS float* KP = (const LAS float*)(lds + O_KP);
        LAS unsigned short* KT = (LAS unsigned short*)(lds + O_KT);
#pragma unroll
        for (int k = 0; k < 4; ++k) { const int idx = tid + 512 * k; KT[256 + idx] = (unsigned short)f2bf(KP[idx] + KP[2048 + idx]); }
        if (tid < 256) KT[tid] = 0;
    }
#endif
    float c1[4], c2[4], d1[4], d2[4];
    {
        const LAS float* pw = (const LAS float*)(lds + O_PW); const LAS float* a256 = (const LAS float*)(lds + O_A256);
#pragma unroll
        for (int cb = 0; cb < 4; ++cb) { const int p = 16 * cb + (rl >> 1); const float ar = pw[(8 * SP + p) * 2], ai = pw[(8 * SP + p) * 2 + 1], br = a256[p * 2], bi = a256[p * 2 + 1];
            c1[cb] = ar; c2[cb] = (rl & 1) ? ai : -ai; d1[cb] = br; d2[cb] = (rl & 1) ? bi : -bi; }
    }
    float gnr[8];
#pragma unroll
    for (int j = 0; j < 8; ++j) gnr[j] = P.gn[g * SC + 8 * h + j];
    __syncthreads();
#ifndef S5_NO_P1
#pragma unroll 1
    for (int pass = 0; pass < 2; ++pass) {
        const int blk = wave + 8 * pass;
        bf16x8 uf[8]; load_ufrag(uf, P, (size_t)b * SEQ + (size_t)blk * BLK, g, rl, h, gnr);
#pragma unroll
        for (int cb = 0; cb < 4; ++cb) {
            const f32x16 acc = stage_a(cb, uf, lds, lane);
            float c = 0.f;
#pragma unroll
            for (int g4 = 0; g4 < 8; ++g4) {
                float cc = c;
#pragma unroll
                for (int r4 = 0; r4 < 4; ++r4) cc = c1[cb] * cc + (c2[cb] * dpp_x1(cc) + acc[4 * (g4 >> 1) + r4]);
                const float oth = __shfl_xor(cc, 32);
                c = (h == (g4 & 1)) ? cc : oth;
            }
            if (h == 0) ((LAS float*)(lds + O_EB))[blk * 128 + 32 * cb + rl] = c;
        }
    }
#endif
    __syncthreads();
#ifndef S5_NO_P2
    float cin[4] = {0.f, 0.f, 0.f, 0.f};
    LAS unsigned char* xt = lds + O_XT + wave * XT_WAVE;
#pragma unroll 1
    for (int pass = 0; pass < 2; ++pass) {
        const int blk = wave + 8 * pass;
        {
            const int b0 = pass ? wave : 0;
            for (int bb = b0; bb < blk; ++bb) {
#pragma unroll
                for (int cb = 0; cb < 4; ++cb) cin[cb] = d1[cb] * cin[cb] + (d2[cb] * dpp_x1(cin[cb]) + ((const LAS float*)(lds + O_EB))[bb * 128 + 32 * cb + rl]);
            }
        }
        const size_t tok0 = (size_t)b * SEQ + (size_t)blk * BLK;
        bf16x8 uf[8]; load_ufrag(uf, P, tok0, g, rl, h, gnr);
#pragma unroll
        for (int cb = 0; cb < 4; ++cb) {
            f32x16 acc = stage_a(cb, uf, lds, lane);
            float c = cin[cb];
#pragma unroll
            for (int g4 = 0; g4 < 8; ++g4) {
                float cc = c;
#pragma unroll
                for (int r4 = 0; r4 < 4; ++r4) { const int q = 4 * (g4 >> 1) + r4; const float sv = acc[q]; if (h == (g4 & 1)) acc[q] = cc; cc = c1[cb] * cc + (c2[cb] * dpp_x1(cc) + sv); }
                const float oth = __shfl_xor(cc, 32);
                c = (h == (g4 & 1)) ? cc : oth;
            }
#pragma unroll
            for (int q = 0; q < 16; ++q) { const int n = (q & 3) + 8 * (q >> 2) + 4 * h; *(LAS unsigned short*)(xt + n * XT_ROW + (32 * cb + rl) * 2) = (unsigned short)f2bf(acc[q]); }
        }
        LDS_WAIT(); asm volatile("" ::: "memory");
#pragma unroll 1
        for (int i = 0; i < 4; ++i) {
            f32x16 y = (f32x16){0.f, 0.f, 0.f, 0.f, 0.f, 0.f, 0.f, 0.f, 0.f, 0.f, 0.f, 0.f, 0.f, 0.f, 0.f, 0.f};
#pragma unroll
            for (int s = 0; s < 8; ++s) {
                int jx = 2 * i - s + 1 + (rl >> 4); jx = jx < 0 ? 0 : jx;
                const bf16x8 ph = *(const LAS bf16x8*)(lds + O_KT + (jx * 16 + (rl & 15)) * 32 + h * 16);
                y = __builtin_amdgcn_mfma_f32_32x32x16_bf16(ph, uf[s], y, 0, 0, 0);
            }
#pragma unroll
            for (int ks = 0; ks < 8; ++ks) {
                const bf16x8 ff = *(const LAS bf16x8*)(lds + O_FT + (((ks * 4 + i) * 32 + rl) * 2 + h) * 16);
                const bf16x8 xf = *(const LAS bf16x8*)(xt + rl * XT_ROW + ks * 32 + h * 16);
                y = __builtin_amdgcn_mfma_f32_32x32x16_bf16(ff, xf, y, 0, 0, 0);
            }
#pragma unroll
            for (int ts = 0; ts < 2; ++ts) {
                const size_t tok = tok0 + 8 * rl + 2 * i + ts;
                const float rs = P.rstd0[tok];
#pragma unroll
                for (int h8 = 0; h8 < 2; ++h8) {
                    const int c0 = 8 * h8 + 4 * h;
                    const f32x4 xv = *(const f32x4*)(P.x + tok * D + g * SC + c0), gv = *(const f32x4*)(P.gn + g * SC + c0), dv = *(const f32x4*)(P.dsk + g * SC + c0);
                    float o[4];
#pragma unroll
                    for (int e = 0; e < 4; ++e) o[e] = gelu_t(y[8 * ts + 4 * h8 + e] + dv[e] * (xv[e] * rs * gv[e]));
                    uint2 w; w.x = pg8::cvt_pk_bf16(o[0], o[1]); w.y = pg8::cvt_pk_bf16(o[2], o[3]);
                    *(uint2*)(P.z + tok * D + g * SC + c0) = w;
                }
            }
        }
        LDS_WAIT(); asm volatile("" ::: "memory");
    }
#endif
}
}
namespace att {
typedef float f32x16 __attribute__((ext_vector_type(16)));
typedef short s16x4 __attribute__((ext_vector_type(4)));
constexpr int TILE = 16384;
constexpr int O_V = 0, O_K = 3 * TILE, O_WS = 6 * TILE, LDS_END = O_WS + 8 * 64 * 4;
#define ATT_KSWZ(row, colB) ((row) * 256 + ((colB) ^ (((row) & 7) << 4)))
#define ATT_SBAR() __builtin_amdgcn_sched_barrier(0)
__device__ __forceinline__ int v_st(int k, int c) { const int kk = (k & ~0xC) | ((k & 4) << 1) | ((k & 8) >> 1); return ((kk >> 3) * 4 + (c >> 5)) * 512 + ((kk & 7) * 32 + (c & 31)) * 2; }
__device__ __forceinline__ int v_rd_base(int lane) { return ((lane & 3) << 3) | (((lane >> 2) & 3) << 6) | (((lane >> 4) & 1) << 5) | (((lane >> 5) & 1) << 8); }
constexpr int v_rd_off(int d0, int ks, int half) { return d0 * 512 + ks * 4096 + half * 2048; }
__device__ __forceinline__ int crow(int r, int hi) { return (r & 3) + 8 * (r >> 2) + 4 * hi; }
__device__ __forceinline__ unsigned cvtpk(float lo, float hi) { unsigned r; asm volatile("v_cvt_pk_bf16_f32 %0, %1, %2" : "=v"(r) : "v"(lo), "v"(hi)); return r; }
__device__ __forceinline__ void mask_tile(f32x16& p0, f32x16& p1, int dq) {
    const float NEG = -__builtin_inff();
#pragma unroll
    for (int r = 0; r < 16; ++r) {
        const int c = (r & 3) + 8 * (r >> 2);
        if ((unsigned)(dq - c) >= 129u) p0[r] = NEG;
        if ((unsigned)(dq - c - 32) >= 129u) p1[r] = NEG;
    }
}
__device__ __forceinline__ void partialSM(f32x16& p0, f32x16& p1, float& m_reg, float& alpha) {
    float pmax = p0[0];
#pragma unroll
    for (int r = 1; r < 16; ++r) pmax = fmaxf(pmax, p0[r]);
#pragma unroll
    for (int r = 0; r < 16; ++r) pmax = fmaxf(pmax, p1[r]);
    { auto rr = __builtin_amdgcn_permlane32_swap(__float_as_uint(pmax), __float_as_uint(pmax), false, false);
      pmax = fmaxf(__uint_as_float(rr[0]), __uint_as_float(rr[1])); }
    float mn;
    if (__all(pmax <= m_reg)) { mn = m_reg; alpha = 1.f; }
    else { mn = fmaxf(m_reg, pmax); alpha = __builtin_amdgcn_exp2f(m_reg - mn); m_reg = mn; }
#pragma unroll
    for (int r = 0; r < 16; ++r) { p0[r] = __builtin_amdgcn_exp2f(p0[r] - mn); p1[r] = __builtin_amdgcn_exp2f(p1[r] - mn); }
}
__device__ __forceinline__ void finishSM(const f32x16& p0, const f32x16& p1, float alpha, float& l_reg, bf16x8& pa0, bf16x8& pa1, bf16x8& pa2, bf16x8& pa3) {
    float ps = 0.f;
#pragma unroll
    for (int r = 0; r < 16; ++r) ps += p0[r];
#pragma unroll
    for (int r = 0; r < 16; ++r) ps += p1[r];
    { auto rr = __builtin_amdgcn_permlane32_swap(__float_as_uint(ps), __float_as_uint(ps), false, false);
      ps = __uint_as_float(rr[0]) + __uint_as_float(rr[1]); }
    l_reg = l_reg * alpha + ps;
#define ATT_PK4(P, B_, OUT) do { unsigned a0 = cvtpk(P[B_+0], P[B_+1]), a1 = cvtpk(P[B_+2], P[B_+3]);                          \
        unsigned b0 = cvtpk(P[B_+4], P[B_+5]), b1 = cvtpk(P[B_+6], P[B_+7]);                                             \
        auto r0 = __builtin_amdgcn_permlane32_swap(a0, b0, false, false); auto r1 = __builtin_amdgcn_permlane32_swap(a1, b1, false, false); \
        v4u w = {r0[0], r1[0], r0[1], r1[1]}; OUT = __builtin_bit_cast(bf16x8, w); } while (0)
    ATT_PK4(p0, 0, pa0); ATT_PK4(p0, 8, pa1); ATT_PK4(p1, 0, pa2); ATT_PK4(p1, 8, pa3);
#undef ATT_PK4
}
__device__ __forceinline__ void qkt(f32x16& p0, f32x16& p1, const LAS unsigned char* K_t, int r32, int hi, const bf16x8* qr) {
    p0 = (f32x16){0.f, 0.f, 0.f, 0.f, 0.f, 0.f, 0.f, 0.f, 0.f, 0.f, 0.f, 0.f, 0.f, 0.f, 0.f, 0.f}; p1 = p0;
    const LAS unsigned char* kb[4];
#pragma unroll
    for (int dd = 0; dd < 4; ++dd) kb[dd] = K_t + ATT_KSWZ(r32, (dd * 16 + hi * 8) * 2);
#pragma unroll
    for (int d0 = 0; d0 < 8; ++d0) { const LAS unsigned char* a = kb[d0 & 3] + (d0 >> 2) * 128;
        const bf16x8 b0 = *(const LAS bf16x8*)a;
        const bf16x8 b1 = *(const LAS bf16x8*)(a + 32 * 256);
        p0 = __builtin_amdgcn_mfma_f32_32x32x16_bf16(b0, qr[d0], p0, 0, 0, 0);
        p1 = __builtin_amdgcn_mfma_f32_32x32x16_bf16(b1, qr[d0], p1, 0, 0, 0); }
}
template <int VB>
__device__ __forceinline__ void pv_tile(f32x16* o, int vb0, bf16x8 pa0, bf16x8 pa1, bf16x8 pa2, bf16x8 pa3) {
#define ATT_TRRD(dst, off) asm volatile("ds_read_b64_tr_b16 %0, %1 offset:%2" : "=&v"(dst) : "v"(vb0), "i"(off) : "memory")
#define ATT_PV_D0(d0) do { s16x4 l0, l1, l2, l3, h0, h1, h2, h3; constexpr int b_ = O_V + VB * TILE + v_rd_off(d0, 0, 0); \
        ATT_TRRD(l0, b_); ATT_TRRD(h0, b_ + 2048); ATT_TRRD(l1, b_ + 4096); ATT_TRRD(h1, b_ + 6144); ATT_TRRD(l2, b_ + 8192); ATT_TRRD(h2, b_ + 10240); ATT_TRRD(l3, b_ + 12288); ATT_TRRD(h3, b_ + 14336); \
        asm volatile("s_waitcnt lgkmcnt(0)" ::: "memory"); ATT_SBAR();   \
        o[d0] = __builtin_amdgcn_mfma_f32_32x32x16_bf16(pa0, (bf16x8){l0[0], l0[1], l0[2], l0[3], h0[0], h0[1], h0[2], h0[3]}, o[d0], 0, 0, 0);   \
        o[d0] = __builtin_amdgcn_mfma_f32_32x32x16_bf16(pa1, (bf16x8){l1[0], l1[1], l1[2], l1[3], h1[0], h1[1], h1[2], h1[3]}, o[d0], 0, 0, 0);   \
        o[d0] = __builtin_amdgcn_mfma_f32_32x32x16_bf16(pa2, (bf16x8){l2[0], l2[1], l2[2], l2[3], h2[0], h2[1], h2[2], h2[3]}, o[d0], 0, 0, 0);   \
        o[d0] = __builtin_amdgcn_mfma_f32_32x32x16_bf16(pa3, (bf16x8){l3[0], l3[1], l3[2], l3[3], h3[0], h3[1], h3[2], h3[3]}, o[d0], 0, 0, 0); } while (0)
    ATT_PV_D0(0); ATT_PV_D0(1); ATT_PV_D0(2); ATT_PV_D0(3);
#undef ATT_PV_D0
#undef ATT_TRRD
}

struct Tensors { const bf16* Q; const bf16* K; const bf16* V; bf16* OG; float* LSE; bf16* O; };

template <int TT>
__device__ __forceinline__ void tile_step(f32x16 (&o)[4], float& m_reg, float& l_reg, const LAS unsigned char* lds, LAS float* al_l, int vb0, int r32, int hi, const bf16x8* qr, int dq) {
    f32x16 p0, p1; float alpha; bf16x8 pa0, pa1, pa2, pa3;
    qkt(p0, p1, lds + O_K + TT * TILE, r32, hi, qr);
    mask_tile(p0, p1, dq);
    partialSM(p0, p1, m_reg, alpha);
    finishSM(p0, p1, alpha, l_reg, pa0, pa1, pa2, pa3);
    if (__any(alpha < 1.f)) {
        if (hi == 0) al_l[r32] = alpha;
        asm volatile("s_waitcnt lgkmcnt(0)" ::: "memory");
#pragma unroll
        for (int d_ = 0; d_ < 4; ++d_)
#pragma unroll
            for (int r = 0; r < 16; ++r) o[d_][r] *= al_l[crow(r, hi)];
    }
    ATT_SBAR();
    pv_tile<TT>(o, vb0, pa0, pa1, pa2, pa3);
}

template <bool MERGE>
__device__ __forceinline__ void unit(const Tensors& TS, LAS unsigned char* lds, int pair, int g, int rho, int qb, int tid, int wid, int lane) {
    const int r32 = lane & 31, hi = lane >> 5;
    const int b = pair >> 2, kvh = pair & 3, dil = (g == 0) ? 1 : (g == 1 ? 4 : 16);
    const int i0 = qb * 64;
    const size_t trow0 = (size_t)b * SEQ;
    const int sr = tid >> 4, sc = (tid & 15) * 8;
    const int t_lo = (i0 >= 128) ? 0 : ((i0 >= 64) ? 1 : 2);
    bf16x8 st[3][4];
#pragma unroll
    for (int tt = 0; tt < 3; ++tt) if (tt >= t_lo) {
        const int kl = i0 - 128 + 64 * tt;
        const size_t r0 = (trow0 + rho + (size_t)dil * (kl + sr)) * NKVC + kvh * HD + sc, r1 = r0 + (size_t)dil * 32 * NKVC;
        st[tt][0] = *(const bf16x8*)(TS.K + r0); st[tt][1] = *(const bf16x8*)(TS.K + r1);
        st[tt][2] = *(const bf16x8*)(TS.V + r0); st[tt][3] = *(const bf16x8*)(TS.V + r1);
    }
    const int hq = 4 * kvh + (wid & 3), a = wid >> 2, iq = i0 + 32 * a + r32;
    const size_t qtok = trow0 + rho + (size_t)dil * iq;
    bf16x8 qr[8];
    { const bf16* qp = TS.Q + qtok * NQ + g * (NH * HD) + hq * HD + hi * 8;
#pragma unroll
      for (int d0 = 0; d0 < 8; ++d0) qr[d0] = *(const bf16x8*)(qp + d0 * 16); }
    const int kws = ATT_KSWZ(sr, sc * 2), vst0 = v_st(sr, sc), vst1 = v_st(32 + sr, sc);
#pragma unroll
    for (int tt = 0; tt < 3; ++tt) if (tt >= t_lo) {
        *(LAS bf16x8*)(lds + O_K + tt * TILE + kws) = st[tt][0]; *(LAS bf16x8*)(lds + O_K + tt * TILE + kws + 32 * 256) = st[tt][1];
        *(LAS bf16x8*)(lds + O_V + tt * TILE + vst0) = st[tt][2]; *(LAS bf16x8*)(lds + O_V + tt * TILE + vst1) = st[tt][3];
    }
    __syncthreads();
    LAS float* ws = (LAS float*)(lds + O_WS) + wid * 64; LAS float* al_l = ws; LAS float* li_l = ws + 32;
    const int vb0 = (int)(unsigned)(uintptr_t)(lds + O_V) + v_rd_base(lane);
    float m_reg = -1e30f, l_reg = 0.f; f32x16 o[4];
#pragma unroll
    for (int d_ = 0; d_ < 4; ++d_) o[d_] = (f32x16){0.f, 0.f, 0.f, 0.f, 0.f, 0.f, 0.f, 0.f, 0.f, 0.f, 0.f, 0.f, 0.f, 0.f, 0.f, 0.f};
    const int dq0 = 32 * a + r32 + 128 - 4 * hi;
    if (t_lo <= 0) tile_step<0>(o, m_reg, l_reg, lds, al_l, vb0, r32, hi, qr, dq0);
    if (t_lo <= 1) tile_step<1>(o, m_reg, l_reg, lds, al_l, vb0, r32, hi, qr, dq0 - 64);
    tile_step<2>(o, m_reg, l_reg, lds, al_l, vb0, r32, hi, qr, dq0 - 128);
    if (hi == 0) li_l[r32] = l_reg;
    asm volatile("s_waitcnt lgkmcnt(0)" ::: "memory");
    float rli[16];
#pragma unroll
    for (int r = 0; r < 16; ++r) rli[r] = __builtin_amdgcn_rcpf(li_l[crow(r, hi)]);
    const float lse = m_reg + __builtin_amdgcn_logf(l_reg);
    __syncthreads();
    LAS unsigned char* stg = lds + wid * 8192;
#pragma unroll
    for (int r = 0; r < 16; ++r) { const int orow = crow(r, hi);
#pragma unroll
        for (int d0 = 0; d0 < 4; ++d0) *(LAS unsigned short*)(stg + orow * 256 + (d0 * 32 + r32) * 2) = (unsigned short)f2bf(o[d0][r] * rli[r]); }
    if (hi == 0) al_l[r32] = lse;
    asm volatile("s_waitcnt lgkmcnt(0)" ::: "memory");
#pragma unroll
    for (int i = 0; i < 8; ++i) {
        const int row = i * 4 + (lane >> 4), ch = lane & 15;
        const size_t tok = trow0 + rho + (size_t)dil * (i0 + 32 * a + row);
        const v4u ov = *(const LAS v4u*)(stg + row * 256 + ch * 16);
        if constexpr (!MERGE) {
            *(v4u*)(TS.OG + (size_t)(g - 1) * T * D + tok * D + hq * HD + ch * 8) = ov;
            if (ch == 0) TS.LSE[(size_t)(g - 1) * T * NH + tok * NH + hq] = al_l[row];
        } else {
            const float l0 = al_l[row], l1 = TS.LSE[tok * NH + hq], l2 = TS.LSE[(size_t)T * NH + tok * NH + hq];
            const float mx = fmaxf(fmaxf(l0, l1), l2);
            float w0 = __builtin_amdgcn_exp2f(l0 - mx), w1 = __builtin_amdgcn_exp2f(l1 - mx), w2 = __builtin_amdgcn_exp2f(l2 - mx);
            const float inv = __builtin_amdgcn_rcpf(w0 + w1 + w2); w0 *= inv; w1 *= inv; w2 *= inv;
            const v4u o1 = *(const v4u*)(TS.OG + tok * D + hq * HD + ch * 8), o2 = *(const v4u*)(TS.OG + (size_t)T * D + tok * D + hq * HD + ch * 8);
            v4u res;
#pragma unroll
            for (int e = 0; e < 4; ++e) {
                const float lo = w0 * __builtin_bit_cast(float, ov[e] << 16) + w1 * __builtin_bit_cast(float, o1[e] << 16) + w2 * __builtin_bit_cast(float, o2[e] << 16);
                const float hi_ = w0 * __builtin_bit_cast(float, ov[e] & 0xffff0000u) + w1 * __builtin_bit_cast(float, o1[e] & 0xffff0000u) + w2 * __builtin_bit_cast(float, o2[e] & 0xffff0000u);
                res[e] = cvtpk(lo, hi_);
            }
            *(v4u*)(TS.O + tok * D + hq * HD + ch * 8) = res;
        }
    }
    __syncthreads();
}
#undef ATT_KSWZ
#undef ATT_SBAR
}
__device__ __forceinline__ float bf2f(bf16 v) { return __builtin_bit_cast(float, (unsigned)v << 16); }
__device__ __forceinline__ float gelu_tanh(float y) {
    const float k0 = 0.7978845608028654f, k1 = 0.044715f;
    return 0.5f * y * (1.f + tanhf(k0 * (y + k1 * y * y * y)));
}
__device__ __forceinline__ void s5_simple_item(int bg, int p, const float* __restrict__ x, const float* __restrict__ rstd, const float* __restrict__ gn,
        const float* __restrict__ lam_re, const float* __restrict__ lam_im, const float* __restrict__ log_dt,
        const float* __restrict__ b_re, const float* __restrict__ b_im, const float* __restrict__ c_re, const float* __restrict__ c_im,
        const float* __restrict__ d_skip, bf16* __restrict__ z) {
    constexpr int G = SG, P = SP, C = SC, S = SEQ;
    const int b = bg / G, g = bg % G;
    const float lr = lam_re[g * P + p], li = lam_im[g * P + p];
    const float dt = expf(log_dt[g]);
    const float mag = expf(lr * dt), ang = li * dt;
    const float lbr = mag * cosf(ang), lbi = mag * sinf(ang);
    const float nr = lbr - 1.f, den = lr * lr + li * li;
    const float fr = (nr * lr + lbi * li) / den, fi = (lbi * lr - nr * li) / den;
    float bbr[C], bbi[C], cr[C], ci[C];
#pragma unroll
    for (int c = 0; c < C; ++c) {
        const float br = b_re[(g * P + p) * C + c], bi = b_im[(g * P + p) * C + c];
        bbr[c] = fr * br - fi * bi; bbi[c] = fr * bi + fi * br;
        cr[c] = c_re[(g * C + c) * P + p]; ci[c] = c_im[(g * C + c) * P + p];
    }
    const int pc = p & 15;
    const float gnp = gn[g * C + pc], dp = d_skip[g * C + pc];
    float gnc[C];
#pragma unroll
    for (int c = 0; c < C; ++c) gnc[c] = gn[g * C + c];
    float xr = 0.f, xi = 0.f;
    for (int t = 0; t < S; ++t) {
        const size_t row = (size_t)b * S + t;
        const float* xp = x + row * D + g * C;
        const float r = rstd[row];
        float bur = 0.f, bui = 0.f;
#pragma unroll
        for (int c = 0; c < C; ++c) { const float u = xp[c] * r * gnc[c]; bur += bbr[c] * u; bui += bbi[c] * u; }
        const float nxr = lbr * xr - lbi * xi + bur, nxi = lbr * xi + lbi * xr + bui;
        xr = nxr; xi = nxi;
        float myy = 0.f;
#pragma unroll
        for (int c = 0; c < C; ++c) { float v = cr[c] * xr - ci[c] * xi; v = wave_sum(v); if (p == c) myy = v; }
        if (p < C) { const float up = xp[pc] * r * gnp; z[row * D + g * C + p] = (bf16)f2bf(gelu_tanh(myy + dp * up)); }
    }
}
struct Args { const float* in[20]; float* out; unsigned char* ws; int ph_lo, ph_hi; };

__global__ void __launch_bounds__(NWAVES * 64, 2) mk_fwd(Args args) {
    extern __shared__ __attribute__((aligned(16))) unsigned char lds[];
    Frame F;
    F.lds = (LAS unsigned char*)lds;
    F.MISC = (volatile LAS unsigned*)(F.lds + MISC_OFF);
    F.tid = threadIdx.x; F.lane = F.tid & 63; F.wave = __builtin_amdgcn_readfirstlane(F.tid >> 6);
    F.G = gridDim.x; { const int bx = blockIdx.x; F.vcu = (F.G % 8 == 0) ? (bx % 8) * (F.G / 8) + bx / 8 : bx; }
    unsigned char* ws = args.ws;
    F.ctl = (gu32*)(ws + WS_CTL);
    const float* x = args.in[0];
    bf16* WgluT = (bf16*)(ws + WS_WGLU); bf16* Win0T = (bf16*)(ws + WS_WIN0); bf16* Wout0T = (bf16*)(ws + WS_WOUT0); bf16* WqkvT = (bf16*)(ws + WS_WQKV);
    bf16* WoT = (bf16*)(ws + WS_WO); bf16* Win1T = (bf16*)(ws + WS_WIN1); bf16* Wout1T = (bf16*)(ws + WS_WOUT1);
    float* XA = (float*)(ws + WS_XA); bf16* XB = (bf16*)(ws + WS_XB); bf16* ZO = (bf16*)(ws + WS_ZO); bf16* HQ = (bf16*)(ws + WS_HQ);
    bf16* KB = (bf16*)(ws + WS_K); bf16* VB = (bf16*)(ws + WS_V);
    float* rstd0 = (float*)(ws + WS_RSTD0);
    float* rowsq = (float*)(ws + WS_CTL) + CW_ROWSQ;
    for (int u = F.tid; u < (LDS_BYTES - LDSCTL_OFF) / 4; u += NWAVES * 64) ((LAS unsigned*)(F.lds + LDSCTL_OFF))[u] = 0u;
    __syncthreads();
    XcdBarrier bar = xcd_barrier_post((unsigned*)(F.ctl + CW_BAR), F.MISC + 8);
    const int lo = args.ph_lo, hi = args.ph_hi;
#ifndef PHMASK
#define PHMASK 0xFFF
#endif
#define IN(k) (((PHMASK >> (k)) & 1) && lo <= (k) && (k) < hi)
#define BOTH(k) (IN(k) && IN((k) + 1))
#define GRID_BAR() xcd_barrier(bar)

    if (IN(0)) {
        LAS float* scr = (LAS float*)(F.lds + RING_OFF + F.wave * 16384);
        const int gw = F.vcu * NWAVES + F.wave, NGW = F.G * NWAVES;
        constexpr int I0 = (D / 64) * (2 * D / 32), I1 = (D / 64) * (2 * FF / 32), I2 = (FF / 64) * (D / 32), I3 = (D / 64) * (NQ / 32), I4 = (D / 64) * (2 * NKVC / 32), I5 = (D / 64) * (D / 32);
        constexpr int NITEMS = I0 + 2 * I1 + 2 * I2 + I3 + I4 + I5;
        for (int it = gw; it < NITEMS; it += NGW) {
            int r = it;
            if (r < I0) { p0_transpose_item(args.in[9], D, 2 * D, nullptr, WgluT, D, 0, scr, r, F.lane); continue; } r -= I0;
            if (r < I1) { p0_transpose_item(args.in[12], D, 2 * FF, args.in[11], Win0T, FF, 0, scr, r, F.lane); continue; } r -= I1;
            if (r < I2) { p0_transpose_item(args.in[13], FF, D, nullptr, Wout0T, 0, 0, scr, r, F.lane); continue; } r -= I2;
            if (r < I3) { p0_transpose_item(args.in[15], D, NQ, args.in[14], WqkvT, 0, 0, scr, r, F.lane); continue; } r -= I3;
            if (r < I4) { p0_transpose_item(args.in[18], D, 2 * NKVC, args.in[17], WqkvT, 0, NQ, scr, r, F.lane); continue; } r -= I4;
            if (r < I5) { p0_transpose_item(args.in[16], D, D, nullptr, WoT, 0, 0, scr, r, F.lane); continue; } r -= I5;
            if (r < I1) { p0_transpose_item(args.in[12] + (size_t)D * 2 * FF, D, 2 * FF, args.in[11] + D, Win1T, FF, 0, scr, r, F.lane); continue; } r -= I1;
            p0_transpose_item(args.in[13] + (size_t)FF * D, FF, D, nullptr, Wout1T, 0, 0, scr, r, F.lane);
        }
        for (int m = gw; m < T; m += NGW) {
            const GAS f32x4* xr = (const GAS f32x4*)(x + (size_t)m * D) + F.lane; float s = 0.f;
#pragma unroll
            for (int j = 0; j < D / 256; ++j) { const f32x4 v = xr[64 * j]; s += (v.x * v.x + v.y * v.y) + (v.z * v.z + v.w * v.w); }
            s = wave_sum(s);
            if (F.lane == 0) rstd0[m] = 1.0f / sqrtf(s * (1.0f / D) + EPS);
        }
        if (BOTH(0)) GRID_BAR();
    }
    if (IN(1)) {
        static_assert(s5::LDS_END <= LDSCTL_OFF, "s5 LDS map");
        const s5::Params SPm{x, rstd0, args.in[10], args.in[1], args.in[2], args.in[3], args.in[4], args.in[5], args.in[6], args.in[7], args.in[8], ZO};
        for (int it = F.vcu; it < NB * SG; it += F.G) s5::item(SPm, F.lds, it / SG, it % SG, F.tid, F.wave, F.lane);
        if (BOTH(1)) GRID_BAR();
    }
    if (IN(2)) {
        pg8::Gemm g{ZO, WgluT, T, 2 * D, D}; pg8::StaticOrder S; S.init(T, 2 * D, F.G, (int)blockIdx.x);
        pg8::EpiGluRes E{x, XA, XB, rowsq};
        pg8::gemm_phase<pg8::EpiGluRes, pg8::StaticOrder, true, true>(F.lds + RING_OFF, g, S, E);
        if (BOTH(2)) GRID_BAR();
    }
    if (IN(3)) {
        pg8::Gemm g{XB, Win0T, T, 2 * FF, D}; pg8::StaticOrder S; S.init(T, 2 * FF, F.G, (int)blockIdx.x);
        pg8::EpiSwiGlu E{rowsq, HQ, FF};
        pg8::gemm_phase<pg8::EpiSwiGlu, pg8::StaticOrder, true, true>(F.lds + RING_OFF, g, S, E);
        if (BOTH(3)) GRID_BAR();
    }
    if (IN(4)) {
        pg8::Gemm g{HQ, Wout0T, T, D, FF}; pg8::StaticOrder S; S.init(T, D, F.G, (int)blockIdx.x);
        pg8::EpiRes<true> E{XA, XB, rowsq + T};
        pg8::gemm_phase<pg8::EpiRes<true>, pg8::StaticOrder, true, true>(F.lds + RING_OFF, g, S, E);
        if (BOTH(4)) GRID_BAR();
    }
    if (IN(5)) {
        pg8::Gemm g{XB, WqkvT, T, NQKV, D}; pg8::StaticOrder S; S.init(T, NQKV, F.G, (int)blockIdx.x);
        pg8::EpiQKV E{rowsq + T, HQ, KB, VB, QSCALE};
        pg8::gemm_phase<pg8::EpiQKV, pg8::StaticOrder, true, true>(F.lds + RING_OFF, g, S, E);
        if (BOTH(5)) GRID_BAR();
    }
    if (IN(6)) {
        static_assert(att::LDS_END <= LDSCTL_OFF, "att LDS map");
        const att::Tensors TS{HQ, KB, VB, (bf16*)(ws + WS_OG), (float*)(ws + WS_LSE), ZO};
        for (int u = blockIdx.x; u < 8 * 128; u += F.G) {
            const int pair = u & 7, v = u >> 3, g = 1 + (v >> 6), w = v & 63;
            const int rho = (g == 1) ? (w & 3) : (w & 15), qb = (g == 1) ? (w >> 2) : (w >> 4);
            att::unit<false>(TS, F.lds, pair, g, rho, qb, F.tid, F.wave, F.lane);
        }
        if (BOTH(6)) GRID_BAR();
    }
    if (IN(7)) {
        const att::Tensors TS{HQ, KB, VB, (bf16*)(ws + WS_OG), (float*)(ws + WS_LSE), ZO};
        for (int u = blockIdx.x; u < 8 * 64; u += F.G) att::unit<true>(TS, F.lds, u & 7, 0, 0, u >> 3, F.tid, F.wave, F.lane);
        if (BOTH(7)) GRID_BAR();
    }
    if (IN(8)) {
        pg8::Gemm g{ZO, WoT, T, D, D}; pg8::StaticOrder S; S.init(T, D, F.G, (int)blockIdx.x);
        pg8::EpiRes<true> E{XA, XB, rowsq + 2 * T};
        pg8::gemm_phase<pg8::EpiRes<true>, pg8::StaticOrder, true, true>(F.lds + RING_OFF, g, S, E);
        if (BOTH(8)) GRID_BAR();
    }
    if (IN(9)) {
        pg8::Gemm g{XB, Win1T, T, 2 * FF, D}; pg8::StaticOrder S; S.init(T, 2 * FF, F.G, (int)blockIdx.x);
        pg8::EpiSwiGlu E{rowsq + 2 * T, HQ, FF};
        pg8::gemm_phase<pg8::EpiSwiGlu, pg8::StaticOrder, true, true>(F.lds + RING_OFF, g, S, E);
        if (BOTH(9)) GRID_BAR();
    }
    if (IN(10)) {
        pg8::Gemm g{HQ, Wout1T, T, D, FF}; pg8::StaticOrder S; S.init(T, D, F.G, (int)blockIdx.x);
        pg8::EpiRes<true> E{XA, XB, rowsq + 3 * T};
        pg8::gemm_phase<pg8::EpiRes<true>, pg8::StaticOrder, true, true>(F.lds + RING_OFF, g, S, E);
        if (BOTH(10)) GRID_BAR();
    }
    if (IN(11)) {
        const int gw = F.vcu * NWAVES + F.wave, NGW = F.G * NWAVES;
        const GAS f32x4* gr = (const GAS f32x4*)args.in[19] + F.lane;
        for (int m = gw; m < T; m += NGW) {
            const GAS f32x4* xr = (const GAS f32x4*)(XA + (size_t)m * D) + F.lane; GAS f32x4* orow = (GAS f32x4*)(args.out + (size_t)m * D) + F.lane;
            f32x4 v[D / 256]; float s = 0.f;
#pragma unroll
            for (int j = 0; j < D / 256; ++j) { v[j] = xr[64 * j]; s += (v[j].x * v[j].x + v[j].y * v[j].y) + (v[j].z * v[j].z + v[j].w * v[j].w); }
            s = wave_sum(s);
            const float r = 1.0f / sqrtf(s * (1.0f / D) + EPS);
#pragma unroll
            for (int j = 0; j < D / 256; ++j) orow[64 * j] = v[j] * r * gr[64 * j];
        }
    }
#undef IN
#undef BOTH
#undef GRID_BAR
}

extern "C" void kernel_launch(void* const* d_in, const int* in_sizes, int n_in, void* d_out, int out_size, void* d_ws, size_t ws_size, hipStream_t stream) {
    static int grid = 0;
    if (grid == 0) {
        if (n_in != 20 || out_size != T * D || ws_size < WS_END) { fprintf(stderr, "kernel_launch: unexpected shapes/ws (n_in %d out %d ws %zu)\n", n_in, out_size, ws_size); grid = -1; return; }
        int dev = 0, cus = 0;
        if (hipGetDevice(&dev) != hipSuccess || hipDeviceGetAttribute(&cus, hipDeviceAttributeMultiprocessorCount, dev) != hipSuccess) { grid = -1; return; }
        if (hipFuncSetAttribute((const void*)mk_fwd, hipFuncAttributeMaxDynamicSharedMemorySize, LDS_BYTES) != hipSuccess) { fprintf(stderr, "kernel_launch: hipFuncSetAttribute failed\n"); grid = -1; return; }
        (void)hipGetLastError();
        grid = cus;
    }
    if (grid < 0) return;
    (void)hipMemsetAsync((char*)d_ws + WS_CTL, 0, CTL_ZERO_BYTES, stream);
    Args a{};
    for (int i = 0; i < 20; ++i) a.in[i] = (const float*)d_in[i];
    a.out = (float*)d_out; a.ws = (unsigned char*)d_ws;
    unsigned char* ws = (unsigned char*)d_ws;
#define LAUNCH(lo_, hi_) do { a.ph_lo = (lo_); a.ph_hi = (hi_); hipLaunchKernelGGL(mk_fwd, dim3(grid), dim3(NWAVES * 64), LDS_BYTES, stream, a); } while (0)
    LAUNCH(0, 12);
#undef LAUNCH
}
```

```cpp
#include <hip/hip_runtime.h>
#include <cstdint>
#include <cstdio>
namespace pg8 {
#define PG8_LAS __attribute__((address_space(3)))
typedef unsigned short bf16_t;
typedef short bf16x8 __attribute__((ext_vector_type(8)));
typedef float f32x4 __attribute__((ext_vector_type(4)));
typedef unsigned u32x4 __attribute__((ext_vector_type(4)));
constexpr int BM = 256, BK = 64, HALF = 128, HTB = HALF * BK * 2  , STAGE_BYTES = 8 * HTB, NXCD = 8, WGM = 8;

__host__ __device__ __forceinline__ int lds_byte(int r, int c) { const int st = (r >> 4) * 2 + (c >> 5), rr = r & 15, cc = c & 31, ob = rr * 64 + cc * 2; return st * 1024 + (ob ^ (((ob >> 9) & 1) << 5)); }
__host__ __device__ __forceinline__ void stage_rc(int b, int& R, int& C) { const int st = b / 1024, sb = b % 1024, swz = sb ^ (((sb >> 9) & 1) << 5); R = (st >> 1) * 16 + swz / 64; C = (st & 1) * 32 + (swz % 64) / 2; }
__host__ __device__ __forceinline__ int perm32(int rho) { const int n = rho >> 4, i = rho & 15; return 8 * (i >> 2) + 4 * n + (i & 3); }

struct Unit { int pm, pn; };
struct Gemm { const bf16_t* A; const bf16_t* Bt; int M, N, K; };

struct StaticOrder {
    int nM, nN, nwg, G, c;
    __host__ __device__ void init(int M, int N, int G_, int c_) { nM = M / BM; nN = N / BM; nwg = nM * nN; G = G_; c = c_; }
    __host__ __device__ bool next(int i, Unit& u) const {
        const long L = (long)i * G + c; if (L >= nwg) return false;
        int wgid = (int)L; { const int q = nwg / NXCD, r = nwg % NXCD, xcd = wgid % NXCD, off = wgid / NXCD; wgid = (xcd < r ? xcd * (q + 1) : r * (q + 1) + (xcd - r) * q) + off; }
        const int nig = WGM * nN, gid = wgid / nig, fm = gid * WGM, gsz = (nM - fm) < WGM ? (nM - fm) : WGM;
        u.pm = fm + ((wgid % nig) % gsz); u.pn = (wgid % nig) / gsz; return true;
    }
    __device__ __forceinline__ void a_ready(const Unit&) const {}
    __device__ __forceinline__ void done(const Unit&) const {}
};

__device__ __forceinline__ unsigned cvt_pk_bf16(float lo, float hi) { unsigned r; asm volatile("v_cvt_pk_bf16_f32 %0, %1, %2" : "=v"(r) : "v"(lo), "v"(hi)); return r; }
__device__ __forceinline__ float sigm(float v) { return __builtin_amdgcn_rcpf(1.0f + __builtin_amdgcn_exp2f(v * -1.4426950408889634f)); }
__device__ __forceinline__ u32x4 pack8(const f32x4& a, const f32x4& b) { u32x4 w; w.x = cvt_pk_bf16(a[0], a[1]); w.y = cvt_pk_bf16(a[2], a[3]); w.z = cvt_pk_bf16(b[0], b[1]); w.w = cvt_pk_bf16(b[2], b[3]); return w; }
constexpr int DM = 2048;
constexpr float NORM_EPS = 1e-6f;

struct EpiGluRes {
    static constexpr bool PERM = true, AFTER_DRAIN = false;
    const float* res; float* XA; bf16_t* XB; float* rowsq;
    __device__ __forceinline__ void operator()(const f32x4 (&acc)[2][2][4][2], const Unit& u, int wr, int wc, int fr, int fq) const {
        const int row0 = u.pm * BM + wr * 64 + fr, col0 = u.pn * HALF + wc * 32 + 8 * fq;
#pragma unroll
        for (int ai = 0; ai < 2; ++ai)
#pragma unroll
            for (int m = 0; m < 4; ++m) {
                const int row = row0 + ai * HALF + m * 16; const size_t off = (size_t)row * DM + col0;
                const f32x4 r0 = *(const f32x4*)(res + off), r1 = *(const f32x4*)(res + off + 4);
                f32x4 v0, v1;
#pragma unroll
                for (int j = 0; j < 4; ++j) { v0[j] = r0[j] + acc[ai][0][m][0][j] * sigm(acc[ai][1][m][0][j]); v1[j] = r1[j] + acc[ai][0][m][1][j] * sigm(acc[ai][1][m][1][j]); }
                *(f32x4*)(XA + off) = v0; *(f32x4*)(XA + off + 4) = v1;
                *(u32x4*)(XB + off) = pack8(v0, v1);
                float s = (v0[0] * v0[0] + v0[1] * v0[1]) + (v0[2] * v0[2] + v0[3] * v0[3]) + (v1[0] * v1[0] + v1[1] * v1[1]) + (v1[2] * v1[2] + v1[3] * v1[3]);
                s += __shfl_xor(s, 16); s += __shfl_xor(s, 32);
                if (fq == 0) atomicAdd(rowsq + row, s);
            }
    }
};
struct EpiSwiGlu {
    static constexpr bool PERM = true, AFTER_DRAIN = false;
    const float* rowsq; bf16_t* H; int ldh;
    __device__ __forceinline__ void operator()(const f32x4 (&acc)[2][2][4][2], const Unit& u, int wr, int wc, int fr, int fq) const {
        const int row0 = u.pm * BM + wr * 64 + fr, col0 = u.pn * HALF + wc * 32 + 8 * fq;
#pragma unroll
        for (int ai = 0; ai < 2; ++ai)
#pragma unroll
            for (int m = 0; m < 4; ++m) {
                const int row = row0 + ai * HALF + m * 16;
                const float rs = __builtin_amdgcn_rsqf(rowsq[row] * (1.0f / DM) + NORM_EPS);
                f32x4 v0, v1;
#pragma unroll
                for (int j = 0; j < 4; ++j) { const float g0 = acc[ai][0][m][0][j] * rs, g1 = acc[ai][0][m][1][j] * rs;
                    v0[j] = g0 * sigm(g0) * (acc[ai][1][m][0][j] * rs); v1[j] = g1 * sigm(g1) * (acc[ai][1][m][1][j] * rs); }
                *(u32x4*)(H + (size_t)row * ldh + col0) = pack8(v0, v1);
            }
    }
};
template <bool WRITE_XB> struct EpiRes {
    static constexpr bool PERM = true, AFTER_DRAIN = false;
    float* XA; bf16_t* XB; float* rowsq;
    __device__ __forceinline__ void operator()(const f32x4 (&acc)[2][2][4][2], const Unit& u, int wr, int wc, int fr, int fq) const {
        const int row0 = u.pm * BM + wr * 64 + fr, col0 = u.pn * BM + wc * 32 + 8 * fq;
#pragma unroll
        for (int ai = 0; ai < 2; ++ai)
#pragma unroll
            for (int m = 0; m < 4; ++m) {
                const int row = row0 + ai * HALF + m * 16; float s = 0.f;
#pragma unroll
                for (int bj = 0; bj < 2; ++bj) {
                    const size_t off = (size_t)row * DM + col0 + bj * HALF;
                    const f32x4 v0 = *(const f32x4*)(XA + off) + acc[ai][bj][m][0], v1 = *(const f32x4*)(XA + off + 4) + acc[ai][bj][m][1];
                    *(f32x4*)(XA + off) = v0; *(f32x4*)(XA + off + 4) = v1;
                    if (WRITE_XB) *(u32x4*)(XB + off) = pack8(v0, v1);
                    s += (v0[0] * v0[0] + v0[1] * v0[1]) + (v0[2] * v0[2] + v0[3] * v0[3]) + (v1[0] * v1[0] + v1[1] * v1[1]) + (v1[2] * v1[2] + v1[3] * v1[3]);
                }
                s += __shfl_xor(s, 16); s += __shfl_xor(s, 32);
                if (fq == 0) atomicAdd(rowsq + row, s);
            }
    }
};
struct EpiQKV {
    static constexpr bool PERM = true, AFTER_DRAIN = false;
    const float* rowsq; bf16_t* Q; bf16_t* K; bf16_t* V; float qscale;
    __device__ __forceinline__ void operator()(const f32x4 (&acc)[2][2][4][2], const Unit& u, int wr, int wc, int fr, int fq) const {
        const int row0 = u.pm * BM + wr * 64 + fr;
        bf16_t* base; int ld, colt; float sc = 1.f;
        if (u.pn < 24) { base = Q; ld = 6144; colt = u.pn * BM; sc = qscale; }
        else if (u.pn < 26) { base = K; ld = 512; colt = (u.pn - 24) * BM; }
        else { base = V; ld = 512; colt = (u.pn - 26) * BM; }
        const int col0 = colt + wc * 32 + 8 * fq;
#pragma unroll
        for (int ai = 0; ai < 2; ++ai)
#pragma unroll
            for (int m = 0; m < 4; ++m) {
                const int row = row0 + ai * HALF + m * 16;
                const float rs = __builtin_amdgcn_rsqf(rowsq[row] * (1.0f / DM) + NORM_EPS) * sc;
#pragma unroll
                for (int bj = 0; bj < 2; ++bj) *(u32x4*)(base + (size_t)row * ld + col0 + bj * HALF) = pack8(acc[ai][bj][m][0] * rs, acc[ai][bj][m][1] * rs);
            }
    }
};
template <class Epi, class Sched, bool ALIGN_EPI = false, bool SP2 = false>
__device__ __forceinline__ void gemm_phase(PG8_LAS unsigned char* lds, const Gemm g, const Sched& S, const Epi& E) {
    int tid_ = threadIdx.x; asm volatile("" : "+v"(tid_));
    const int tid = tid_, wid = __builtin_amdgcn_readfirstlane(tid >> 6), lane = tid & 63, wr = wid >> 2, wc = wid & 3, fr = lane & 15, fq = lane >> 4;
    const int K = g.K, nt = K / BK;
    unsigned voffA[2], voffB[2];
#pragma unroll
    for (int i = 0; i < 2; ++i) { int R, C; stage_rc(tid * 16 + i * 8192, R, C); const int Rb = Epi::PERM ? ((R & ~31) + perm32(R & 31)) : R;
        voffA[i] = (unsigned)(R * K + C) * 2u; voffB[i] = (unsigned)(Rb * K + C) * 2u; }
    const size_t kstep = (size_t)(BK * 2);
    const size_t hstep = (size_t)HALF * K * 2;
    const size_t tstep = 2 * hstep;
    const unsigned ldsw = (unsigned)wid * 1024u;
    const int aoff = lds_byte(wr * 64 + fr, fq * 8), boff = lds_byte(wc * 32 + fr, fq * 8);
#define PG8_SA(b, h) (((b) * 2 + (h)) * HTB)
#define PG8_SB(b, h) ((4 + (b) * 2 + (h)) * HTB)
#define PG8_STAGE(bufoff, gbase, voff) do { _Pragma("unroll") for (int _i = 0; _i < 2; ++_i) \
        __builtin_amdgcn_global_load_lds((const unsigned*)((const char*)(gbase) + (voff)[_i]), (PG8_LAS unsigned*)(lds + (bufoff) + ldsw + _i * 8192), 16, 0, 0); } while (0)
#define PG8_LDA(dst, b, h) do { _Pragma("unroll") for (int m = 0; m < 4; ++m) _Pragma("unroll") for (int k = 0; k < 2; ++k) dst[m][k] = *(const PG8_LAS bf16x8*)(lds + PG8_SA(b, h) + aoff + m * 2048 + k * 1024); } while (0)
#define PG8_LDB(dst, b, h) do { _Pragma("unroll") for (int n = 0; n < 2; ++n) _Pragma("unroll") for (int k = 0; k < 2; ++k) dst[n][k] = *(const PG8_LAS bf16x8*)(lds + PG8_SB(b, h) + boff + n * 2048 + k * 1024); } while (0)
#define PG8_MMA(ai, bj, At, Bt) do { __builtin_amdgcn_s_setprio(1); _Pragma("unroll") for (int m = 0; m < 4; ++m) _Pragma("unroll") for (int n = 0; n < 2; ++n) _Pragma("unroll") for (int k = 0; k < 2; ++k) \
        acc[ai][bj][m][n] = __builtin_amdgcn_mfma_f32_16x16x32_bf16(Bt[n][k], At[m][k], acc[ai][bj][m][n], 0, 0, 0); __builtin_amdgcn_s_setprio(0); } while (0)
#define PG8_WAIT_V(n) asm volatile("s_waitcnt vmcnt(" #n ")" ::: "memory")
#define PG8_WAIT_L(n) asm volatile("s_waitcnt lgkmcnt(" #n ")" ::: "memory")
#define PG8_BAR __builtin_amdgcn_s_barrier()
#define PG8_SCHED __builtin_amdgcn_sched_barrier(0)
    Unit cur, nxt; int ui = 0;
    if (!S.next(0, cur)) return;
    f32x4 acc[2][2][4][2];
#pragma unroll
    for (int a = 0; a < 2; ++a)
#pragma unroll
        for (int b = 0; b < 2; ++b)
#pragma unroll
            for (int m = 0; m < 4; ++m)
#pragma unroll
                for (int n = 0; n < 2; ++n) acc[a][b][m][n] = (f32x4){0.f, 0.f, 0.f, 0.f};
    bf16x8 At[4][2], B0[2][2], B1[2][2];
    const char* cA = (const char*)g.A + (size_t)cur.pm * tstep; const char* cB = (const char*)g.Bt + (size_t)cur.pn * tstep;
    S.a_ready(cur);
    if constexpr (SP2) {
        PG8_STAGE(PG8_SB(0, 0), cB, voffB); PG8_STAGE(PG8_SB(0, 1), cB + hstep, voffB); PG8_STAGE(PG8_SA(0, 0), cA, voffA); PG8_STAGE(PG8_SA(0, 1), cA + hstep, voffA);
        if (wr == 1) PG8_BAR;
        PG8_WAIT_V(2); PG8_BAR;
        PG8_STAGE(PG8_SB(1, 0), cB + kstep, voffB); PG8_STAGE(PG8_SA(1, 0), cA + kstep, voffA); PG8_STAGE(PG8_SB(1, 1), cB + hstep + kstep, voffB);
        PG8_WAIT_V(6); PG8_BAR;
    } else {
        PG8_STAGE(PG8_SB(0, 0), cB, voffB); PG8_STAGE(PG8_SA(0, 0), cA, voffA); PG8_STAGE(PG8_SB(0, 1), cB + hstep, voffB); PG8_STAGE(PG8_SA(0, 1), cA + hstep, voffA);
        if (wr == 1) PG8_BAR;
        PG8_WAIT_V(4); PG8_BAR;
        PG8_STAGE(PG8_SB(1, 0), cB + kstep, voffB); PG8_STAGE(PG8_SA(1, 0), cA + kstep, voffA); PG8_STAGE(PG8_SB(1, 1), cB + hstep + kstep, voffB);
        PG8_WAIT_V(6); PG8_BAR;
    }
    for (;;) {
        const bool has_next = S.next(ui + 1, nxt);
        const char* nA = has_next ? (const char*)g.A + (size_t)nxt.pm * tstep : cA; const char* nB = has_next ? (const char*)g.Bt + (size_t)nxt.pn * tstep : cB;
        for (int t = 0; t < nt; t += 2) {
            const bool last = (t == nt - 2);
            const char* a1 = cA + (size_t)(t + 1) * kstep;
            const char* a2 = last ? nA : cA + (size_t)(t + 2) * kstep; const char* b2 = last ? nB : cB + (size_t)(t + 2) * kstep;
            const char* a3 = a2 + kstep; const char* b3 = b2 + kstep;
            if (last && has_next) S.a_ready(nxt);
            if constexpr (SP2) {
            PG8_LDB(B0, 0, 0); PG8_LDB(B1, 0, 1); PG8_SCHED; PG8_LDA(At, 0, 0); PG8_STAGE(PG8_SA(1, 1), a1 + hstep, voffA);
            PG8_WAIT_V(8); PG8_WAIT_L(0); PG8_BAR; PG8_MMA(0, 0, At, B0); PG8_MMA(0, 1, At, B1); PG8_BAR; PG8_SCHED;
            PG8_LDA(At, 0, 1); PG8_STAGE(PG8_SB(0, 0), b2, voffB); PG8_STAGE(PG8_SB(0, 1), b2 + hstep, voffB); PG8_STAGE(PG8_SA(0, 0), a2, voffA);
            PG8_WAIT_V(8); PG8_WAIT_L(0); PG8_BAR; PG8_MMA(1, 0, At, B0); PG8_MMA(1, 1, At, B1); PG8_BAR; PG8_SCHED;
            PG8_LDB(B0, 1, 0); PG8_LDB(B1, 1, 1); PG8_SCHED; PG8_LDA(At, 1, 0); PG8_STAGE(PG8_SA(0, 1), a2 + hstep, voffA);
            PG8_WAIT_V(8); PG8_WAIT_L(0); PG8_BAR; PG8_MMA(0, 0, At, B0); PG8_MMA(0, 1, At, B1); PG8_BAR; PG8_SCHED;
            PG8_LDA(At, 1, 1); PG8_STAGE(PG8_SB(1, 0), b3, voffB); PG8_STAGE(PG8_SB(1, 1), b3 + hstep, voffB); PG8_STAGE(PG8_SA(1, 0), a3, voffA);
            PG8_WAIT_V(8); PG8_WAIT_L(0); PG8_BAR; PG8_MMA(1, 0, At, B0); PG8_MMA(1, 1, At, B1); PG8_BAR; PG8_SCHED;
            } else {
            PG8_LDB(B0, 0, 0); PG8_SCHED; PG8_LDA(At, 0, 0); PG8_STAGE(PG8_SA(1, 1), a1 + hstep, voffA);
            PG8_WAIT_L(8); PG8_BAR; PG8_WAIT_L(0); PG8_MMA(0, 0, At, B0); PG8_BAR; PG8_SCHED;
            PG8_LDB(B1, 0, 1); PG8_STAGE(PG8_SB(0, 0), b2, voffB);
            PG8_BAR; PG8_WAIT_L(0); PG8_MMA(0, 1, At, B1); PG8_BAR;
            PG8_LDA(At, 0, 1); PG8_STAGE(PG8_SA(0, 0), a2, voffA);
            PG8_BAR; PG8_WAIT_L(0); PG8_MMA(1, 0, At, B0); PG8_BAR; PG8_SCHED;
            PG8_STAGE(PG8_SB(0, 1), b2 + hstep, voffB);
            PG8_WAIT_V(6); PG8_BAR; PG8_MMA(1, 1, At, B1); PG8_BAR;
            PG8_LDB(B0, 1, 0); PG8_SCHED; PG8_LDA(At, 1, 0); PG8_STAGE(PG8_SA(0, 1), a2 + hstep, voffA);
            PG8_WAIT_L(8); PG8_BAR; PG8_WAIT_L(0); PG8_MMA(0, 0, At, B0); PG8_BAR; PG8_SCHED;
            PG8_LDB(B1, 1, 1); PG8_STAGE(PG8_SB(1, 0), b3, voffB);
            PG8_BAR; PG8_WAIT_L(0); PG8_MMA(0, 1, At, B1); PG8_BAR;
            PG8_LDA(At, 1, 1); PG8_STAGE(PG8_SA(1, 0), a3, voffA);
            PG8_BAR; PG8_WAIT_L(0); PG8_MMA(1, 0, At, B0); PG8_BAR; PG8_SCHED;
            PG8_STAGE(PG8_SB(1, 1), b3 + hstep, voffB);
            PG8_WAIT_V(6); PG8_BAR; PG8_MMA(1, 1, At, B1); PG8_BAR;
            }
        }
        if constexpr (ALIGN_EPI) { if (wr == 0) PG8_BAR; }
        if constexpr (!Epi::AFTER_DRAIN) { E(acc, cur, wr, wc, fr, fq); S.done(cur); }
        if (!has_next) break;
#pragma unroll
        for (int a = 0; a < 2; ++a)
#pragma unroll
            for (int b = 0; b < 2; ++b)
#pragma unroll
                for (int m = 0; m < 4; ++m)
#pragma unroll
                    for (int n = 0; n < 2; ++n) acc[a][b][m][n] = (f32x4){0.f, 0.f, 0.f, 0.f};
        cur = nxt; cA = nA; cB = nB; ++ui;
        if constexpr (ALIGN_EPI) { if (wr == 1) PG8_BAR; }
    }
    PG8_WAIT_V(0);
    if constexpr (!ALIGN_EPI) { if (wr == 0) PG8_BAR; }
    PG8_BAR;
    if constexpr (Epi::AFTER_DRAIN) { E.fused(acc, cur, wr, wc, fr, fq, lds, wid, lane); S.done(cur); }
#undef PG8_SA
#undef PG8_SB
#undef PG8_STAGE
#undef PG8_LDA
#undef PG8_LDB
#undef PG8_MMA
#undef PG8_WAIT_V
#undef PG8_WAIT_L
#undef PG8_BAR
#undef PG8_SCHED
}
}
#define GAS __attribute__((address_space(1)))
#define LAS __attribute__((address_space(3)))
typedef unsigned short bf16;
typedef unsigned v4u __attribute__((ext_vector_type(4)));
typedef float f32x4 __attribute__((ext_vector_type(4)));
typedef short bf16x8 __attribute__((ext_vector_type(8)));
typedef GAS unsigned gu32;
typedef GAS unsigned long long gu64;
#define RLX_AGENT __ATOMIC_RELAXED, __HIP_MEMORY_SCOPE_AGENT
#define LDS_WAIT() asm volatile("s_waitcnt lgkmcnt(0)" ::: "memory")
#define VM_WAIT() asm volatile("s_waitcnt vmcnt(0)" ::: "memory")
__device__ __forceinline__ unsigned long long rt() { return __builtin_amdgcn_s_memrealtime(); }
__device__ __forceinline__ unsigned f2bf(float f) { unsigned u = __builtin_bit_cast(unsigned, f); return (u + 0x7fffu + ((u >> 16) & 1u)) >> 16; }
__device__ __forceinline__ unsigned pk2(float lo, float hi) { return f2bf(lo) | (f2bf(hi) << 16); }

#define XB_TMO      128
#define XB_XCNT(j)  (256  + 64 * (j))
#define XB_XSUB(j)  (1280 + 64 * (j))
#define XB_XGEN(j)  (2304 + 64 * (j))
#define XB_TOP      3328
#define XB_TOPGEN   3392
#define XCD_BAR_WORDS 3456
#define XB_SPIN_CAP (1u << 18)

__device__ __forceinline__ unsigned xb_ld(unsigned* p)              { return __hip_atomic_load(p, __ATOMIC_RELAXED, __HIP_MEMORY_SCOPE_AGENT); }
__device__ __forceinline__ unsigned xb_add(unsigned* p, unsigned v) { return __hip_atomic_fetch_add(p, v, __ATOMIC_RELAXED, __HIP_MEMORY_SCOPE_AGENT); }
__device__ __forceinline__ unsigned xb_xcc_id() { return (unsigned)__builtin_amdgcn_s_getreg((3 << 11) | 20) & 0xFu; }
#define XB_SPIN(cond, bar) do { unsigned _sp = 0; while (cond) { __builtin_amdgcn_s_sleep(1); \
    if ((++_sp & 255u) == 0u) { if (xb_ld(&(bar)[XB_TMO])) break; if (_sp > XB_SPIN_CAP) { atomicAdd(&(bar)[XB_TMO], 1u); break; } } } } while (0)

struct XcdBarrier {
    unsigned* bar; unsigned x;
    volatile LAS unsigned* st;
};

__device__ __forceinline__ XcdBarrier xcd_barrier_post(unsigned* bar, volatile LAS unsigned* st) {
    XcdBarrier b; b.bar = bar; b.x = xb_xcc_id(); b.st = st;
    if (threadIdx.x == 0) (void)xb_add(&bar[XB_XCNT(b.x)], 1u);
    return b;
}
__device__ __forceinline__ void xcd_barrier_complete(unsigned* bar, unsigned x, unsigned& nloc, unsigned& nx) {
    const unsigned G = gridDim.x * gridDim.y * gridDim.z;
    unsigned sum, cnt, mine, sp = 0u;
    for (;;) {
        sum = 0u; cnt = 0u; mine = 0u;
#pragma unroll
        for (unsigned j = 0; j < 16; ++j) { const unsigned c = xb_ld(&bar[XB_XCNT(j)]); sum += c; cnt += (c > 0u) ? 1u : 0u; mine = (j == x) ? c : mine; }
        if (sum == G) break;
        __builtin_amdgcn_s_sleep(1);
        if ((++sp & 255u) == 0u) { if (xb_ld(&bar[XB_TMO])) break; if (sp > XB_SPIN_CAP) { atomicAdd(&bar[XB_TMO], 1u); break; } }
    }
    nloc = mine > 0u ? mine : 1u; nx = cnt > 0u ? cnt : 1u;
}

__device__ __forceinline__ void xcd_barrier(const XcdBarrier& b) {
    asm volatile("s_waitcnt vmcnt(0)" ::: "memory");
    __syncthreads();
    if (threadIdx.x == 0) {
        unsigned* bar = b.bar;
        __builtin_amdgcn_s_waitcnt(0);
        unsigned nloc = b.st[0], nx = b.st[1];
        if (nloc == 0u) { xcd_barrier_complete(bar, b.x, nloc, nx); b.st[0] = nloc; b.st[1] = nx; }
        const unsigned old = xb_add(&bar[XB_XSUB(b.x)], 1u);
        const unsigned gen = old / nloc;
        if (old + 1u == (gen + 1u) * nloc) {
            __builtin_amdgcn_fence(__ATOMIC_RELEASE, "agent");
            asm volatile("s_waitcnt vmcnt(0)" ::: "memory");
            const unsigned og = xb_add(&bar[XB_TOP], 1u);
            const unsigned tg = og / nx;
            if (og + 1u == (tg + 1u) * nx) xb_add(&bar[XB_TOPGEN], 1u);
            else XB_SPIN(xb_ld(&bar[XB_TOPGEN]) == tg, bar);
            __builtin_amdgcn_fence(__ATOMIC_ACQUIRE, "agent");
            xb_add(&bar[XB_XGEN(b.x)], 1u);
            asm volatile("s_waitcnt vmcnt(0)" ::: "memory");
        } else {
            XB_SPIN(xb_ld(&bar[XB_XGEN(b.x)]) == gen, bar);
            __builtin_amdgcn_fence(__ATOMIC_ACQUIRE, "agent");
            asm volatile("s_waitcnt vmcnt(0)" ::: "memory");
        }
    }
    __syncthreads();
}
constexpr int NWAVES = 8;
constexpr int D = 2048, NB = 2, SEQ = 4096, T = NB * SEQ;
constexpr int SG = 128, SP = 64, SC = 16;
constexpr int NH = 16, HD = 128, NKV = 4, NGRP = 3;
constexpr int FF = 5632;
constexpr int NQ = NGRP * NH * HD, NKVC = NKV * HD;
constexpr int NQKV = NQ + 2 * NKVC;
constexpr float EPS = 1e-6f;
constexpr float QSCALE = 0.08838834764831845f * 1.4426950408889634f;

constexpr size_t MiB = 1u << 20;
constexpr size_t WS_CTL = 0, CTL_ZERO_BYTES = 1 * MiB;
constexpr size_t WS_RSTD0 = 1 * MiB;
constexpr size_t WS_WGLU = 2 * MiB, WS_WIN0 = 18 * MiB, WS_WOUT0 = 62 * MiB, WS_WQKV = 84 * MiB, WS_WO = 112 * MiB, WS_WIN1 = 120 * MiB, WS_WOUT1 = 164 * MiB;
constexpr size_t WS_XA = 186 * MiB;
constexpr size_t WS_XB = 250 * MiB;
constexpr size_t WS_ZO = 282 * MiB;
constexpr size_t WS_HQ = 314 * MiB;
constexpr size_t WS_K = 410 * MiB, WS_V = 418 * MiB;
constexpr size_t WS_OG = 426 * MiB;
constexpr size_t WS_LSE = 522 * MiB;
constexpr size_t WS_END = 524 * MiB;
constexpr int CW_TMO = 0, CW_CODE = 1, CW_BAR = 4096;
constexpr int CW_ROWSQ = 16384;
static_assert((CW_ROWSQ + 4 * T) * 4 <= (int)CTL_ZERO_BYTES, "ctl");

constexpr int RING_OFF = 0, RING_BYTES = 131072;
constexpr int LDSCTL_OFF = 155648, MISC_OFF = LDSCTL_OFF + 320;
constexpr int LDS_BYTES = 163840;

struct Frame {
    LAS unsigned char* lds;
    volatile LAS unsigned* MISC;
    gu32* ctl;
    int tid, lane, wave;
    int vcu, G;
};

__device__ __forceinline__ float wave_sum(float v) {
#pragma unroll
    for (int o = 1; o < 64; o <<= 1) v += __shfl_xor(v, o);
    return v;
}
__device__ __forceinline__ float wave_max(float v) {
#pragma unroll
    for (int o = 1; o < 64; o <<= 1) v = fmaxf(v, __shfl_xor(v, o));
    return v;
}
__device__ __forceinline__ void p0_transpose_item(const float* W, int K, int N, const float* gain, bf16* WT, int Nh, int row_off, LAS float* scr, int item, int lane) {
    const int nblk = N / 64, kb = item / nblk, nb = item % nblk, k0 = 64 * kb, n0 = 64 * nb;
    const int nq = lane & 15, kr = lane >> 4;
    f32x4 v[16];
#pragma unroll
    for (int j = 0; j < 16; ++j) v[j] = *(const GAS f32x4*)(W + (size_t)(k0 + 4 * j + kr) * N + n0 + 4 * nq);
    if (gain) {
#pragma unroll
        for (int j = 0; j < 16; ++j) v[j] = v[j] * gain[k0 + 4 * j + kr];
    }
#pragma unroll
    for (int j = 0; j < 16; ++j) { LAS float* d = scr + (4 * j + kr) * 65 + 4 * nq; d[0] = v[j].x; d[1] = v[j].y; d[2] = v[j].z; d[3] = v[j].w; }
    LDS_WAIT(); asm volatile("" ::: "memory");
    int drow0 = row_off + n0;
    if (Nh) { const int nn = n0 % Nh; drow0 = 256 * (nn / 128) + 128 * (n0 / Nh) + (nn % 128); }
    const int oct = lane & 7, ns = lane >> 3;
#pragma unroll
    for (int i = 0; i < 8; ++i) { const int n = 8 * i + ns; const LAS float* s = scr + (8 * oct) * 65 + n;
        v4u o; o.x = pk2(s[0 * 65], s[1 * 65]); o.y = pk2(s[2 * 65], s[3 * 65]); o.z = pk2(s[4 * 65], s[5 * 65]); o.w = pk2(s[6 * 65], s[7 * 65]);
        *(GAS v4u*)(WT + (size_t)(drow0 + n) * K + k0 + 8 * oct) = o; }
    LDS_WAIT(); asm volatile("" ::: "memory");
}

namespace s5 {
typedef float f32x16 __attribute__((ext_vector_type(16)));
constexpr int L = 8, NCH = 32, BLK = 256, NBLK = SEQ / BLK;
constexpr int O_PW = 0;
constexpr int O_A256 = 4608;
constexpr int O_KT = 5120;
constexpr int O_ET = O_KT + 4608;
constexpr int O_FT = O_ET + 32768;
constexpr int O_EB = O_FT + 32768;
constexpr int O_XT = O_EB + 8192;
constexpr int XT_ROW = 272, XT_WAVE = 32 * XT_ROW;
constexpr int BBS = 17, CCS = 65;
constexpr int O_BB = O_XT;
constexpr int O_CC = O_XT + 8704;
constexpr int O_KP = O_XT + 17408;
constexpr int LDS_END = O_XT + 8 * XT_WAVE;
static_assert(O_KP + 16384 <= LDS_END, "s5 lds");

__device__ __forceinline__ float dpp_x1(float v) { return __builtin_bit_cast(float, __builtin_amdgcn_mov_dpp(__builtin_bit_cast(int, v), 0xB1, 0xF, 0xF, true)); }
__device__ __forceinline__ float gelu_t(float y) {
    const float inner = y * (1.0f + 0.044715f * y * y);
    return y * __builtin_amdgcn_rcpf(1.0f + __builtin_amdgcn_exp2f(-2.3022081981f * inner));
}
__device__ __forceinline__ void disc(const float* lam_re, const float* lam_im, const float* log_dt, int g, int p, float& lbr, float& lbi, float& fr, float& fi) {
    const float lr = lam_re[g * SP + p], li = lam_im[g * SP + p], dt = expf(log_dt[g]);
    const float mag = expf(lr * dt), ang = li * dt;
    lbr = mag * cosf(ang); lbi = mag * sinf(ang);
    const float nr = lbr - 1.f, den = lr * lr + li * li;
    fr = (nr * lr + lbi * li) / den; fi = (lbi * lr - nr * li) / den;
}

struct Params { const float *x, *rstd0, *gn, *lam_re, *lam_im, *log_dt, *b_re, *b_im, *c_re, *c_im, *dsk; bf16* z; };

__device__ __forceinline__ void load_ufrag(bf16x8 (&uf)[8], const Params& P, size_t tok0  , int g, int n, int h, const float (&gnr)[8]) {
    const float* xp = P.x + (tok0 + 8 * n) * D + g * SC + 8 * h;
    const f32x4 r0 = *(const f32x4*)(P.rstd0 + tok0 + 8 * n), r1 = *(const f32x4*)(P.rstd0 + tok0 + 8 * n + 4);
    const float rs[8] = {r0[0], r0[1], r0[2], r0[3], r1[0], r1[1], r1[2], r1[3]};
#pragma unroll
    for (int s = 0; s < 8; ++s) {
        const f32x4 a = *(const f32x4*)(xp + (size_t)s * D), c = *(const f32x4*)(xp + (size_t)s * D + 4);
        v4u w;
        w.x = pg8::cvt_pk_bf16(a[0] * rs[s] * gnr[0], a[1] * rs[s] * gnr[1]); w.y = pg8::cvt_pk_bf16(a[2] * rs[s] * gnr[2], a[3] * rs[s] * gnr[3]);
        w.z = pg8::cvt_pk_bf16(c[0] * rs[s] * gnr[4], c[1] * rs[s] * gnr[5]); w.w = pg8::cvt_pk_bf16(c[2] * rs[s] * gnr[6], c[3] * rs[s] * gnr[7]);
        uf[s] = __builtin_bit_cast(bf16x8, w);
    }
}
__device__ __forceinline__ f32x16 stage_a(int cb, const bf16x8 (&uf)[8], const LAS unsigned char* lds, int lane) {
    f32x16 acc = (f32x16){0.f, 0.f, 0.f, 0.f, 0.f, 0.f, 0.f, 0.f, 0.f, 0.f, 0.f, 0.f, 0.f, 0.f, 0.f, 0.f};
#pragma unroll
    for (int s = 0; s < 8; ++s) {
        const bf16x8 e = *(const LAS bf16x8*)(lds + O_ET + ((s * 4 + cb) * 32 + (lane & 31)) * 32 + (lane >> 5) * 16);
        acc = __builtin_amdgcn_mfma_f32_32x32x16_bf16(uf[s], e, acc, 0, 0, 0);
    }
    return acc;
}

__device__ __forceinline__ void item(const Params& P, LAS unsigned char* lds, int b, int g, int tid, int wave, int lane) {
    const int rl = lane & 31, h = lane >> 5;
#ifndef S5_REP_SETUP
#define S5_REP_SETUP 1
#endif
#ifndef S5_REP_ROUNDS
#define S5_REP_ROUNDS 1
#endif
    float c1[4], c2[4], d1[4], d2[4]; float gnr[8];
#pragma unroll 1
    for (int rs_ = 0; rs_ < S5_REP_SETUP; ++rs_) {
    __syncthreads();
    if (tid < SP) {
        float lbr, lbi, fr, fi; disc(P.lam_re, P.lam_im, P.log_dt, g, tid, lbr, lbi, fr, fi);
        LAS float* pw = (LAS float*)(lds + O_PW);
        float pr = 1.f, pi = 0.f;
#pragma unroll
        for (int m = 0; m <= 8; ++m) { pw[(m * SP + tid) * 2] = pr; pw[(m * SP + tid) * 2 + 1] = pi; const float nr = pr * lbr - pi * lbi, ni = pr * lbi + pi * lbr; pr = nr; pi = ni; }
        float ar = pw[(8 * SP + tid) * 2], ai = pw[(8 * SP + tid) * 2 + 1];
#pragma unroll
        for (int k = 0; k < 5; ++k) { const float nr = ar * ar - ai * ai, ni = 2.f * ar * ai; ar = nr; ai = ni; }
        LAS float* a256 = (LAS float*)(lds + O_A256); a256[tid * 2] = ar; a256[tid * 2 + 1] = ai;
    }
    {
        LAS float* BB = (LAS float*)(lds + O_BB); LAS float* CC = (LAS float*)(lds + O_CC);
#pragma unroll
        for (int k = 0; k < 2; ++k) {
            const int idx = tid + 512 * k, p = idx >> 4, ci = idx & 15;
            float lbr, lbi, fr, fi; disc(P.lam_re, P.lam_im, P.log_dt, g, p, lbr, lbi, fr, fi);
            const float br = P.b_re[(g * SP + p) * SC + ci], bi = P.b_im[(g * SP + p) * SC + ci];
            BB[(p * BBS + ci) * 2] = fr * br - fi * bi; BB[(p * BBS + ci) * 2 + 1] = fr * bi + fi * br;
            CC[((idx >> 6) * CCS + (idx & 63)) * 2] = P.c_re[(size_t)g * SC * SP + idx]; CC[((idx >> 6) * CCS + (idx & 63)) * 2 + 1] = P.c_im[(size_t)g * SC * SP + idx];
        }
    }
    __syncthreads();
    {
        const LAS float* pw = (const LAS float*)(lds + O_PW); const LAS float* BB = (const LAS float*)(lds + O_BB); const LAS float* CC = (const LAS float*)(lds + O_CC);
        {
            const int ph = tid >> 8, co = (tid >> 4) & 15, ci = tid & 15;
            float kd[8];
#pragma unroll
            for (int d = 0; d < 8; ++d) kd[d] = 0.f;
#pragma unroll 2
            for (int pp = 0; pp < 32; ++pp) {
                const int p = ph * 32 + pp;
                const float cr = CC[(co * CCS + p) * 2], cim = CC[(co * CCS + p) * 2 + 1], lbr = pw[(SP + p) * 2], lbi = pw[(SP + p) * 2 + 1];
                float wr = BB[(p * BBS + ci) * 2], wi = BB[(p * BBS + ci) * 2 + 1];
#pragma unroll
                for (int d = 0; d < 8; ++d) { kd[d] += cr * wr - cim * wi; const float nr = wr * lbr - wi * lbi, ni = wr * lbi + wi * lbr; wr = nr; wi = ni; }
            }
            LAS float* KP = (LAS float*)(lds + O_KP);
#pragma unroll
            for (int d = 0; d < 8; ++d) KP[(ph * 8 + d) * 256 + co * 16 + ci] = kd[d];
        }
        __builtin_amdgcn_sched_barrier(0);
        {
#pragma unroll 1
            for (int k = 0; k < 2; ++k) {
                const int pair = tid + 512 * k, s = pair >> 7, rho = pair & 127, p = rho >> 1, part = rho & 1;
                const float qr = pw[((7 - s) * SP + p) * 2], qi = pw[((7 - s) * SP + p) * 2 + 1];
                float v[16];
#pragma unroll
                for (int ci = 0; ci < 16; ++ci) { const float br = BB[(p * BBS + ci) * 2], bi = BB[(p * BBS + ci) * 2 + 1]; v[ci] = part ? (qr * bi + qi * br) : (qr * br - qi * bi); }
                LAS v4u* dst = (LAS v4u*)(lds + O_ET + (s * 128 + rho) * 32);
                v4u w0, w1;
                w0.x = pg8::cvt_pk_bf16(v[0], v[1]); w0.y = pg8::cvt_pk_bf16(v[2], v[3]); w0.z = pg8::cvt_pk_bf16(v[4], v[5]); w0.w = pg8::cvt_pk_bf16(v[6], v[7]);
                w1.x = pg8::cvt_pk_bf16(v[8], v[9]); w1.y = pg8::cvt_pk_bf16(v[10], v[11]); w1.z = pg8::cvt_pk_bf16(v[12], v[13]); w1.w = pg8::cvt_pk_bf16(v[14], v[15]);
                dst[0] = w0; dst[1] = w1;
            }
        }
        __builtin_amdgcn_sched_barrier(0);
        {
#pragma unroll 1
            for (int k = 0; k < 4; ++k) {
                const int tup = tid + 512 * k, hh = tup & 1, r = (tup >> 1) & 31, i = (tup >> 6) & 3, ks = tup >> 8;
                const int t = 2 * i + (r >> 4), co = r & 15;
                float v[8];
#pragma unroll
                for (int jj = 0; jj < 4; ++jj) {
                    const int p = 8 * ks + 4 * hh + jj;
                    const float cr = CC[(co * CCS + p) * 2], cim = CC[(co * CCS + p) * 2 + 1], qr = pw[((t + 1) * SP + p) * 2], qi = pw[((t + 1) * SP + p) * 2 + 1];
                    v[2 * jj] = cr * qr - cim * qi; v[2 * jj + 1] = -(cr * qi + cim * qr);
                }
                v4u w; w.x = pg8::cvt_pk_bf16(v[0], v[1]); w.y = pg8::cvt_pk_bf16(v[2], v[3]); w.z = pg8::cvt_pk_bf16(v[4], v[5]); w.w = pg8::cvt_pk_bf16(v[6], v[7]);
                *(LAS v4u*)(lds + O_FT + tup * 16) = w;
            }
        }
    }
    __syncthreads();
    {
        const LAS float* KP = (const LAS float*)(lds + O_KP);
        LAS unsigned short* KT = (LAS unsigned short*)(lds + O_KT);
#pragma unroll
        for (int k = 0; k < 4; ++k) { const int idx = tid + 512 * k; KT[256 + idx] = (unsigned short)f2bf(KP[idx] + KP[2048 + idx]); }
        if (tid < 256) KT[tid] = 0;
    }
    {
        const LAS float* pw = (const LAS float*)(lds + O_PW); const LAS float* a256 = (const LAS float*)(lds + O_A256);
#pragma unroll
        for (int cb = 0; cb < 4; ++cb) { const int p = 16 * cb + (rl >> 1); const float ar = pw[(8 * SP + p) * 2], ai = pw[(8 * SP + p) * 2 + 1], br = a256[p * 2], bi = a256[p * 2 + 1];
            c1[cb] = ar; c2[cb] = (rl & 1) ? ai : -ai; d1[cb] = br; d2[cb] = (rl & 1) ? bi : -bi; }
    }
#pragma unroll
    for (int j = 0; j < 8; ++j) gnr[j] = P.gn[g * SC + 8 * h + j];
    __syncthreads();
    }
#pragma unroll 1
    for (int rr_ = 0; rr_ < S5_REP_ROUNDS; ++rr_) {
    float cbase[4] = {0.f, 0.f, 0.f, 0.f};
    f32x4 dv0, dv1;
    dv0 = *(const f32x4*)(P.dsk + g * SC + 4 * h); dv1 = *(const f32x4*)(P.dsk + g * SC + 8 + 4 * h);
    LAS unsigned char* xt = lds + O_XT + wave * XT_WAVE;
#pragma unroll 1
    for (int round = 0; round < 2; ++round) {
        const int blk = wave + 8 * round;
        const size_t tok0 = (size_t)b * SEQ + (size_t)blk * BLK;
        bf16x8 uf[8]; load_ufrag(uf, P, tok0, g, rl, h, gnr);
        f32x16 S[4];
#pragma unroll
        for (int cb = 0; cb < 4; ++cb) {
            S[cb] = stage_a(cb, uf, lds, lane);
            float c = 0.f;
#pragma unroll
            for (int g4 = 0; g4 < 8; ++g4) {
                float cc = c;
#pragma unroll
                for (int r4 = 0; r4 < 4; ++r4) cc = c1[cb] * cc + (c2[cb] * dpp_x1(cc) + S[cb][4 * (g4 >> 1) + r4]);
                const float oth = __shfl_xor(cc, 32);
                c = (h == (g4 & 1)) ? cc : oth;
            }
            if (h == 0) ((LAS float*)(lds + O_EB))[blk * 128 + 32 * cb + rl] = c;
        }
        __syncthreads();
        float cin[4];
#pragma unroll
        for (int cb = 0; cb < 4; ++cb) cin[cb] = cbase[cb];
        for (int k = 0; k < 8; ++k) {
            if (k == wave) {
#pragma unroll
                for (int cb = 0; cb < 4; ++cb) cin[cb] = cbase[cb];
            }
#pragma unroll
            for (int cb = 0; cb < 4; ++cb) cbase[cb] = d1[cb] * cbase[cb] + (d2[cb] * dpp_x1(cbase[cb]) + ((const LAS float*)(lds + O_EB))[(8 * round + k) * 128 + 32 * cb + rl]);
        }
#pragma unroll
        for (int cb = 0; cb < 4; ++cb) {
            float c = cin[cb];
#pragma unroll
            for (int g4 = 0; g4 < 8; ++g4) {
                float cc = c;
#pragma unroll
                for (int r4 = 0; r4 < 4; ++r4) { const int q = 4 * (g4 >> 1) + r4; const float sv = S[cb][q]; if (h == (g4 & 1)) S[cb][q] = cc; cc = c1[cb] * cc + (c2[cb] * dpp_x1(cc) + sv); }
                const float oth = __shfl_xor(cc, 32);
                c = (h == (g4 & 1)) ? cc : oth;
            }
#pragma unroll
            for (int q = 0; q < 16; ++q) { const int n = (q & 3) + 8 * (q >> 2) + 4 * h; *(LAS unsigned short*)(xt + n * XT_ROW + (32 * cb + rl) * 2) = (unsigned short)f2bf(S[cb][q]); }
        }
        LDS_WAIT(); asm volatile("" ::: "memory");
#pragma unroll 1
        for (int i = 0; i < 4; ++i) {
            f32x16 y = (f32x16){0.f, 0.f, 0.f, 0.f, 0.f, 0.f, 0.f, 0.f, 0.f, 0.f, 0.f, 0.f, 0.f, 0.f, 0.f, 0.f};
#pragma unroll
            for (int s = 0; s < 8; ++s) {
                int jx = 2 * i - s + 1 + (rl >> 4); jx = jx < 0 ? 0 : jx;
                const bf16x8 ph = *(const LAS bf16x8*)(lds + O_KT + (jx * 16 + (rl & 15)) * 32 + h * 16);
                y = __builtin_amdgcn_mfma_f32_32x32x16_bf16(ph, uf[s], y, 0, 0, 0);
            }
#pragma unroll
            for (int ks = 0; ks < 8; ++ks) {
                const bf16x8 ff = *(const LAS bf16x8*)(lds + O_FT + (((ks * 4 + i) * 32 + rl) * 2 + h) * 16);
                const bf16x8 xf = *(const LAS bf16x8*)(xt + rl * XT_ROW + ks * 32 + h * 16);
                y = __builtin_amdgcn_mfma_f32_32x32x16_bf16(ff, xf, y, 0, 0, 0);
            }
#pragma unroll
            for (int ts = 0; ts < 2; ++ts) {
                const bf16x8 us = (i == 0) ? uf[ts] : (i == 1) ? uf[2 + ts] : (i == 2) ? uf[4 + ts] : uf[6 + ts];
                const v4u uw = __builtin_bit_cast(v4u, us);
                const auto s0 = __builtin_amdgcn_permlane32_swap(uw.x, uw.z, false, false), s1 = __builtin_amdgcn_permlane32_swap(uw.y, uw.w, false, false);
                const unsigned ua[2][2] = {{s0[0], s1[0]}, {s0[1], s1[1]}};
                const size_t tok = tok0 + 8 * rl + 2 * i + ts;
#pragma unroll
                for (int h8 = 0; h8 < 2; ++h8) {
                    const int c0 = 8 * h8 + 4 * h;
                    const f32x4 dv = h8 ? dv1 : dv0;
                    const float u0 = __builtin_bit_cast(float, ua[h8][0] << 16), u1 = __builtin_bit_cast(float, ua[h8][0] & 0xffff0000u);
                    const float u2 = __builtin_bit_cast(float, ua[h8][1] << 16), u3 = __builtin_bit_cast(float, ua[h8][1] & 0xffff0000u);
                    const float o0 = gelu_t(y[8 * ts + 4 * h8 + 0] + dv[0] * u0), o1 = gelu_t(y[8 * ts + 4 * h8 + 1] + dv[1] * u1);
                    const float o2 = gelu_t(y[8 * ts + 4 * h8 + 2] + dv[2] * u2), o3 = gelu_t(y[8 * ts + 4 * h8 + 3] + dv[3] * u3);
                    uint2 w; w.x = pg8::cvt_pk_bf16(o0, o1); w.y = pg8::cvt_pk_bf16(o2, o3);
                    *(uint2*)(P.z + tok * D + g * SC + c0) = w;
                }
            }
        }
        LDS_WAIT(); asm volatile("" ::: "memory");
    }
    }
}
}
namespace att {
typedef float f32x16 __attribute__((ext_vector_type(16)));
typedef short s16x4 __attribute__((ext_vector_type(4)));
constexpr int TILE = 16384;
constexpr int O_V = 0, O_K = 3 * TILE, O_WS = 6 * TILE, LDS_END = O_WS + 8 * 64 * 4;
#define ATT_KSWZ(row, colB) ((row) * 256 + ((colB) ^ (((row) & 7) << 4)))
#define ATT_SBAR() __builtin_amdgcn_sched_barrier(0)
__device__ __forceinline__ int v_st(int k, int c) { const int kk = (k & ~0xC) | ((k & 4) << 1) | ((k & 8) >> 1); return ((kk >> 3) * 4 + (c >> 5)) * 512 + ((kk & 7) * 32 + (c & 31)) * 2; }
__device__ __forceinline__ int v_rd_base(int lane) { return ((lane & 3) << 3) | (((lane >> 2) & 3) << 6) | (((lane >> 4) & 1) << 5) | (((lane >> 5) & 1) << 8); }
constexpr int v_rd_off(int d0, int ks, int half) { return d0 * 512 + ks * 4096 + half * 2048; }
__device__ __forceinline__ int crow(int r, int hi) { return (r & 3) + 8 * (r >> 2) + 4 * hi; }
__device__ __forceinline__ unsigned cvtpk(float lo, float hi) { unsigned r; asm volatile("v_cvt_pk_bf16_f32 %0, %1, %2" : "=v"(r) : "v"(lo), "v"(hi)); return r; }
__device__ __forceinline__ void mask_tile(f32x16& p0, f32x16& p1, int dq) {
    const float NEG = -__builtin_inff();
#pragma unroll
    for (int r = 0; r < 16; ++r) {
        const int c = (r & 3) + 8 * (r >> 2);
        if ((unsigned)(dq - c) >= 129u) p0[r] = NEG;
        if ((unsigned)(dq - c - 32) >= 129u) p1[r] = NEG;
    }
}
__device__ __forceinline__ void partialSM(f32x16& p0, f32x16& p1, float& m_reg, float& alpha) {
    float pmax = p0[0];
#pragma unroll
    for (int r = 1; r < 16; ++r) pmax = fmaxf(pmax, p0[r]);
#pragma unroll
    for (int r = 0; r < 16; ++r) pmax = fmaxf(pmax, p1[r]);
    { auto rr = __builtin_amdgcn_permlane32_swap(__float_as_uint(pmax), __float_as_uint(pmax), false, false);
      pmax = fmaxf(__uint_as_float(rr[0]), __uint_as_float(rr[1])); }
    float mn;
    if (__all(pmax <= m_reg)) { mn = m_reg; alpha = 1.f; }
    else { mn = fmaxf(m_reg, pmax); alpha = __builtin_amdgcn_exp2f(m_reg - mn); m_reg = mn; }
#pragma unroll
    for (int r = 0; r < 16; ++r) { p0[r] = __builtin_amdgcn_exp2f(p0[r] - mn); p1[r] = __builtin_amdgcn_exp2f(p1[r] - mn); }
}
__device__ __forceinline__ void finishSM(const f32x16& p0, const f32x16& p1, float alpha, float& l_reg, bf16x8& pa0, bf16x8& pa1, bf16x8& pa2, bf16x8& pa3) {
    float ps = 0.f;
#pragma unroll
    for (int r = 0; r < 16; ++r) ps += p0[r];
#pragma unroll
    for (int r = 0; r < 16; ++r) ps += p1[r];
    { auto rr = __builtin_amdgcn_permlane32_swap(__float_as_uint(ps), __float_as_uint(ps), false, false);
      ps = __uint_as_float(rr[0]) + __uint_as_float(rr[1]); }
    l_reg = l_reg * alpha + ps;
#define ATT_PK4(P, B_, OUT) do { unsigned a0 = cvtpk(P[B_+0], P[B_+1]), a1 = cvtpk(P[B_+2], P[B_+3]);                          \
        unsigned b0 = cvtpk(P[B_+4], P[B_+5]), b1 = cvtpk(P[B_+6], P[B_+7]);                                             \
        auto r0 = __builtin_amdgcn_permlane32_swap(a0, b0, false, false); auto r1 = __builtin_amdgcn_permlane32_swap(a1, b1, false, false); \
        v4u w = {r0[0], r1[0], r0[1], r1[1]}; OUT = __builtin_bit_cast(bf16x8, w); } while (0)
    ATT_PK4(p0, 0, pa0); ATT_PK4(p0, 8, pa1); ATT_PK4(p1, 0, pa2); ATT_PK4(p1, 8, pa3);
#undef ATT_PK4
}
__device__ __forceinline__ void qkt(f32x16& p0, f32x16& p1, const LAS unsigned char* K_t, int r32, int hi, const bf16x8* qr) {
    p0 = (f32x16){0.f, 0.f, 0.f, 0.f, 0.f, 0.f, 0.f, 0.f, 0.f, 0.f, 0.f, 0.f, 0.f, 0.f, 0.f, 0.f}; p1 = p0;
    const LAS unsigned char* kb[4];
#pragma unroll
    for (int dd = 0; dd < 4; ++dd) kb[dd] = K_t + ATT_KSWZ(r32, (dd * 16 + hi * 8) * 2);
#pragma unroll
    for (int d0 = 0; d0 < 8; ++d0) { const LAS unsigned char* a = kb[d0 & 3] + (d0 >> 2) * 128;
        const bf16x8 b0 = *(const LAS bf16x8*)a;
        const bf16x8 b1 = *(const LAS bf16x8*)(a + 32 * 256);
        p0 = __builtin_amdgcn_mfma_f32_32x32x16_bf16(b0, qr[d0], p0, 0, 0, 0);
        p1 = __builtin_amdgcn_mfma_f32_32x32x16_bf16(b1, qr[d0], p1, 0, 0, 0); }
}
template <int VB>
__device__ __forceinline__ void pv_tile(f32x16* o, int vb0, bf16x8 pa0, bf16x8 pa1, bf16x8 pa2, bf16x8 pa3) {
#define ATT_TRRD(dst, off) asm volatile("ds_read_b64_tr_b16 %0, %1 offset:%2" : "=&v"(dst) : "v"(vb0), "i"(off) : "memory")
#define ATT_PV_D0(d0) do { s16x4 l0, l1, l2, l3, h0, h1, h2, h3; constexpr int b_ = O_V + VB * TILE + v_rd_off(d0, 0, 0); \
        ATT_TRRD(l0, b_); ATT_TRRD(h0, b_ + 2048); ATT_TRRD(l1, b_ + 4096); ATT_TRRD(h1, b_ + 6144); ATT_TRRD(l2, b_ + 8192); ATT_TRRD(h2, b_ + 10240); ATT_TRRD(l3, b_ + 12288); ATT_TRRD(h3, b_ + 14336); \
        asm volatile("s_waitcnt lgkmcnt(0)" ::: "memory"); ATT_SBAR();   \
        o[d0] = __builtin_amdgcn_mfma_f32_32x32x16_bf16(pa0, (bf16x8){l0[0], l0[1], l0[2], l0[3], h0[0], h0[1], h0[2], h0[3]}, o[d0], 0, 0, 0);   \
        o[d0] = __builtin_amdgcn_mfma_f32_32x32x16_bf16(pa1, (bf16x8){l1[0], l1[1], l1[2], l1[3], h1[0], h1[1], h1[2], h1[3]}, o[d0], 0, 0, 0);   \
        o[d0] = __builtin_amdgcn_mfma_f32_32x32x16_bf16(pa2, (bf16x8){l2[0], l2[1], l2[2], l2[3], h2[0], h2[1], h2[2], h2[3]}, o[d0], 0, 0, 0);   \
        o[d0] = __builtin_amdgcn_mfma_f32_32x32x16_bf16(pa3, (bf16x8){l3[0], l3[1], l3[2], l3[3], h3[0], h3[1], h3[2], h3[3]}, o[d0], 0, 0, 0); } while (0)
    ATT_PV_D0(0); ATT_PV_D0(1); ATT_PV_D0(2); ATT_PV_D0(3);
#undef ATT_PV_D0
#undef ATT_TRRD
}

struct Tensors { const bf16* Q; const bf16* K; const bf16* V; bf16* OG; float* LSE; bf16* O; };

template <int TT>
__device__ __forceinline__ void tile_step(f32x16 (&o)[4], float& m_reg, float& l_reg, const LAS unsigned char* lds, LAS float* al_l, int vb0, int r32, int hi, const bf16x8* qr, int dq) {
    f32x16 p0, p1; float alpha; bf16x8 pa0, pa1, pa2, pa3;
    qkt(p0, p1, lds + O_K + TT * TILE, r32, hi, qr);
    mask_tile(p0, p1, dq);
    partialSM(p0, p1, m_reg, alpha);
    finishSM(p0, p1, alpha, l_reg, pa0, pa1, pa2, pa3);
    if (__any(alpha < 1.f)) {
        if (hi == 0) al_l[r32] = alpha;
        asm volatile("s_waitcnt lgkmcnt(0)" ::: "memory");
#pragma unroll
        for (int d_ = 0; d_ < 4; ++d_)
#pragma unroll
            for (int r = 0; r < 16; ++r) o[d_][r] *= al_l[crow(r, hi)];
    }
    ATT_SBAR();
    pv_tile<TT>(o, vb0, pa0, pa1, pa2, pa3);
}

template <bool MERGE>
__device__ __forceinline__ void unit(const Tensors& TS, LAS unsigned char* lds, int pair, int g, int rho, int qb, int tid, int wid, int lane) {
    const int r32 = lane & 31, hi = lane >> 5;
    const int b = pair >> 2, kvh = pair & 3, dil = (g == 0) ? 1 : (g == 1 ? 4 : 16);
    const int i0 = qb * 64;
    const size_t trow0 = (size_t)b * SEQ;
    const int sr = tid >> 4, sc = (tid & 15) * 8;
    const int t_lo = (i0 >= 128) ? 0 : ((i0 >= 64) ? 1 : 2);
    bf16x8 st[3][4];
#pragma unroll
    for (int tt = 0; tt < 3; ++tt) if (tt >= t_lo) {
        const int kl = i0 - 128 + 64 * tt;
        const size_t r0 = (trow0 + rho + (size_t)dil * (kl + sr)) * NKVC + kvh * HD + sc, r1 = r0 + (size_t)dil * 32 * NKVC;
        st[tt][0] = *(const bf16x8*)(TS.K + r0); st[tt][1] = *(const bf16x8*)(TS.K + r1);
        st[tt][2] = *(const bf16x8*)(TS.V + r0); st[tt][3] = *(const bf16x8*)(TS.V + r1);
    }
    const int hq = 4 * kvh + (wid & 3), a = wid >> 2, iq = i0 + 32 * a + r32;
    const size_t qtok = trow0 + rho + (size_t)dil * iq;
    bf16x8 qr[8];
    { const bf16* qp = TS.Q + qtok * NQ + g * (NH * HD) + hq * HD + hi * 8;
#pragma unroll
      for (int d0 = 0; d0 < 8; ++d0) qr[d0] = *(const bf16x8*)(qp + d0 * 16); }
    const int kws = ATT_KSWZ(sr, sc * 2), vst0 = v_st(sr, sc), vst1 = v_st(32 + sr, sc);
#pragma unroll
    for (int tt = 0; tt < 3; ++tt) if (tt >= t_lo) {
        *(LAS bf16x8*)(lds + O_K + tt * TILE + kws) = st[tt][0]; *(LAS bf16x8*)(lds + O_K + tt * TILE + kws + 32 * 256) = st[tt][1];
        *(LAS bf16x8*)(lds + O_V + tt * TILE + vst0) = st[tt][2]; *(LAS bf16x8*)(lds + O_V + tt * TILE + vst1) = st[tt][3];
    }
    __syncthreads();
    LAS float* ws = (LAS float*)(lds + O_WS) + wid * 64; LAS float* al_l = ws; LAS float* li_l = ws + 32;
    const int vb0 = (int)(unsigned)(uintptr_t)(lds + O_V) + v_rd_base(lane);
    float m_reg = -1e30f, l_reg = 0.f; f32x16 o[4];
#pragma unroll
    for (int d_ = 0; d_ < 4; ++d_) o[d_] = (f32x16){0.f, 0.f, 0.f, 0.f, 0.f, 0.f, 0.f, 0.f, 0.f, 0.f, 0.f, 0.f, 0.f, 0.f, 0.f, 0.f};
    const int dq0 = 32 * a + r32 + 128 - 4 * hi;
    if (t_lo <= 0) tile_step<0>(o, m_reg, l_reg, lds, al_l, vb0, r32, hi, qr, dq0);
    if (t_lo <= 1) tile_step<1>(o, m_reg, l_reg, lds, al_l, vb0, r32, hi, qr, dq0 - 64);
    tile_step<2>(o, m_reg, l_reg, lds, al_l, vb0, r32, hi, qr, dq0 - 128);
    if (hi == 0) li_l[r32] = l_reg;
    asm volatile("s_waitcnt lgkmcnt(0)" ::: "memory");
    float rli[16];
#pragma unroll
    for (int r = 0; r < 16; ++r) rli[r] = __builtin_amdgcn_rcpf(li_l[crow(r, hi)]);
    const float lse = m_reg + __builtin_amdgcn_logf(l_reg);
    __syncthreads();
    LAS unsigned char* stg = lds + wid * 8192;
#pragma unroll
    for (int r = 0; r < 16; ++r) { const int orow = crow(r, hi);
#pragma unroll
        for (int d0 = 0; d0 < 4; ++d0) *(LAS unsigned short*)(stg + orow * 256 + (d0 * 32 + r32) * 2) = (unsigned short)f2bf(o[d0][r] * rli[r]); }
    if (hi == 0) al_l[r32] = lse;
    asm volatile("s_waitcnt lgkmcnt(0)" ::: "memory");
#pragma unroll
    for (int i = 0; i < 8; ++i) {
        const int row = i * 4 + (lane >> 4), ch = lane & 15;
        const size_t tok = trow0 + rho + (size_t)dil * (i0 + 32 * a + row);
        const v4u ov = *(const LAS v4u*)(stg + row * 256 + ch * 16);
        if constexpr (!MERGE) {
            *(v4u*)(TS.OG + (size_t)(g - 1) * T * D + tok * D + hq * HD + ch * 8) = ov;
            if (ch == 0) TS.LSE[(size_t)(g - 1) * T * NH + tok * NH + hq] = al_l[row];
        } else {
            const float l0 = al_l[row], l1 = TS.LSE[tok * NH + hq], l2 = TS.LSE[(size_t)T * NH + tok * NH + hq];
            const float mx = fmaxf(fmaxf(l0, l1), l2);
            float w0 = __builtin_amdgcn_exp2f(l0 - mx), w1 = __builtin_amdgcn_exp2f(l1 - mx), w2 = __builtin_amdgcn_exp2f(l2 - mx);
            const float inv = __builtin_amdgcn_rcpf(w0 + w1 + w2); w0 *= inv; w1 *= inv; w2 *= inv;
            const v4u o1 = *(const v4u*)(TS.OG + tok * D + hq * HD + ch * 8), o2 = *(const v4u*)(TS.OG + (size_t)T * D + tok * D + hq * HD + ch * 8);
            v4u res;
#pragma unroll
            for (int e = 0; e < 4; ++e) {
                const float lo = w0 * __builtin_bit_cast(float, ov[e] << 16) + w1 * __builtin_bit_cast(float, o1[e] << 16) + w2 * __builtin_bit_cast(float, o2[e] << 16);
                const float hi_ = w0 * __builtin_bit_cast(float, ov[e] & 0xffff0000u) + w1 * __builtin_bit_cast(float, o1[e] & 0xffff0000u) + w2 * __builtin_bit_cast(float, o2[e] & 0xffff0000u);
                res[e] = cvtpk(lo, hi_);
            }
            *(v4u*)(TS.O + tok * D + hq * HD + ch * 8) = res;
        }
    }
    __syncthreads();
}
#undef ATT_KSWZ
#undef ATT_SBAR
}
__device__ __forceinline__ float bf2f(bf16 v) { return __builtin_bit_cast(float, (unsigned)v << 16); }
__device__ __forceinline__ float gelu_tanh(float y) {
    const float k0 = 0.7978845608028654f, k1 = 0.044715f;
    return 0.5f * y * (1.f + tanhf(k0 * (y + k1 * y * y * y)));
}
__device__ __forceinline__ void s5_simple_item(int bg, int p, const float* __restrict__ x, const float* __restrict__ rstd, const float* __restrict__ gn,
        const float* __restrict__ lam_re, const float* __restrict__ lam_im, const float* __restrict__ log_dt,
        const float* __restrict__ b_re, const float* __restrict__ b_im, const float* __restrict__ c_re, const float* __restrict__ c_im,
        const float* __restrict__ d_skip, bf16* __restrict__ z) {
    constexpr int G = SG, P = SP, C = SC, S = SEQ;
    const int b = bg / G, g = bg % G;
    const float lr = lam_re[g * P + p], li = lam_im[g * P + p];
    const float dt = expf(log_dt[g]);
    const float mag = expf(lr * dt), ang = li * dt;
    const float lbr = mag * cosf(ang), lbi = mag * sinf(ang);
    const float nr = lbr - 1.f, den = lr * lr + li * li;
    const float fr = (nr * lr + lbi * li) / den, fi = (lbi * lr - nr * li) / den;
    float bbr[C], bbi[C], cr[C], ci[C];
#pragma unroll
    for (int c = 0; c < C; ++c) {
        const float br = b_re[(g * P + p) * C + c], bi = b_im[(g * P + p) * C + c];
        bbr[c] = fr * br - fi * bi; bbi[c] = fr * bi + fi * br;
        cr[c] = c_re[(g * C + c) * P + p]; ci[c] = c_im[(g * C + c) * P + p];
    }
    const int pc = p & 15;
    const float gnp = gn[g * C + pc], dp = d_skip[g * C + pc];
    float gnc[C];
#pragma unroll
    for (int c = 0; c < C; ++c) gnc[c] = gn[g * C + c];
    float xr = 0.f, xi = 0.f;
    for (int t = 0; t < S; ++t) {
        const size_t row = (size_t)b * S + t;
        const float* xp = x + row * D + g * C;
        const float r = rstd[row];
        float bur = 0.f, bui = 0.f;
#pragma unroll
        for (int c = 0; c < C; ++c) { const float u = xp[c] * r * gnc[c]; bur += bbr[c] * u; bui += bbi[c] * u; }
        const float nxr = lbr * xr - lbi * xi + bur, nxi = lbr * xi + lbi * xr + bui;
        xr = nxr; xi = nxi;
        float myy = 0.f;
#pragma unroll
        for (int c = 0; c < C; ++c) { float v = cr[c] * xr - ci[c] * xi; v = wave_sum(v); if (p == c) myy = v; }
        if (p < C) { const float up = xp[pc] * r * gnp; z[row * D + g * C + p] = (bf16)f2bf(gelu_tanh(myy + dp * up)); }
    }
}
struct Args { const float* in[20]; float* out; unsigned char* ws; int ph_lo, ph_hi; };

__global__ void __launch_bounds__(NWAVES * 64, 2) mk_fwd(Args args) {
    extern __shared__ __attribute__((aligned(16))) unsigned char lds[];
    Frame F;
    F.lds = (LAS unsigned char*)lds;
    F.MISC = (volatile LAS unsigned*)(F.lds + MISC_OFF);
    F.tid = threadIdx.x; F.lane = F.tid & 63; F.wave = __builtin_amdgcn_readfirstlane(F.tid >> 6);
    F.G = gridDim.x; { const int bx = blockIdx.x; F.vcu = (F.G % 8 == 0) ? (bx % 8) * (F.G / 8) + bx / 8 : bx; }
    unsigned char* ws = args.ws;
    F.ctl = (gu32*)(ws + WS_CTL);
    const float* x = args.in[0];
    bf16* WgluT = (bf16*)(ws + WS_WGLU); bf16* Win0T = (bf16*)(ws + WS_WIN0); bf16* Wout0T = (bf16*)(ws + WS_WOUT0); bf16* WqkvT = (bf16*)(ws + WS_WQKV);
    bf16* WoT = (bf16*)(ws + WS_WO); bf16* Win1T = (bf16*)(ws + WS_WIN1); bf16* Wout1T = (bf16*)(ws + WS_WOUT1);
    float* XA = (float*)(ws + WS_XA); bf16* XB = (bf16*)(ws + WS_XB); bf16* ZO = (bf16*)(ws + WS_ZO); bf16* HQ = (bf16*)(ws + WS_HQ);
    bf16* KB = (bf16*)(ws + WS_K); bf16* VB = (bf16*)(ws + WS_V);
    float* rstd0 = (float*)(ws + WS_RSTD0);
    float* rowsq = (float*)(ws + WS_CTL) + CW_ROWSQ;
    for (int u = F.tid; u < (LDS_BYTES - LDSCTL_OFF) / 4; u += NWAVES * 64) ((LAS unsigned*)(F.lds + LDSCTL_OFF))[u] = 0u;
    __syncthreads();
    XcdBarrier bar = xcd_barrier_post((unsigned*)(F.ctl + CW_BAR), F.MISC + 8);
    const int lo = args.ph_lo, hi = args.ph_hi;
#ifndef REP0
#define REP0 1
#endif
#ifndef REP1
#define REP1 1
#endif
#ifndef REP3
#define REP3 1
#endif
#ifndef REP5
#define REP5 1
#endif
#ifndef REP67
#define REP67 1
#endif
#ifndef PHMASK
#define PHMASK 0xFFF
#endif
#define IN(k) (((PHMASK >> (k)) & 1) && lo <= (k) && (k) < hi)
#define BOTH(k) (IN(k) && IN((k) + 1))
#define GRID_BAR() xcd_barrier(bar)

    for (int rep_ = 0; rep_ < REP0; ++rep_) if (IN(0)) {
        LAS float* scr = (LAS float*)(F.lds + RING_OFF + F.wave * 16896);
        const int gw = F.vcu * NWAVES + F.wave, NGW = F.G * NWAVES;
        constexpr int I0 = (D / 64) * (2 * D / 64), I1 = (D / 64) * (2 * FF / 64), I2 = (FF / 64) * (D / 64), I3 = (D / 64) * (NQ / 64), I4 = (D / 64) * (2 * NKVC / 64), I5 = (D / 64) * (D / 64);
        constexpr int NITEMS = I0 + 2 * I1 + 2 * I2 + I3 + I4 + I5;
        for (int it = gw; it < NITEMS; it += NGW) {
            int r = it;
            if (r < I0) { p0_transpose_item(args.in[9], D, 2 * D, nullptr, WgluT, D, 0, scr, r, F.lane); continue; } r -= I0;
            if (r < I1) { p0_transpose_item(args.in[12], D, 2 * FF, args.in[11], Win0T, FF, 0, scr, r, F.lane); continue; } r -= I1;
            if (r < I2) { p0_transpose_item(args.in[13], FF, D, nullptr, Wout0T, 0, 0, scr, r, F.lane); continue; } r -= I2;
            if (r < I3) { p0_transpose_item(args.in[15], D, NQ, args.in[14], WqkvT, 0, 0, scr, r, F.lane); continue; } r -= I3;
            if (r < I4) { p0_transpose_item(args.in[18], D, 2 * NKVC, args.in[17], WqkvT, 0, NQ, scr, r, F.lane); continue; } r -= I4;
            if (r < I5) { p0_transpose_item(args.in[16], D, D, nullptr, WoT, 0, 0, scr, r, F.lane); continue; } r -= I5;
            if (r < I1) { p0_transpose_item(args.in[12] + (size_t)D * 2 * FF, D, 2 * FF, args.in[11] + D, Win1T, FF, 0, scr, r, F.lane); continue; } r -= I1;
            p0_transpose_item(args.in[13] + (size_t)FF * D, FF, D, nullptr, Wout1T, 0, 0, scr, r, F.lane);
        }
        for (int m = gw; m < T; m += NGW) {
            const GAS f32x4* xr = (const GAS f32x4*)(x + (size_t)m * D) + F.lane; float s = 0.f;
#pragma unroll
            for (int j = 0; j < D / 256; ++j) { const f32x4 v = xr[64 * j]; s += (v.x * v.x + v.y * v.y) + (v.z * v.z + v.w * v.w); }
            s = wave_sum(s);
            if (F.lane == 0) rstd0[m] = 1.0f / sqrtf(s * (1.0f / D) + EPS);
        }
        if (BOTH(0)) GRID_BAR();
    }
    for (int rep_ = 0; rep_ < REP1; ++rep_) if (IN(1)) {
        static_assert(s5::LDS_END <= LDSCTL_OFF, "s5 LDS map");
        const s5::Params SPm{x, rstd0, args.in[10], args.in[1], args.in[2], args.in[3], args.in[4], args.in[5], args.in[6], args.in[7], args.in[8], ZO};
        int tid_ = threadIdx.x; asm volatile("" : "+v"(tid_));
        for (int it = F.vcu; it < NB * SG; it += F.G) s5::item(SPm, F.lds, it / SG, it % SG, tid_, __builtin_amdgcn_readfirstlane(tid_ >> 6), tid_ & 63);
        if (BOTH(1)) GRID_BAR();
    }
    if (IN(2)) {
        pg8::Gemm g{ZO, WgluT, T, 2 * D, D}; pg8::StaticOrder S; S.init(T, 2 * D, F.G, (int)blockIdx.x);
        pg8::EpiGluRes E{x, XA, XB, rowsq};
        pg8::gemm_phase<pg8::EpiGluRes, pg8::StaticOrder, true, true>(F.lds + RING_OFF, g, S, E);
        if (BOTH(2)) GRID_BAR();
    }
    for (int rep_ = 0; rep_ < REP3; ++rep_) if (IN(3)) {
        pg8::Gemm g{XB, Win0T, T, 2 * FF, D}; pg8::StaticOrder S; S.init(T, 2 * FF, F.G, (int)blockIdx.x);
        pg8::EpiSwiGlu E{rowsq, HQ, FF};
        pg8::gemm_phase<pg8::EpiSwiGlu, pg8::StaticOrder, true, true>(F.lds + RING_OFF, g, S, E);
        if (BOTH(3)) GRID_BAR();
    }
    if (IN(4)) {
        pg8::Gemm g{HQ, Wout0T, T, D, FF}; pg8::StaticOrder S; S.init(T, D, F.G, (int)blockIdx.x);
        pg8::EpiRes<true> E{XA, XB, rowsq + T};
        pg8::gemm_phase<pg8::EpiRes<true>, pg8::StaticOrder, true, true>(F.lds + RING_OFF, g, S, E);
        if (BOTH(4)) GRID_BAR();
    }
    for (int rep_ = 0; rep_ < REP5; ++rep_) if (IN(5)) {
        pg8::Gemm g{XB, WqkvT, T, NQKV, D}; pg8::StaticOrder S; S.init(T, NQKV, F.G, (int)blockIdx.x);
        pg8::EpiQKV E{rowsq + T, HQ, KB, VB, QSCALE};
        pg8::gemm_phase<pg8::EpiQKV, pg8::StaticOrder, true, true>(F.lds + RING_OFF, g, S, E);
        if (BOTH(5)) GRID_BAR();
    }
    for (int rep_ = 0; rep_ < REP67; ++rep_) {
    if (IN(6)) {
        static_assert(att::LDS_END <= LDSCTL_OFF, "att LDS map");
        const att::Tensors TS{HQ, KB, VB, (bf16*)(ws + WS_OG), (float*)(ws + WS_LSE), ZO};
        int tid_ = threadIdx.x; asm volatile("" : "+v"(tid_));
        for (int u = blockIdx.x; u < 8 * 128; u += F.G) {
            const int pair = u & 7, v = u >> 3, g = 1 + (v >> 6), w = v & 63;
            const int rho = (g == 1) ? (w & 3) : (w & 15), qb = (g == 1) ? (w >> 2) : (w >> 4);
            att::unit<false>(TS, F.lds, pair, g, rho, qb, tid_, __builtin_amdgcn_readfirstlane(tid_ >> 6), tid_ & 63);
        }
        if (BOTH(6)) GRID_BAR();
    }
    if (IN(7)) {
        const att::Tensors TS{HQ, KB, VB, (bf16*)(ws + WS_OG), (float*)(ws + WS_LSE), ZO};
        int tid_ = threadIdx.x; asm volatile("" : "+v"(tid_));
        for (int u = blockIdx.x; u < 8 * 64; u += F.G) att::unit<true>(TS, F.lds, u & 7, 0, 0, u >> 3, tid_, __builtin_amdgcn_readfirstlane(tid_ >> 6), tid_ & 63);
        if (BOTH(7)) GRID_BAR();
    }
    }
    if (IN(8)) {
        pg8::Gemm g{ZO, WoT, T, D, D}; pg8::StaticOrder S; S.init(T, D, F.G, (int)blockIdx.x);
        pg8::EpiRes<true> E{XA, XB, rowsq + 2 * T};
        pg8::gemm_phase<pg8::EpiRes<true>, pg8::StaticOrder, true, true>(F.lds + RING_OFF, g, S, E);
        if (BOTH(8)) GRID_BAR();
    }
    if (IN(9)) {
        pg8::Gemm g{XB, Win1T, T, 2 * FF, D}; pg8::StaticOrder S; S.init(T, 2 * FF, F.G, (int)blockIdx.x);
        pg8::EpiSwiGlu E{rowsq + 2 * T, HQ, FF};
        pg8::gemm_phase<pg8::EpiSwiGlu, pg8::StaticOrder, true, true>(F.lds + RING_OFF, g, S, E);
        if (BOTH(9)) GRID_BAR();
    }
    if (IN(10)) {
        pg8::Gemm g{HQ, Wout1T, T, D, FF}; pg8::StaticOrder S; S.init(T, D, F.G, (int)blockIdx.x);
        pg8::EpiRes<true> E{XA, XB, rowsq + 3 * T};
        pg8::gemm_phase<pg8::EpiRes<true>, pg8::StaticOrder, true, true>(F.lds + RING_OFF, g, S, E);
        if (BOTH(10)) GRID_BAR();
    }
    if (IN(11)) {
        const int gw = F.vcu * NWAVES + F.wave, NGW = F.G * NWAVES;
        const GAS f32x4* gr = (const GAS f32x4*)args.in[19] + F.lane;
        for (int m = gw; m < T; m += NGW) {
            const GAS f32x4* xr = (const GAS f32x4*)(XA + (size_t)m * D) + F.lane; GAS f32x4* orow = (GAS f32x4*)(args.out + (size_t)m * D) + F.lane;
            f32x4 v[D / 256]; float s = 0.f;
#pragma unroll
            for (int j = 0; j < D / 256; ++j) { v[j] = xr[64 * j]; s += (v[j].x * v[j].x + v[j].y * v[j].y) + (v[j].z * v[j].z + v[j].w * v[j].w); }
            s = wave_sum(s);
            const float r = 1.0f / sqrtf(s * (1.0f / D) + EPS);
#pragma unroll
            for (int j = 0; j < D / 256; ++j) orow[64 * j] = v[j] * r * gr[64 * j];
        }
    }
#undef IN
#undef BOTH
#undef GRID_BAR
}

extern "C" void kernel_launch(void* const* d_in, const int* in_sizes, int n_in, void* d_out, int out_size, void* d_ws, size_t ws_size, hipStream_t stream) {
    static int grid = 0;
    if (grid == 0) {
        if (n_in != 20 || out_size != T * D || ws_size < WS_END) { fprintf(stderr, "kernel_launch: unexpected shapes/ws (n_in %d out %d ws %zu)\n", n_in, out_size, ws_size); grid = -1; return; }
        int dev = 0, cus = 0;
        if (hipGetDevice(&dev) != hipSuccess || hipDeviceGetAttribute(&cus, hipDeviceAttributeMultiprocessorCount, dev) != hipSuccess) { grid = -1; return; }
        if (hipFuncSetAttribute((const void*)mk_fwd, hipFuncAttributeMaxDynamicSharedMemorySize, LDS_BYTES) != hipSuccess) { fprintf(stderr, "kernel_launch: hipFuncSetAttribute failed\n"); grid = -1; return; }
        (void)hipGetLastError();
        grid = cus;
    }
    if (grid < 0) return;
    (void)hipMemsetAsync((char*)d_ws + WS_CTL, 0, CTL_ZERO_BYTES, stream);
    Args a{};
    for (int i = 0; i < 20; ++i) a.in[i] = (const float*)d_in[i];
    a.out = (float*)d_out; a.ws = (unsigned char*)d_ws;
    unsigned char* ws = (unsigned char*)d_ws;
#define LAUNCH(lo_, hi_) do { a.ph_lo = (lo_); a.ph_hi = (hi_); hipLaunchKernelGGL(mk_fwd, dim3(grid), dim3(NWAVES * 64), LDS_BYTES, stream, a); } while (0)
    LAUNCH(0, 12);
#undef LAUNCH
}
```

```cpp
#include <hip/hip_runtime.h>
#include <cstdint>
#include <cstdio>
namespace pg8 {
#define PG8_LAS __attribute__((address_space(3)))
typedef unsigned short bf16_t;
typedef short bf16x8 __attribute__((ext_vector_type(8)));
typedef float f32x4 __attribute__((ext_vector_type(4)));
typedef unsigned u32x4 __attribute__((ext_vector_type(4)));
constexpr int BM = 256, BK = 64, HALF = 128, HTB = HALF * BK * 2  , STAGE_BYTES = 8 * HTB, NXCD = 8, WGM = 8;

__host__ __device__ __forceinline__ int lds_byte(int r, int c) { const int st = (r >> 4) * 2 + (c >> 5), rr = r & 15, cc = c & 31, ob = rr * 64 + cc * 2; return st * 1024 + (ob ^ (((ob >> 9) & 1) << 5)); }
__host__ __device__ __forceinline__ void stage_rc(int b, int& R, int& C) { const int st = b / 1024, sb = b % 1024, swz = sb ^ (((sb >> 9) & 1) << 5); R = (st >> 1) * 16 + swz / 64; C = (st & 1) * 32 + (swz % 64) / 2; }
__host__ __device__ __forceinline__ int perm32(int rho) { const int n = rho >> 4, i = rho & 15; return 8 * (i >> 2) + 4 * n + (i & 3); }

struct Unit { int pm, pn; };
struct Gemm { const bf16_t* A; const bf16_t* Bt; int M, N, K; };

struct StaticOrder {
    int nM, nN, nwg, G, c;
    __host__ __device__ void init(int M, int N, int G_, int c_) { nM = M / BM; nN = N / BM; nwg = nM * nN; G = G_; c = c_; }
    __host__ __device__ bool next(int i, Unit& u) const {
        const long L = (long)i * G + c; if (L >= nwg) return false;
        int wgid = (int)L; { const int q = nwg / NXCD, r = nwg % NXCD, xcd = wgid % NXCD, off = wgid / NXCD; wgid = (xcd < r ? xcd * (q + 1) : r * (q + 1) + (xcd - r) * q) + off; }
        const int nig = WGM * nN, gid = wgid / nig, fm = gid * WGM, gsz = (nM - fm) < WGM ? (nM - fm) : WGM;
        u.pm = fm + ((wgid % nig) % gsz); u.pn = (wgid % nig) / gsz; return true;
    }
    __device__ __forceinline__ void a_ready(const Unit&) const {}
    __device__ __forceinline__ void done(const Unit&) const {}
};

__device__ __forceinline__ unsigned cvt_pk_bf16(float lo, float hi) { unsigned r; asm volatile("v_cvt_pk_bf16_f32 %0, %1, %2" : "=v"(r) : "v"(lo), "v"(hi)); return r; }
__device__ __forceinline__ float sigm(float v) { return __builtin_amdgcn_rcpf(1.0f + __builtin_amdgcn_exp2f(v * -1.4426950408889634f)); }
__device__ __forceinline__ u32x4 pack8(const f32x4& a, const f32x4& b) { u32x4 w; w.x = cvt_pk_bf16(a[0], a[1]); w.y = cvt_pk_bf16(a[2], a[3]); w.z = cvt_pk_bf16(b[0], b[1]); w.w = cvt_pk_bf16(b[2], b[3]); return w; }
constexpr int DM = 2048;
constexpr float NORM_EPS = 1e-6f;

struct EpiGluRes {
    static constexpr bool PERM = true, AFTER_DRAIN = false;
    const float* res; float* XA; bf16_t* XB; float* rowsq;
    __device__ __forceinline__ void operator()(const f32x4 (&acc)[2][2][4][2], const Unit& u, int wr, int wc, int fr, int fq) const {
        const int row0 = u.pm * BM + wr * 64 + fr, col0 = u.pn * HALF + wc * 32 + 8 * fq;
#pragma unroll
        for (int ai = 0; ai < 2; ++ai)
#pragma unroll
            for (int m = 0; m < 4; ++m) {
                const int row = row0 + ai * HALF + m * 16; const size_t off = (size_t)row * DM + col0;
                const f32x4 r0 = *(const f32x4*)(res + off), r1 = *(const f32x4*)(res + off + 4);
                f32x4 v0, v1;
#pragma unroll
                for (int j = 0; j < 4; ++j) { v0[j] = r0[j] + acc[ai][0][m][0][j] * sigm(acc[ai][1][m][0][j]); v1[j] = r1[j] + acc[ai][0][m][1][j] * sigm(acc[ai][1][m][1][j]); }
                *(f32x4*)(XA + off) = v0; *(f32x4*)(XA + off + 4) = v1;
                *(u32x4*)(XB + off) = pack8(v0, v1);
                float s = (v0[0] * v0[0] + v0[1] * v0[1]) + (v0[2] * v0[2] + v0[3] * v0[3]) + (v1[0] * v1[0] + v1[1] * v1[1]) + (v1[2] * v1[2] + v1[3] * v1[3]);
                s += __shfl_xor(s, 16); s += __shfl_xor(s, 32);
                if (fq == 0) atomicAdd(rowsq + row, s);
            }
    }
};
struct EpiSwiGlu {
    static constexpr bool PERM = true, AFTER_DRAIN = false;
    const float* rowsq; bf16_t* H; int ldh;
    __device__ __forceinline__ void operator()(const f32x4 (&acc)[2][2][4][2], const Unit& u, int wr, int wc, int fr, int fq) const {
        const int row0 = u.pm * BM + wr * 64 + fr, col0 = u.pn * HALF + wc * 32 + 8 * fq;
#pragma unroll
        for (int ai = 0; ai < 2; ++ai)
#pragma unroll
            for (int m = 0; m < 4; ++m) {
                const int row = row0 + ai * HALF + m * 16;
                const float rs = __builtin_amdgcn_rsqf(rowsq[row] * (1.0f / DM) + NORM_EPS);
                f32x4 v0, v1;
#pragma unroll
                for (int j = 0; j < 4; ++j) { const float g0 = acc[ai][0][m][0][j] * rs, g1 = acc[ai][0][m][1][j] * rs;
                    v0[j] = g0 * sigm(g0) * (acc[ai][1][m][0][j] * rs); v1[j] = g1 * sigm(g1) * (acc[ai][1][m][1][j] * rs); }
                *(u32x4*)(H + (size_t)row * ldh + col0) = pack8(v0, v1);
            }
    }
};
template <bool WRITE_XB> struct EpiRes {
    static constexpr bool PERM = true, AFTER_DRAIN = false;
    float* XA; bf16_t* XB; float* rowsq;
    __device__ __forceinline__ void operator()(const f32x4 (&acc)[2][2][4][2], const Unit& u, int wr, int wc, int fr, int fq) const {
        const int row0 = u.pm * BM + wr * 64 + fr, col0 = u.pn * BM + wc * 32 + 8 * fq;
#pragma unroll
        for (int ai = 0; ai < 2; ++ai)
#pragma unroll
            for (int m = 0; m < 4; ++m) {
                const int row = row0 + ai * HALF + m * 16; float s = 0.f;
#pragma unroll
                for (int bj = 0; bj < 2; ++bj) {
                    const size_t off = (size_t)row * DM + col0 + bj * HALF;
                    const f32x4 v0 = *(const f32x4*)(XA + off) + acc[ai][bj][m][0], v1 = *(const f32x4*)(XA + off + 4) + acc[ai][bj][m][1];
                    *(f32x4*)(XA + off) = v0; *(f32x4*)(XA + off + 4) = v1;
                    if (WRITE_XB) *(u32x4*)(XB + off) = pack8(v0, v1);
                    s += (v0[0] * v0[0] + v0[1] * v0[1]) + (v0[2] * v0[2] + v0[3] * v0[3]) + (v1[0] * v1[0] + v1[1] * v1[1]) + (v1[2] * v1[2] + v1[3] * v1[3]);
                }
                s += __shfl_xor(s, 16); s += __shfl_xor(s, 32);
                if (fq == 0) atomicAdd(rowsq + row, s);
            }
    }
};
struct EpiQKV {
    static constexpr bool PERM = true, AFTER_DRAIN = false;
    const float* rowsq; bf16_t* Q; bf16_t* K; bf16_t* V; float qscale;
    __device__ __forceinline__ void operator()(const f32x4 (&acc)[2][2][4][2], const Unit& u, int wr, int wc, int fr, int fq) const {
        const int row0 = u.pm * BM + wr * 64 + fr;
        bf16_t* base; int ld, colt; float sc = 1.f;
        if (u.pn < 24) { base = Q; ld = 6144; colt = u.pn * BM; sc = qscale; }
        else if (u.pn < 26) { base = K; ld = 512; colt = (u.pn - 24) * BM; }
        else { base = V; ld = 512; colt = (u.pn - 26) * BM; }
        const int col0 = colt + wc * 32 + 8 * fq;
#pragma unroll
        for (int ai = 0; ai < 2; ++ai)
#pragma unroll
            for (int m = 0; m < 4; ++m) {
                const int row = row0 + ai * HALF + m * 16;
                const float rs = __builtin_amdgcn_rsqf(rowsq[row] * (1.0f / DM) + NORM_EPS) * sc;
#pragma unroll
                for (int bj = 0; bj < 2; ++bj) *(u32x4*)(base + (size_t)row * ld + col0 + bj * HALF) = pack8(acc[ai][bj][m][0] * rs, acc[ai][bj][m][1] * rs);
            }
    }
};
template <class Epi, class Sched, bool ALIGN_EPI = false, bool SP2 = false>
__device__ __forceinline__ void gemm_phase(PG8_LAS unsigned char* lds, const Gemm g, const Sched& S, const Epi& E) {
    int tid_ = threadIdx.x; asm volatile("" : "+v"(tid_));
    const int tid = tid_, wid = __builtin_amdgcn_readfirstlane(tid >> 6), lane = tid & 63, wr = wid >> 2, wc = wid & 3, fr = lane & 15, fq = lane >> 4;
    const int K = g.K, nt = K / BK;
    unsigned voffA[2], voffB[2];
#pragma unroll
    for (int i = 0; i < 2; ++i) { int R, C; stage_rc(tid * 16 + i * 8192, R, C); const int Rb = Epi::PERM ? ((R & ~31) + perm32(R & 31)) : R;
        voffA[i] = (unsigned)(R * K + C) * 2u; voffB[i] = (unsigned)(Rb * K + C) * 2u; }
    const size_t kstep = (size_t)(BK * 2);
    const size_t hstep = (size_t)HALF * K * 2;
    const size_t tstep = 2 * hstep;
    const unsigned ldsw = (unsigned)wid * 1024u;
    const int aoff = lds_byte(wr * 64 + fr, fq * 8), boff = lds_byte(wc * 32 + fr, fq * 8);
#define PG8_SA(b, h) (((b) * 2 + (h)) * HTB)
#define PG8_SB(b, h) ((4 + (b) * 2 + (h)) * HTB)
#define PG8_STAGE(bufoff, gbase, voff) do { _Pragma("unroll") for (int _i = 0; _i < 2; ++_i) \
        __builtin_amdgcn_global_load_lds((const unsigned*)((const char*)(gbase) + (voff)[_i]), (PG8_LAS unsigned*)(lds + (bufoff) + ldsw + _i * 8192), 16, 0, 0); } while (0)
#define PG8_LDA(dst, b, h) do { _Pragma("unroll") for (int m = 0; m < 4; ++m) _Pragma("unroll") for (int k = 0; k < 2; ++k) dst[m][k] = *(const PG8_LAS bf16x8*)(lds + PG8_SA(b, h) + aoff + m * 2048 + k * 1024); } while (0)
#define PG8_LDB(dst, b, h) do { _Pragma("unroll") for (int n = 0; n < 2; ++n) _Pragma("unroll") for (int k = 0; k < 2; ++k) dst[n][k] = *(const PG8_LAS bf16x8*)(lds + PG8_SB(b, h) + boff + n * 2048 + k * 1024); } while (0)
#define PG8_MMA(ai, bj, At, Bt) do { __builtin_amdgcn_s_setprio(1); _Pragma("unroll") for (int m = 0; m < 4; ++m) _Pragma("unroll") for (int n = 0; n < 2; ++n) _Pragma("unroll") for (int k = 0; k < 2; ++k) \
        acc[ai][bj][m][n] = __builtin_amdgcn_mfma_f32_16x16x32_bf16(Bt[n][k], At[m][k], acc[ai][bj][m][n], 0, 0, 0); __builtin_amdgcn_s_setprio(0); } while (0)
#define PG8_WAIT_V(n) asm volatile("s_waitcnt vmcnt(" #n ")" ::: "memory")
#define PG8_WAIT_L(n) asm volatile("s_waitcnt lgkmcnt(" #n ")" ::: "memory")
#define PG8_BAR __builtin_amdgcn_s_barrier()
#define PG8_SCHED __builtin_amdgcn_sched_barrier(0)
    Unit cur, nxt; int ui = 0;
    if (!S.next(0, cur)) return;
    f32x4 acc[2][2][4][2];
#pragma unroll
    for (int a = 0; a < 2; ++a)
#pragma unroll
        for (int b = 0; b < 2; ++b)
#pragma unroll
            for (int m = 0; m < 4; ++m)
#pragma unroll
                for (int n = 0; n < 2; ++n) acc[a][b][m][n] = (f32x4){0.f, 0.f, 0.f, 0.f};
    bf16x8 At[4][2], B0[2][2], B1[2][2];
    const char* cA = (const char*)g.A + (size_t)cur.pm * tstep; const char* cB = (const char*)g.Bt + (size_t)cur.pn * tstep;
    S.a_ready(cur);
    if constexpr (SP2) {
        PG8_STAGE(PG8_SB(0, 0), cB, voffB); PG8_STAGE(PG8_SB(0, 1), cB + hstep, voffB); PG8_STAGE(PG8_SA(0, 0), cA, voffA); PG8_STAGE(PG8_SA(0, 1), cA + hstep, voffA);
        if (wr == 1) PG8_BAR;
        PG8_WAIT_V(2); PG8_BAR;
        PG8_STAGE(PG8_SB(1, 0), cB + kstep, voffB); PG8_STAGE(PG8_SA(1, 0), cA + kstep, voffA); PG8_STAGE(PG8_SB(1, 1), cB + hstep + kstep, voffB);
        PG8_WAIT_V(6); PG8_BAR;
    } else {
        PG8_STAGE(PG8_SB(0, 0), cB, voffB); PG8_STAGE(PG8_SA(0, 0), cA, voffA); PG8_STAGE(PG8_SB(0, 1), cB + hstep, voffB); PG8_STAGE(PG8_SA(0, 1), cA + hstep, voffA);
        if (wr == 1) PG8_BAR;
        PG8_WAIT_V(4); PG8_BAR;
        PG8_STAGE(PG8_SB(1, 0), cB + kstep, voffB); PG8_STAGE(PG8_SA(1, 0), cA + kstep, voffA); PG8_STAGE(PG8_SB(1, 1), cB + hstep + kstep, voffB);
        PG8_WAIT_V(6); PG8_BAR;
    }
    for (;;) {
        const bool has_next = S.next(ui + 1, nxt);
        const char* nA = has_next ? (const char*)g.A + (size_t)nxt.pm * tstep : cA; const char* nB = has_next ? (const char*)g.Bt + (size_t)nxt.pn * tstep : cB;
        for (int t = 0; t < nt; t += 2) {
            const bool last = (t == nt - 2);
            const char* a1 = cA + (size_t)(t + 1) * kstep;
            const char* a2 = last ? nA : cA + (size_t)(t + 2) * kstep; const char* b2 = last ? nB : cB + (size_t)(t + 2) * kstep;
            const char* a3 = a2 + kstep; const char* b3 = b2 + kstep;
            if (last && has_next) S.a_ready(nxt);
            if constexpr (SP2) {
            PG8_LDB(B0, 0, 0); PG8_LDB(B1, 0, 1); PG8_SCHED; PG8_LDA(At, 0, 0); PG8_STAGE(PG8_SA(1, 1), a1 + hstep, voffA);
            PG8_WAIT_V(8); PG8_WAIT_L(0); PG8_BAR; PG8_MMA(0, 0, At, B0); PG8_MMA(0, 1, At, B1); PG8_BAR; PG8_SCHED;
            PG8_LDA(At, 0, 1); PG8_STAGE(PG8_SB(0, 0), b2, voffB); PG8_STAGE(PG8_SB(0, 1), b2 + hstep, voffB); PG8_STAGE(PG8_SA(0, 0), a2, voffA);
            PG8_WAIT_V(8); PG8_WAIT_L(0); PG8_BAR; PG8_MMA(1, 0, At, B0); PG8_MMA(1, 1, At, B1); PG8_BAR; PG8_SCHED;
            PG8_LDB(B0, 1, 0); PG8_LDB(B1, 1, 1); PG8_SCHED; PG8_LDA(At, 1, 0); PG8_STAGE(PG8_SA(0, 1), a2 + hstep, voffA);
            PG8_WAIT_V(8); PG8_WAIT_L(0); PG8_BAR; PG8_MMA(0, 0, At, B0); PG8_MMA(0, 1, At, B1); PG8_BAR; PG8_SCHED;
            PG8_LDA(At, 1, 1); PG8_STAGE(PG8_SB(1, 0), b3, voffB); PG8_STAGE(PG8_SB(1, 1), b3 + hstep, voffB); PG8_STAGE(PG8_SA(1, 0), a3, voffA);
            PG8_WAIT_V(8); PG8_WAIT_L(0); PG8_BAR; PG8_MMA(1, 0, At, B0); PG8_MMA(1, 1, At, B1); PG8_BAR; PG8_SCHED;
            } else {
            PG8_LDB(B0, 0, 0); PG8_SCHED; PG8_LDA(At, 0, 0); PG8_STAGE(PG8_SA(1, 1), a1 + hstep, voffA);
            PG8_WAIT_L(8); PG8_BAR; PG8_WAIT_L(0); PG8_MMA(0, 0, At, B0); PG8_BAR; PG8_SCHED;
            PG8_LDB(B1, 0, 1); PG8_STAGE(PG8_SB(0, 0), b2, voffB);
            PG8_BAR; PG8_WAIT_L(0); PG8_MMA(0, 1, At, B1); PG8_BAR;
            PG8_LDA(At, 0, 1); PG8_STAGE(PG8_SA(0, 0), a2, voffA);
            PG8_BAR; PG8_WAIT_L(0); PG8_MMA(1, 0, At, B0); PG8_BAR; PG8_SCHED;
            PG8_STAGE(PG8_SB(0, 1), b2 + hstep, voffB);
            PG8_WAIT_V(6); PG8_BAR; PG8_MMA(1, 1, At, B1); PG8_BAR;
            PG8_LDB(B0, 1, 0); PG8_SCHED; PG8_LDA(At, 1, 0); PG8_STAGE(PG8_SA(0, 1), a2 + hstep, voffA);
            PG8_WAIT_L(8); PG8_BAR; PG8_WAIT_L(0); PG8_MMA(0, 0, At, B0); PG8_BAR; PG8_SCHED;
            PG8_LDB(B1, 1, 1); PG8_STAGE(PG8_SB(1, 0), b3, voffB);
            PG8_BAR; PG8_WAIT_L(0); PG8_MMA(0, 1, At, B1); PG8_BAR;
            PG8_LDA(At, 1, 1); PG8_STAGE(PG8_SA(1, 0), a3, voffA);
            PG8_BAR; PG8_WAIT_L(0); PG8_MMA(1, 0, At, B0); PG8_BAR; PG8_SCHED;
            PG8_STAGE(PG8_SB(1, 1), b3 + hstep, voffB);
            PG8_WAIT_V(6); PG8_BAR; PG8_MMA(1, 1, At, B1); PG8_BAR;
            }
        }
        if constexpr (ALIGN_EPI) { if (wr == 0) PG8_BAR; }
        if constexpr (!Epi::AFTER_DRAIN) { E(acc, cur, wr, wc, fr, fq); S.done(cur); }
        if (!has_next) break;
#pragma unroll
        for (int a = 0; a < 2; ++a)
#pragma unroll
            for (int b = 0; b < 2; ++b)
#pragma unroll
                for (int m = 0; m < 4; ++m)
#pragma unroll
                    for (int n = 0; n < 2; ++n) acc[a][b][m][n] = (f32x4){0.f, 0.f, 0.f, 0.f};
        cur = nxt; cA = nA; cB = nB; ++ui;
        if constexpr (ALIGN_EPI) { if (wr == 1) PG8_BAR; }
    }
    PG8_WAIT_V(0);
    if constexpr (!ALIGN_EPI) { if (wr == 0) PG8_BAR; }
    PG8_BAR;
    if constexpr (Epi::AFTER_DRAIN) { E.fused(acc, cur, wr, wc, fr, fq, lds, wid, lane); S.done(cur); }
#undef PG8_SA
#undef PG8_SB
#undef PG8_STAGE
#undef PG8_LDA
#undef PG8_LDB
#undef PG8_MMA
#undef PG8_WAIT_V
#undef PG8_WAIT_L
#undef PG8_BAR
#undef PG8_SCHED
}
}
#define GAS __attribute__((address_space(1)))
#define LAS __attribute__((address_space(3)))
typedef unsigned short bf16;
typedef unsigned v4u __attribute__((ext_vector_type(4)));
typedef float f32x4 __attribute__((ext_vector_type(4)));
typedef short bf16x8 __attribute__((ext_vector_type(8)));
typedef GAS unsigned gu32;
typedef GAS unsigned long long gu64;
#define RLX_AGENT __ATOMIC_RELAXED, __HIP_MEMORY_SCOPE_AGENT
#define LDS_WAIT() asm volatile("s_waitcnt lgkmcnt(0)" ::: "memory")
#define VM_WAIT() asm volatile("s_waitcnt vmcnt(0)" ::: "memory")
__device__ __forceinline__ unsigned long long rt() { return __builtin_amdgcn_s_memrealtime(); }
__device__ __forceinline__ unsigned f2bf(float f) { unsigned u = __builtin_bit_cast(unsigned, f); return (u + 0x7fffu + ((u >> 16) & 1u)) >> 16; }
__device__ __forceinline__ unsigned pk2(float lo, float hi) { return f2bf(lo) | (f2bf(hi) << 16); }

#define XB_TMO      128
#define XB_XCNT(j)  (256  + 64 * (j))
#define XB_XSUB(j)  (1280 + 64 * (j))
#define XB_XGEN(j)  (2304 + 64 * (j))
#define XB_TOP      3328
#define XB_TOPGEN   3392
#define XCD_BAR_WORDS 3456
#define XB_SPIN_CAP (1u << 18)

__device__ __forceinline__ unsigned xb_ld(unsigned* p)              { return __hip_atomic_load(p, __ATOMIC_RELAXED, __HIP_MEMORY_SCOPE_AGENT); }
__device__ __forceinline__ unsigned xb_add(unsigned* p, unsigned v) { return __hip_atomic_fetch_add(p, v, __ATOMIC_RELAXED, __HIP_MEMORY_SCOPE_AGENT); }
__device__ __forceinline__ unsigned xb_xcc_id() { return (unsigned)__builtin_amdgcn_s_getreg((3 << 11) | 20) & 0xFu; }
#define XB_SPIN(cond, bar) do { unsigned _sp = 0; while (cond) { __builtin_amdgcn_s_sleep(1); \
    if ((++_sp & 255u) == 0u) { if (xb_ld(&(bar)[XB_TMO])) break; if (_sp > XB_SPIN_CAP) { atomicAdd(&(bar)[XB_TMO], 1u); break; } } } } while (0)

struct XcdBarrier {
    unsigned* bar; unsigned x;
    volatile LAS unsigned* st;
};

__device__ __forceinline__ XcdBarrier xcd_barrier_post(unsigned* bar, volatile LAS unsigned* st) {
    XcdBarrier b; b.bar = bar; b.x = xb_xcc_id(); b.st = st;
    if (threadIdx.x == 0) (void)xb_add(&bar[XB_XCNT(b.x)], 1u);
    return b;
}
__device__ __forceinline__ void xcd_barrier_complete(unsigned* bar, unsigned x, unsigned& nloc, unsigned& nx) {
    const unsigned G = gridDim.x * gridDim.y * gridDim.z;
    unsigned sum, cnt, mine, sp = 0u;
    for (;;) {
        sum = 0u; cnt = 0u; mine = 0u;
#pragma unroll
        for (unsigned j = 0; j < 16; ++j) { const unsigned c = xb_ld(&bar[XB_XCNT(j)]); sum += c; cnt += (c > 0u) ? 1u : 0u; mine = (j == x) ? c : mine; }
        if (sum == G) break;
        __builtin_amdgcn_s_sleep(1);
        if ((++sp & 255u) == 0u) { if (xb_ld(&bar[XB_TMO])) break; if (sp > XB_SPIN_CAP) { atomicAdd(&bar[XB_TMO], 1u); break; } }
    }
    nloc = mine > 0u ? mine : 1u; nx = cnt > 0u ? cnt : 1u;
}

__device__ __forceinline__ void xcd_barrier(const XcdBarrier& b) {
    asm volatile("s_waitcnt vmcnt(0)" ::: "memory");
    __syncthreads();
    if (threadIdx.x == 0) {
        unsigned* bar = b.bar;
        __builtin_amdgcn_s_waitcnt(0);
        unsigned nloc = b.st[0], nx = b.st[1];
        if (nloc == 0u) { xcd_barrier_complete(bar, b.x, nloc, nx); b.st[0] = nloc; b.st[1] = nx; }
        const unsigned old = xb_add(&bar[XB_XSUB(b.x)], 1u);
        const unsigned gen = old / nloc;
        if (old + 1u == (gen + 1u) * nloc) {
            __builtin_amdgcn_fence(__ATOMIC_RELEASE, "agent");
            asm volatile("s_waitcnt vmcnt(0)" ::: "memory");
            const unsigned og = xb_add(&bar[XB_TOP], 1u);
            const unsigned tg = og / nx;
            if (og + 1u == (tg + 1u) * nx) xb_add(&bar[XB_TOPGEN], 1u);
            else XB_SPIN(xb_ld(&bar[XB_TOPGEN]) == tg, bar);
            __builtin_amdgcn_fence(__ATOMIC_ACQUIRE, "agent");
            xb_add(&bar[XB_XGEN(b.x)], 1u);
            asm volatile("s_waitcnt vmcnt(0)" ::: "memory");
        } else {
            XB_SPIN(xb_ld(&bar[XB_XGEN(b.x)]) == gen, bar);
            __builtin_amdgcn_fence(__ATOMIC_ACQUIRE, "agent");
            asm volatile("s_waitcnt vmcnt(0)" ::: "memory");
        }
    }
    __syncthreads();
}
constexpr int NWAVES = 8;
constexpr int D = 2048, NB = 2, SEQ = 4096, T = NB * SEQ;
constexpr int SG = 128, SP = 64, SC = 16;
constexpr int NH = 16, HD = 128, NKV = 4, NGRP = 3;
constexpr int FF = 5632;
constexpr int NQ = NGRP * NH * HD, NKVC = NKV * HD;
constexpr int NQKV = NQ + 2 * NKVC;
constexpr float EPS = 1e-6f;
constexpr float QSCALE = 0.08838834764831845f * 1.4426950408889634f;

constexpr size_t MiB = 1u << 20;
constexpr size_t WS_CTL = 0, CTL_ZERO_BYTES = 1 * MiB;
constexpr size_t WS_RSTD0 = 1 * MiB;
constexpr size_t WS_WGLU = 2 * MiB, WS_WIN0 = 18 * MiB, WS_WOUT0 = 62 * MiB, WS_WQKV = 84 * MiB, WS_WO = 112 * MiB, WS_WIN1 = 120 * MiB, WS_WOUT1 = 164 * MiB;
constexpr size_t WS_XA = 186 * MiB;
constexpr size_t WS_XB = 250 * MiB;
constexpr size_t WS_ZO = 282 * MiB;
constexpr size_t WS_HQ = 314 * MiB;
constexpr size_t WS_K = 410 * MiB, WS_V = 418 * MiB;
constexpr size_t WS_OG = 426 * MiB;
constexpr size_t WS_LSE = 522 * MiB;
constexpr size_t WS_END = 524 * MiB;
constexpr int CW_TMO = 0, CW_CODE = 1, CW_BAR = 4096;
constexpr int CW_ROWSQ = 16384;
static_assert((CW_ROWSQ + 4 * T) * 4 <= (int)CTL_ZERO_BYTES, "ctl");

constexpr int RING_OFF = 0, RING_BYTES = 131072;
constexpr int LDSCTL_OFF = 155648, MISC_OFF = LDSCTL_OFF + 320;
constexpr int LDS_BYTES = 163840;

struct Frame {
    LAS unsigned char* lds;
    volatile LAS unsigned* MISC;
    gu32* ctl;
    int tid, lane, wave;
    int vcu, G;
};

__device__ __forceinline__ float wave_sum(float v) {
#pragma unroll
    for (int o = 1; o < 64; o <<= 1) v += __shfl_xor(v, o);
    return v;
}
__device__ __forceinline__ float wave_max(float v) {
#pragma unroll
    for (int o = 1; o < 64; o <<= 1) v = fmaxf(v, __shfl_xor(v, o));
    return v;
}
__device__ __forceinline__ void p0_transpose_item(const float* W, int K, int N, const float* gain, bf16* WT, int Nh, int row_off, LAS float* scr, int item, int lane) {
    const int nblk = N / 64, kb = item / nblk, nb = item % nblk, k0 = 64 * kb, n0 = 64 * nb;
    const int nq = lane & 15, kr = lane >> 4;
    f32x4 v[16];
#pragma unroll
    for (int j = 0; j < 16; ++j) v[j] = *(const GAS f32x4*)(W + (size_t)(k0 + 4 * j + kr) * N + n0 + 4 * nq);
    if (gain) {
#pragma unroll
        for (int j = 0; j < 16; ++j) v[j] = v[j] * gain[k0 + 4 * j + kr];
    }
#pragma unroll
    for (int j = 0; j < 16; ++j) { LAS float* d = scr + (4 * j + kr) * 65 + 4 * nq; d[0] = v[j].x; d[1] = v[j].y; d[2] = v[j].z; d[3] = v[j].w; }
    LDS_WAIT(); asm volatile("" ::: "memory");
    int drow0 = row_off + n0;
    if (Nh) { const int nn = n0 % Nh; drow0 = 256 * (nn / 128) + 128 * (n0 / Nh) + (nn % 128); }
    const int oct = lane & 7, ns = lane >> 3;
#pragma unroll
    for (int i = 0; i < 8; ++i) { const int n = 8 * i + ns; const LAS float* s = scr + (8 * oct) * 65 + n;
        v4u o; o.x = pk2(s[0 * 65], s[1 * 65]); o.y = pk2(s[2 * 65], s[3 * 65]); o.z = pk2(s[4 * 65], s[5 * 65]); o.w = pk2(s[6 * 65], s[7 * 65]);
        *(GAS v4u*)(WT + (size_t)(drow0 + n) * K + k0 + 8 * oct) = o; }
    LDS_WAIT(); asm volatile("" ::: "memory");
}

namespace s5 {
typedef float f32x16 __attribute__((ext_vector_type(16)));
constexpr int L = 8, NCH = 32, BLK = 256, NBLK = SEQ / BLK;
constexpr int O_PW = 0;
constexpr int O_A256 = 4608;
constexpr int O_KT = 5120;
constexpr int O_ET = O_KT + 4608;
constexpr int O_FT = O_ET + 32768;
constexpr int O_EB = O_FT + 32768;
constexpr int O_XT = O_EB + 8192;
constexpr int XT_ROW = 272, XT_WAVE = 32 * XT_ROW;
constexpr int BBS = 17, CCS = 65;
constexpr int O_BB = O_XT;
constexpr int O_CC = O_XT + 8704;
constexpr int O_KP = O_XT + 17408;
constexpr int LDS_END = O_XT + 8 * XT_WAVE;
static_assert(O_KP + 16384 <= LDS_END, "s5 lds");

__device__ __forceinline__ float dpp_x1(float v) { return __builtin_bit_cast(float, __builtin_amdgcn_mov_dpp(__builtin_bit_cast(int, v), 0xB1, 0xF, 0xF, true)); }
__device__ __forceinline__ float gelu_t(float y) {
    const float inner = y * (1.0f + 0.044715f * y * y);
    return y * __builtin_amdgcn_rcpf(1.0f + __builtin_amdgcn_exp2f(-2.3022081981f * inner));
}
__device__ __forceinline__ void disc(const float* lam_re, const float* lam_im, const float* log_dt, int g, int p, float& lbr, float& lbi, float& fr, float& fi) {
    const float lr = lam_re[g * SP + p], li = lam_im[g * SP + p], dt = expf(log_dt[g]);
    const float mag = expf(lr * dt), ang = li * dt;
    lbr = mag * cosf(ang); lbi = mag * sinf(ang);
    const float nr = lbr - 1.f, den = lr * lr + li * li;
    fr = (nr * lr + lbi * li) / den; fi = (lbi * lr - nr * li) / den;
}

struct Params { const float *x, *rstd0, *gn, *lam_re, *lam_im, *log_dt, *b_re, *b_im, *c_re, *c_im, *dsk; bf16* z; };

__device__ __forceinline__ void load_ufrag(bf16x8 (&uf)[8], const Params& P, size_t tok0  , int g, int n, int h, const float (&gnr)[8]) {
    const float* xp = P.x + (tok0 + 8 * n) * D + g * SC + 8 * h;
    const f32x4 r0 = *(const f32x4*)(P.rstd0 + tok0 + 8 * n), r1 = *(const f32x4*)(P.rstd0 + tok0 + 8 * n + 4);
    const float rs[8] = {r0[0], r0[1], r0[2], r0[3], r1[0], r1[1], r1[2], r1[3]};
#pragma unroll
    for (int s = 0; s < 8; ++s) {
        const f32x4 a = *(const f32x4*)(xp + (size_t)s * D), c = *(const f32x4*)(xp + (size_t)s * D + 4);
        v4u w;
        w.x = pg8::cvt_pk_bf16(a[0] * rs[s] * gnr[0], a[1] * rs[s] * gnr[1]); w.y = pg8::cvt_pk_bf16(a[2] * rs[s] * gnr[2], a[3] * rs[s] * gnr[3]);
        w.z = pg8::cvt_pk_bf16(c[0] * rs[s] * gnr[4], c[1] * rs[s] * gnr[5]); w.w = pg8::cvt_pk_bf16(c[2] * rs[s] * gnr[6], c[3] * rs[s] * gnr[7]);
        uf[s] = __builtin_bit_cast(bf16x8, w);
    }
}
__device__ __forceinline__ f32x16 stage_a(int cb, const bf16x8 (&uf)[8], const LAS unsigned char* lds, int lane) {
    f32x16 acc = (f32x16){0.f, 0.f, 0.f, 0.f, 0.f, 0.f, 0.f, 0.f, 0.f, 0.f, 0.f, 0.f, 0.f, 0.f, 0.f, 0.f};
#pragma unroll
    for (int s = 0; s < 8; ++s) {
        const bf16x8 e = *(const LAS bf16x8*)(lds + O_ET + ((s * 4 + cb) * 32 + (lane & 31)) * 32 + (lane >> 5) * 16);
        acc = __builtin_amdgcn_mfma_f32_32x32x16_bf16(uf[s], e, acc, 0, 0, 0);
    }
    return acc;
}

__device__ __forceinline__ void item(const Params& P, LAS unsigned char* lds, int b, int g, int tid, int wave, int lane) {
    const int rl = lane & 31, h = lane >> 5;
#ifndef S5_REP_SETUP
#define S5_REP_SETUP 1
#endif
#ifndef S5_REP_ROUNDS
#define S5_REP_ROUNDS 1
#endif
    float c1[4], c2[4], d1[4], d2[4]; float gnr[8];
#pragma unroll 1
    for (int rs_ = 0; rs_ < S5_REP_SETUP; ++rs_) {
    __syncthreads();
    if (tid < SP) {
        float lbr, lbi, fr, fi; disc(P.lam_re, P.lam_im, P.log_dt, g, tid, lbr, lbi, fr, fi);
        LAS float* pw = (LAS float*)(lds + O_PW);
        float pr = 1.f, pi = 0.f;
#pragma unroll
        for (int m = 0; m <= 8; ++m) { pw[(m * SP + tid) * 2] = pr; pw[(m * SP + tid) * 2 + 1] = pi; const float nr = pr * lbr - pi * lbi, ni = pr * lbi + pi * lbr; pr = nr; pi = ni; }
        float ar = pw[(8 * SP + tid) * 2], ai = pw[(8 * SP + tid) * 2 + 1];
#pragma unroll
        for (int k = 0; k < 5; ++k) { const float nr = ar * ar - ai * ai, ni = 2.f * ar * ai; ar = nr; ai = ni; }
        LAS float* a256 = (LAS float*)(lds + O_A256); a256[tid * 2] = ar; a256[tid * 2 + 1] = ai;
    }
    {
        LAS float* BB = (LAS float*)(lds + O_BB); LAS float* CC = (LAS float*)(lds + O_CC);
#pragma unroll
        for (int k = 0; k < 2; ++k) {
            const int idx = tid + 512 * k, p = idx >> 4, ci = idx & 15;
            float lbr, lbi, fr, fi; disc(P.lam_re, P.lam_im, P.log_dt, g, p, lbr, lbi, fr, fi);
            const float br = P.b_re[(g * SP + p) * SC + ci], bi = P.b_im[(g * SP + p) * SC + ci];
            BB[(p * BBS + ci) * 2] = fr * br - fi * bi; BB[(p * BBS + ci) * 2 + 1] = fr * bi + fi * br;
            CC[((idx >> 6) * CCS + (idx & 63)) * 2] = P.c_re[(size_t)g * SC * SP + idx]; CC[((idx >> 6) * CCS + (idx & 63)) * 2 + 1] = P.c_im[(size_t)g * SC * SP + idx];
        }
    }
    __syncthreads();
    {
        const LAS float* pw = (const LAS float*)(lds + O_PW); const LAS float* BB = (const LAS float*)(lds + O_BB); const LAS float* CC = (const LAS float*)(lds + O_CC);
        {
            const int ph = tid >> 8, co = (tid >> 4) & 15, ci = tid & 15;
            float kd[8];
#pragma unroll
            for (int d = 0; d < 8; ++d) kd[d] = 0.f;
#pragma unroll 2
            for (int pp = 0; pp < 32; ++pp) {
                const int p = ph * 32 + pp;
                const float cr = CC[(co * CCS + p) * 2], cim = CC[(co * CCS + p) * 2 + 1], lbr = pw[(SP + p) * 2], lbi = pw[(SP + p) * 2 + 1];
                float wr = BB[(p * BBS + ci) * 2], wi = BB[(p * BBS + ci) * 2 + 1];
#pragma unroll
                for (int d = 0; d < 8; ++d) { kd[d] += cr * wr - cim * wi; const float nr = wr * lbr - wi * lbi, ni = wr * lbi + wi * lbr; wr = nr; wi = ni; }
            }
            LAS float* KP = (LAS float*)(lds + O_KP);
#pragma unroll
            for (int d = 0; d < 8; ++d) KP[(ph * 8 + d) * 256 + co * 16 + ci] = kd[d];
        }
        __builtin_amdgcn_sched_barrier(0);
        {
#pragma unroll 1
            for (int k = 0; k < 2; ++k) {
                const int pair = tid + 512 * k, s = pair >> 7, rho = pair & 127, p = rho >> 1, part = rho & 1;
                const float qr = pw[((7 - s) * SP + p) * 2], qi = pw[((7 - s) * SP + p) * 2 + 1];
                float v[16];
#pragma unroll
                for (int ci = 0; ci < 16; ++ci) { const float br = BB[(p * BBS + ci) * 2], bi = BB[(p * BBS + ci) * 2 + 1]; v[ci] = part ? (qr * bi + qi * br) : (qr * br - qi * bi); }
                LAS v4u* dst = (LAS v4u*)(lds + O_ET + (s * 128 + rho) * 32);
                v4u w0, w1;
                w0.x = pg8::cvt_pk_bf16(v[0], v[1]); w0.y = pg8::cvt_pk_bf16(v[2], v[3]); w0.z = pg8::cvt_pk_bf16(v[4], v[5]); w0.w = pg8::cvt_pk_bf16(v[6], v[7]);
                w1.x = pg8::cvt_pk_bf16(v[8], v[9]); w1.y = pg8::cvt_pk_bf16(v[10], v[11]); w1.z = pg8::cvt_pk_bf16(v[12], v[13]); w1.w = pg8::cvt_pk_bf16(v[14], v[15]);
                dst[0] = w0; dst[1] = w1;
            }
        }
        __builtin_amdgcn_sched_barrier(0);
        {
#pragma unroll 1
            for (int k = 0; k < 4; ++k) {
                const int tup = tid + 512 * k, hh = tup & 1, r = (tup >> 1) & 31, i = (tup >> 6) & 3, ks = tup >> 8;
                const int t = 2 * i + (r >> 4), co = r & 15;
                float v[8];
#pragma unroll
                for (int jj = 0; jj < 4; ++jj) {
                    const int p = 8 * ks + 4 * hh + jj;
                    const float cr = CC[(co * CCS + p) * 2], cim = CC[(co * CCS + p) * 2 + 1], qr = pw[((t + 1) * SP + p) * 2], qi = pw[((t + 1) * SP + p) * 2 + 1];
                    v[2 * jj] = cr * qr - cim * qi; v[2 * jj + 1] = -(cr * qi + cim * qr);
                }
                v4u w; w.x = pg8::cvt_pk_bf16(v[0], v[1]); w.y = pg8::cvt_pk_bf16(v[2], v[3]); w.z = pg8::cvt_pk_bf16(v[4], v[5]); w.w = pg8::cvt_pk_bf16(v[6], v[7]);
                *(LAS v4u*)(lds + O_FT + tup * 16) = w;
            }
        }
    }
    __syncthreads();
    {
        const LAS float* KP = (const LAS float*)(lds + O_KP);
        LAS unsigned short* KT = (LAS unsigned short*)(lds + O_KT);
#pragma unroll
        for (int k = 0; k < 4; ++k) { const int idx = tid + 512 * k; KT[256 + idx] = (unsigned short)f2bf(KP[idx] + KP[2048 + idx]); }
        if (tid < 256) KT[tid] = 0;
    }
    {
        const LAS float* pw = (const LAS float*)(lds + O_PW); const LAS float* a256 = (const LAS float*)(lds + O_A256);
#pragma unroll
        for (int cb = 0; cb < 4; ++cb) { const int p = 16 * cb + (rl >> 1); const float ar = pw[(8 * SP + p) * 2], ai = pw[(8 * SP + p) * 2 + 1], br = a256[p * 2], bi = a256[p * 2 + 1];
            c1[cb] = ar; c2[cb] = (rl & 1) ? ai : -ai; d1[cb] = br; d2[cb] = (rl & 1) ? bi : -bi; }
    }
#pragma unroll
    for (int j = 0; j < 8; ++j) gnr[j] = P.gn[g * SC + 8 * h + j];
    __syncthreads();
    }
#pragma unroll 1
    for (int rr_ = 0; rr_ < S5_REP_ROUNDS; ++rr_) {
    float cbase[4] = {0.f, 0.f, 0.f, 0.f};
    f32x4 dv0, dv1;
    dv0 = *(const f32x4*)(P.dsk + g * SC + 4 * h); dv1 = *(const f32x4*)(P.dsk + g * SC + 8 + 4 * h);
    LAS unsigned char* xt = lds + O_XT + wave * XT_WAVE;
#pragma unroll 1
    for (int round = 0; round < 2; ++round) {
        const int blk = wave + 8 * round;
        const size_t tok0 = (size_t)b * SEQ + (size_t)blk * BLK;
        bf16x8 uf[8]; load_ufrag(uf, P, tok0, g, rl, h, gnr);
        f32x16 S[4];
#pragma unroll
        for (int cb = 0; cb < 4; ++cb) {
            S[cb] = stage_a(cb, uf, lds, lane);
            float c = 0.f;
#pragma unroll
            for (int g4 = 0; g4 < 8; ++g4) {
                float cc = c;
#pragma unroll
                for (int r4 = 0; r4 < 4; ++r4) cc = c1[cb] * cc + (c2[cb] * dpp_x1(cc) + S[cb][4 * (g4 >> 1) + r4]);
                const float oth = __shfl_xor(cc, 32);
                c = (h == (g4 & 1)) ? cc : oth;
            }
            if (h == 0) ((LAS float*)(lds + O_EB))[blk * 128 + 32 * cb + rl] = c;
        }
        __syncthreads();
        float cin[4];
#pragma unroll
        for (int cb = 0; cb < 4; ++cb) cin[cb] = cbase[cb];
        for (int k = 0; k < 8; ++k) {
            if (k == wave) {
#pragma unroll
                for (int cb = 0; cb < 4; ++cb) cin[cb] = cbase[cb];
            }
#pragma unroll
            for (int cb = 0; cb < 4; ++cb) cbase[cb] = d1[cb] * cbase[cb] + (d2[cb] * dpp_x1(cbase[cb]) + ((const LAS float*)(lds + O_EB))[(8 * round + k) * 128 + 32 * cb + rl]);
        }
#pragma unroll
        for (int cb = 0; cb < 4; ++cb) {
            float c = cin[cb];
#pragma unroll
            for (int g4 = 0; g4 < 8; ++g4) {
                float cc = c;
#pragma unroll
                for (int r4 = 0; r4 < 4; ++r4) { const int q = 4 * (g4 >> 1) + r4; const float sv = S[cb][q]; if (h == (g4 & 1)) S[cb][q] = cc; cc = c1[cb] * cc + (c2[cb] * dpp_x1(cc) + sv); }
                const float oth = __shfl_xor(cc, 32);
                c = (h == (g4 & 1)) ? cc : oth;
            }
#pragma unroll
            for (int q = 0; q < 16; ++q) { const int n = (q & 3) + 8 * (q >> 2) + 4 * h; *(LAS unsigned short*)(xt + n * XT_ROW + (32 * cb + rl) * 2) = (unsigned short)f2bf(S[cb][q]); }
        }
        LDS_WAIT(); asm volatile("" ::: "memory");
#pragma unroll 1
        for (int i = 0; i < 4; ++i) {
            f32x16 y = (f32x16){0.f, 0.f, 0.f, 0.f, 0.f, 0.f, 0.f, 0.f, 0.f, 0.f, 0.f, 0.f, 0.f, 0.f, 0.f, 0.f};
#pragma unroll
            for (int s = 0; s < 8; ++s) {
                int jx = 2 * i - s + 1 + (rl >> 4); jx = jx < 0 ? 0 : jx;
                const bf16x8 ph = *(const LAS bf16x8*)(lds + O_KT + (jx * 16 + (rl & 15)) * 32 + h * 16);
                y = __builtin_amdgcn_mfma_f32_32x32x16_bf16(ph, uf[s], y, 0, 0, 0);
            }
#pragma unroll
            for (int ks = 0; ks < 8; ++ks) {
                const bf16x8 ff = *(const LAS bf16x8*)(lds + O_FT + (((ks * 4 + i) * 32 + rl) * 2 + h) * 16);
                const bf16x8 xf = *(const LAS bf16x8*)(xt + rl * XT_ROW + ks * 32 + h * 16);
                y = __builtin_amdgcn_mfma_f32_32x32x16_bf16(ff, xf, y, 0, 0, 0);
            }
#pragma unroll
            for (int ts = 0; ts < 2; ++ts) {
                const bf16x8 us = (i == 0) ? uf[ts] : (i == 1) ? uf[2 + ts] : (i == 2) ? uf[4 + ts] : uf[6 + ts];
                const v4u uw = __builtin_bit_cast(v4u, us);
                const auto s0 = __builtin_amdgcn_permlane32_swap(uw.x, uw.z, false, false), s1 = __builtin_amdgcn_permlane32_swap(uw.y, uw.w, false, false);
                const unsigned ua[2][2] = {{s0[0], s1[0]}, {s0[1], s1[1]}};
                const size_t tok = tok0 + 8 * rl + 2 * i + ts;
#pragma unroll
                for (int h8 = 0; h8 < 2; ++h8) {
                    const int c0 = 8 * h8 + 4 * h;
                    const f32x4 dv = h8 ? dv1 : dv0;
                    const float u0 = __builtin_bit_cast(float, ua[h8][0] << 16), u1 = __builtin_bit_cast(float, ua[h8][0] & 0xffff0000u);
                    const float u2 = __builtin_bit_cast(float, ua[h8][1] << 16), u3 = __builtin_bit_cast(float, ua[h8][1] & 0xffff0000u);
                    const float o0 = gelu_t(y[8 * ts + 4 * h8 + 0] + dv[0] * u0), o1 = gelu_t(y[8 * ts + 4 * h8 + 1] + dv[1] * u1);
                    const float o2 = gelu_t(y[8 * ts + 4 * h8 + 2] + dv[2] * u2), o3 = gelu_t(y[8 * ts + 4 * h8 + 3] + dv[3] * u3);
                    uint2 w; w.x = pg8::cvt_pk_bf16(o0, o1); w.y = pg8::cvt_pk_bf16(o2, o3);
                    *(uint2*)(P.z + tok * D + g * SC + c0) = w;
                }
            }
        }
        LDS_WAIT(); asm volatile("" ::: "memory");
    }
    }
}
}
namespace att {
typedef float f32x16 __attribute__((ext_vector_type(16)));
typedef short s16x4 __attribute__((ext_vector_type(4)));
constexpr int TILE = 16384;
constexpr int O_V = 0, O_K = 3 * TILE, O_WS = 6 * TILE, LDS_END = O_WS + 8 * 64 * 4;
#define ATT_KSWZ(row, colB) ((row) * 256 + ((colB) ^ (((row) & 7) << 4)))
#define ATT_SBAR() __builtin_amdgcn_sched_barrier(0)
__device__ __forceinline__ int v_st(int k, int c) { const int kk = (k & ~0xC) | ((k & 4) << 1) | ((k & 8) >> 1); return ((kk >> 3) * 4 + (c >> 5)) * 512 + ((kk & 7) * 32 + (c & 31)) * 2; }
__device__ __forceinline__ int v_rd_base(int lane) { return ((lane & 3) << 3) | (((lane >> 2) & 3) << 6) | (((lane >> 4) & 1) << 5) | (((lane >> 5) & 1) << 8); }
constexpr int v_rd_off(int d0, int ks, int half) { return d0 * 512 + ks * 4096 + half * 2048; }
__device__ __forceinline__ int crow(int r, int hi) { return (r & 3) + 8 * (r >> 2) + 4 * hi; }
__device__ __forceinline__ unsigned cvtpk(float lo, float hi) { unsigned r; asm volatile("v_cvt_pk_bf16_f32 %0, %1, %2" : "=v"(r) : "v"(lo), "v"(hi)); return r; }
__device__ __forceinline__ void mask_tile(f32x16& p0, f32x16& p1, int dq) {
    const float NEG = -__builtin_inff();
#pragma unroll
    for (int r = 0; r < 16; ++r) {
        const int c = (r & 3) + 8 * (r >> 2);
        if ((unsigned)(dq - c) >= 129u) p0[r] = NEG;
        if ((unsigned)(dq - c - 32) >= 129u) p1[r] = NEG;
    }
}
__device__ __forceinline__ void partialSM(f32x16& p0, f32x16& p1, float& m_reg, float& alpha) {
    float pmax = p0[0];
#pragma unroll
    for (int r = 1; r < 16; ++r) pmax = fmaxf(pmax, p0[r]);
#pragma unroll
    for (int r = 0; r < 16; ++r) pmax = fmaxf(pmax, p1[r]);
    { auto rr = __builtin_amdgcn_permlane32_swap(__float_as_uint(pmax), __float_as_uint(pmax), false, false);
      pmax = fmaxf(__uint_as_float(rr[0]), __uint_as_float(rr[1])); }
    float mn;
    if (__all(pmax <= m_reg)) { mn = m_reg; alpha = 1.f; }
    else { mn = fmaxf(m_reg, pmax); alpha = __builtin_amdgcn_exp2f(m_reg - mn); m_reg = mn; }
#pragma unroll
    for (int r = 0; r < 16; ++r) { p0[r] = __builtin_amdgcn_exp2f(p0[r] - mn); p1[r] = __builtin_amdgcn_exp2f(p1[r] - mn); }
}
__device__ __forceinline__ void finishSM(const f32x16& p0, const f32x16& p1, float alpha, float& l_reg, bf16x8& pa0, bf16x8& pa1, bf16x8& pa2, bf16x8& pa3) {
    float ps = 0.f;
#pragma unroll
    for (int r = 0; r < 16; ++r) ps += p0[r];
#pragma unroll
    for (int r = 0; r < 16; ++r) ps += p1[r];
    { auto rr = __builtin_amdgcn_permlane32_swap(__float_as_uint(ps), __float_as_uint(ps), false, false);
      ps = __uint_as_float(rr[0]) + __uint_as_float(rr[1]); }
    l_reg = l_reg * alpha + ps;
#define ATT_PK4(P, B_, OUT) do { unsigned a0 = cvtpk(P[B_+0], P[B_+1]), a1 = cvtpk(P[B_+2], P[B_+3]);                          \
        unsigned b0 = cvtpk(P[B_+4], P[B_+5]), b1 = cvtpk(P[B_+6], P[B_+7]);                                             \
        auto r0 = __builtin_amdgcn_permlane32_swap(a0, b0, false, false); auto r1 = __builtin_amdgcn_permlane32_swap(a1, b1, false, false); \
        v4u w = {r0[0], r1[0], r0[1], r1[1]}; OUT = __builtin_bit_cast(bf16x8, w); } while (0)
    ATT_PK4(p0, 0, pa0); ATT_PK4(p0, 8, pa1); ATT_PK4(p1, 0, pa2); ATT_PK4(p1, 8, pa3);
#undef ATT_PK4
}
__device__ __forceinline__ void qkt(f32x16& p0, f32x16& p1, const LAS unsigned char* K_t, int r32, int hi, const bf16x8* qr) {
    p0 = (f32x16){0.f, 0.f, 0.f, 0.f, 0.f, 0.f, 0.f, 0.f, 0.f, 0.f, 0.f, 0.f, 0.f, 0.f, 0.f, 0.f}; p1 = p0;
    const LAS unsigned char* kb[4];
#pragma unroll
    for (int dd = 0; dd < 4; ++dd) kb[dd] = K_t + ATT_KSWZ(r32, (dd * 16 + hi * 8) * 2);
#pragma unroll
    for (int d0 = 0; d0 < 8; ++d0) { const LAS unsigned char* a = kb[d0 & 3] + (d0 >> 2) * 128;
        const bf16x8 b0 = *(const LAS bf16x8*)a;
        const bf16x8 b1 = *(const LAS bf16x8*)(a + 32 * 256);
        p0 = __builtin_amdgcn_mfma_f32_32x32x16_bf16(b0, qr[d0], p0, 0, 0, 0);
        p1 = __builtin_amdgcn_mfma_f32_32x32x16_bf16(b1, qr[d0], p1, 0, 0, 0); }
}
template <int VB>
__device__ __forceinline__ void pv_tile(f32x16* o, int vb0, bf16x8 pa0, bf16x8 pa1, bf16x8 pa2, bf16x8 pa3) {
#define ATT_TRRD(dst, off) asm volatile("ds_read_b64_tr_b16 %0, %1 offset:%2" : "=&v"(dst) : "v"(vb0), "i"(off) : "memory")
#define ATT_PV_D0(d0) do { s16x4 l0, l1, l2, l3, h0, h1, h2, h3; constexpr int b_ = O_V + VB * TILE + v_rd_off(d0, 0, 0); \
        ATT_TRRD(l0, b_); ATT_TRRD(h0, b_ + 2048); ATT_TRRD(l1, b_ + 4096); ATT_TRRD(h1, b_ + 6144); ATT_TRRD(l2, b_ + 8192); ATT_TRRD(h2, b_ + 10240); ATT_TRRD(l3, b_ + 12288); ATT_TRRD(h3, b_ + 14336); \
        asm volatile("s_waitcnt lgkmcnt(0)" ::: "memory"); ATT_SBAR();   \
        o[d0] = __builtin_amdgcn_mfma_f32_32x32x16_bf16(pa0, (bf16x8){l0[0], l0[1], l0[2], l0[3], h0[0], h0[1], h0[2], h0[3]}, o[d0], 0, 0, 0);   \
        o[d0] = __builtin_amdgcn_mfma_f32_32x32x16_bf16(pa1, (bf16x8){l1[0], l1[1], l1[2], l1[3], h1[0], h1[1], h1[2], h1[3]}, o[d0], 0, 0, 0);   \
        o[d0] = __builtin_amdgcn_mfma_f32_32x32x16_bf16(pa2, (bf16x8){l2[0], l2[1], l2[2], l2[3], h2[0], h2[1], h2[2], h2[3]}, o[d0], 0, 0, 0);   \
        o[d0] = __builtin_amdgcn_mfma_f32_32x32x16_bf16(pa3, (bf16x8){l3[0], l3[1], l3[2], l3[3], h3[0], h3[1], h3[2], h3[3]}, o[d0], 0, 0, 0); } while (0)
    ATT_PV_D0(0); ATT_PV_D0(1); ATT_PV_D0(2); ATT_PV_D0(3);
#undef ATT_PV_D0
#undef ATT_TRRD
}

struct Tensors { const bf16* Q; const bf16* K; const bf16* V; bf16* OG; float* LSE; bf16* O; };

template <int TT>
__device__ __forceinline__ void tile_step(f32x16 (&o)[4], float& m_reg, float& l_reg, const LAS unsigned char* lds, LAS float* al_l, int vb0, int r32, int hi, const bf16x8* qr, int dq, bool first) {
    f32x16 p0, p1; float alpha; bf16x8 pa0, pa1, pa2, pa3;
    qkt(p0, p1, lds + O_K + TT * TILE, r32, hi, qr);
    mask_tile(p0, p1, dq);
    partialSM(p0, p1, m_reg, alpha);
    finishSM(p0, p1, alpha, l_reg, pa0, pa1, pa2, pa3);
    if (!first && __any(alpha < 1.f)) {
        if (hi == 0) al_l[r32] = alpha;
        asm volatile("s_waitcnt lgkmcnt(0)" ::: "memory");
#pragma unroll
        for (int d_ = 0; d_ < 4; ++d_)
#pragma unroll
            for (int r = 0; r < 16; ++r) o[d_][r] *= al_l[crow(r, hi)];
    }
    ATT_SBAR();
    pv_tile<TT>(o, vb0, pa0, pa1, pa2, pa3);
}

template <bool MERGE>
__device__ __forceinline__ void unit(const Tensors& TS, LAS unsigned char* lds, int pair, int g, int rho, int qb, int npair, int ng, int nrho, int nqb  , int tid, int wid, int lane) {
    const int r32 = lane & 31, hi = lane >> 5;
    const int b = pair >> 2, kvh = pair & 3, dil = (g == 0) ? 1 : (g == 1 ? 4 : 16);
    const int i0 = qb * 64;
    const size_t trow0 = (size_t)b * SEQ;
    const int sr = tid >> 4, sc = (tid & 15) * 8;
    const int t_lo = (i0 >= 128) ? 0 : ((i0 >= 64) ? 1 : 2);
#ifndef ATT_REP_STAGE
#define ATT_REP_STAGE 1
#endif
#ifndef ATT_REP_COMP
#define ATT_REP_COMP 1
#endif
#ifndef ATT_REP_EPI
#define ATT_REP_EPI 1
#endif
    const int hq = 4 * kvh + (wid & 3), a = wid >> 2, iq = i0 + 32 * a + r32;
    const size_t qtok = trow0 + rho + (size_t)dil * iq;
    bf16x8 qr[8];
#pragma unroll 1
    for (int rs_ = 0; rs_ < ATT_REP_STAGE; ++rs_) {
    if (rs_) __syncthreads();
    bf16x8 st[3][4];
#pragma unroll
    for (int tt = 0; tt < 3; ++tt) if (tt >= t_lo) {
        const int kl = i0 - 128 + 64 * tt;
        const size_t r0 = (trow0 + rho + (size_t)dil * (kl + sr)) * NKVC + kvh * HD + sc, r1 = r0 + (size_t)dil * 32 * NKVC;
        st[tt][0] = *(const bf16x8*)(TS.K + r0); st[tt][1] = *(const bf16x8*)(TS.K + r1);
        st[tt][2] = *(const bf16x8*)(TS.V + r0); st[tt][3] = *(const bf16x8*)(TS.V + r1);
    }
    { const bf16* qp = TS.Q + qtok * NQ + g * (NH * HD) + hq * HD + hi * 8;
#pragma unroll
      for (int d0 = 0; d0 < 8; ++d0) qr[d0] = *(const bf16x8*)(qp + d0 * 16); }
    const int kws = ATT_KSWZ(sr, sc * 2), vst0 = v_st(sr, sc), vst1 = v_st(32 + sr, sc);
#pragma unroll
    for (int tt = 0; tt < 3; ++tt) if (tt >= t_lo) {
        *(LAS bf16x8*)(lds + O_K + tt * TILE + kws) = st[tt][0]; *(LAS bf16x8*)(lds + O_K + tt * TILE + kws + 32 * 256) = st[tt][1];
        *(LAS bf16x8*)(lds + O_V + tt * TILE + vst0) = st[tt][2]; *(LAS bf16x8*)(lds + O_V + tt * TILE + vst1) = st[tt][3];
    }
    __syncthreads();
    }
    float pf = 0.f;
    if (npair >= 0) {
        const int ndil = (ng == 0) ? 1 : (ng == 1 ? 4 : 16);
        const size_t ntok = (size_t)(npair >> 2) * SEQ + nrho + (size_t)ndil * (nqb * 64 + (tid >> 3));
        pf += __builtin_bit_cast(float, *(const volatile unsigned*)(TS.Q + ntok * NQ + ng * (NH * HD) + 4 * (npair & 3) * HD + (tid & 7) * 64));
    }
    if constexpr (MERGE) {
        const size_t mtok = trow0 + rho + (size_t)dil * (i0 + (tid >> 3));
        const bf16* og = TS.OG + mtok * D + 4 * kvh * HD + (tid & 7) * 64;
        pf += __builtin_bit_cast(float, *(const volatile unsigned*)og) + __builtin_bit_cast(float, *(const volatile unsigned*)(og + (size_t)T * D));
    }
    LAS float* ws = (LAS float*)(lds + O_WS) + wid * 64; LAS float* al_l = ws; LAS float* li_l = ws + 32;
    const int vb0 = (int)(unsigned)(uintptr_t)(lds + O_V) + v_rd_base(lane);
    float m_reg, l_reg; f32x16 o[4];
#pragma unroll 1
    for (int rc_ = 0; rc_ < ATT_REP_COMP; ++rc_) {
    m_reg = -1e30f; l_reg = 0.f;
#pragma unroll
    for (int d_ = 0; d_ < 4; ++d_) o[d_] = (f32x16){0.f, 0.f, 0.f, 0.f, 0.f, 0.f, 0.f, 0.f, 0.f, 0.f, 0.f, 0.f, 0.f, 0.f, 0.f, 0.f};
    const int dq0 = 32 * a + r32 + 128 - 4 * hi;
    if (t_lo <= 0) tile_step<0>(o, m_reg, l_reg, lds, al_l, vb0, r32, hi, qr, dq0, true);
    if (t_lo <= 1) tile_step<1>(o, m_reg, l_reg, lds, al_l, vb0, r32, hi, qr, dq0 - 64, t_lo == 1);
    tile_step<2>(o, m_reg, l_reg, lds, al_l, vb0, r32, hi, qr, dq0 - 128, t_lo == 2);
    }
#pragma unroll 1
    for (int re_ = 0; re_ < ATT_REP_EPI; ++re_) {
    if (re_) __syncthreads();
    if (hi == 0) li_l[r32] = l_reg;
    asm volatile("s_waitcnt lgkmcnt(0)" ::: "memory");
    float rli[16];
#pragma unroll
    for (int r = 0; r < 16; ++r) rli[r] = __builtin_amdgcn_rcpf(li_l[crow(r, hi)]);
    const float lse = m_reg + __builtin_amdgcn_logf(l_reg);
    __syncthreads();
    LAS unsigned char* stg = lds + wid * 8192;
#pragma unroll
    for (int r = 0; r < 16; ++r) { const int orow = crow(r, hi);
#pragma unroll
        for (int d0 = 0; d0 < 4; ++d0) { const float v = o[d0][r] * rli[r];
            const float vn = __builtin_bit_cast(float, __builtin_amdgcn_mov_dpp(__builtin_bit_cast(int, v), 0xB1, 0xF, 0xF, true));
            if ((r32 & 1) == 0) *(LAS unsigned*)(stg + orow * 256 + (d0 * 32 + r32) * 2) = cvtpk(v, vn); } }
    if (hi == 0) al_l[r32] = lse;
    asm volatile("s_waitcnt lgkmcnt(0)" ::: "memory");
#pragma unroll
    for (int i = 0; i < 8; ++i) {
        const int row = i * 4 + (lane >> 4), ch = lane & 15;
        const size_t tok = trow0 + rho + (size_t)dil * (i0 + 32 * a + row);
        const v4u ov = *(const LAS v4u*)(stg + row * 256 + ch * 16);
        if constexpr (!MERGE) {
            *(v4u*)(TS.OG + (size_t)(g - 1) * T * D + tok * D + hq * HD + ch * 8) = ov;
            if (ch == 0) TS.LSE[(size_t)(g - 1) * T * NH + tok * NH + hq] = al_l[row];
        } else {
            const float l0 = al_l[row], l1 = TS.LSE[tok * NH + hq], l2 = TS.LSE[(size_t)T * NH + tok * NH + hq];
            const float mx = fmaxf(fmaxf(l0, l1), l2);
            float w0 = __builtin_amdgcn_exp2f(l0 - mx), w1 = __builtin_amdgcn_exp2f(l1 - mx), w2 = __builtin_amdgcn_exp2f(l2 - mx);
            const float inv = __builtin_amdgcn_rcpf(w0 + w1 + w2); w0 *= inv; w1 *= inv; w2 *= inv;
            const v4u o1 = *(const v4u*)(TS.OG + tok * D + hq * HD + ch * 8), o2 = *(const v4u*)(TS.OG + (size_t)T * D + tok * D + hq * HD + ch * 8);
            v4u res;
#pragma unroll
            for (int e = 0; e < 4; ++e) {
                const float lo = w0 * __builtin_bit_cast(float, ov[e] << 16) + w1 * __builtin_bit_cast(float, o1[e] << 16) + w2 * __builtin_bit_cast(float, o2[e] << 16);
                const float hi_ = w0 * __builtin_bit_cast(float, ov[e] & 0xffff0000u) + w1 * __builtin_bit_cast(float, o1[e] & 0xffff0000u) + w2 * __builtin_bit_cast(float, o2[e] & 0xffff0000u);
                res[e] = cvtpk(lo, hi_);
            }
            *(v4u*)(TS.O + tok * D + hq * HD + ch * 8) = res;
        }
    }
    }
    if (__builtin_bit_cast(unsigned, pf) == 0x7fc12345u) TS.LSE[0] = pf;
    __syncthreads();
}
#undef ATT_KSWZ
#undef ATT_SBAR
}
__device__ __forceinline__ float bf2f(bf16 v) { return __builtin_bit_cast(float, (unsigned)v << 16); }
__device__ __forceinline__ float gelu_tanh(float y) {
    const float k0 = 0.7978845608028654f, k1 = 0.044715f;
    return 0.5f * y * (1.f + tanhf(k0 * (y + k1 * y * y * y)));
}
__device__ __forceinline__ void s5_simple_item(int bg, int p, const float* __restrict__ x, const float* __restrict__ rstd, const float* __restrict__ gn,
        const float* __restrict__ lam_re, const float* __restrict__ lam_im, const float* __restrict__ log_dt,
        const float* __restrict__ b_re, const float* __restrict__ b_im, const float* __restrict__ c_re, const float* __restrict__ c_im,
        const float* __restrict__ d_skip, bf16* __restrict__ z) {
    constexpr int G = SG, P = SP, C = SC, S = SEQ;
    const int b = bg / G, g = bg % G;
    const float lr = lam_re[g * P + p], li = lam_im[g * P + p];
    const float dt = expf(log_dt[g]);
    const float mag = expf(lr * dt), ang = li * dt;
    const float lbr = mag * cosf(ang), lbi = mag * sinf(ang);
    const float nr = lbr - 1.f, den = lr * lr + li * li;
    const float fr = (nr * lr + lbi * li) / den, fi = (lbi * lr - nr * li) / den;
    float bbr[C], bbi[C], cr[C], ci[C];
#pragma unroll
    for (int c = 0; c < C; ++c) {
        const float br = b_re[(g * P + p) * C + c], bi = b_im[(g * P + p) * C + c];
        bbr[c] = fr * br - fi * bi; bbi[c] = fr * bi + fi * br;
        cr[c] = c_re[(g * C + c) * P + p]; ci[c] = c_im[(g * C + c) * P + p];
    }
    const int pc = p & 15;
    const float gnp = gn[g * C + pc], dp = d_skip[g * C + pc];
    float gnc[C];
#pragma unroll
    for (int c = 0; c < C; ++c) gnc[c] = gn[g * C + c];
    float xr = 0.f, xi = 0.f;
    for (int t = 0; t < S; ++t) {
        const size_t row = (size_t)b * S + t;
        const float* xp = x + row * D + g * C;
        const float r = rstd[row];
        float bur = 0.f, bui = 0.f;
#pragma unroll
        for (int c = 0; c < C; ++c) { const float u = xp[c] * r * gnc[c]; bur += bbr[c] * u; bui += bbi[c] * u; }
        const float nxr = lbr * xr - lbi * xi + bur, nxi = lbr * xi + lbi * xr + bui;
        xr = nxr; xi = nxi;
        float myy = 0.f;
#pragma unroll
        for (int c = 0; c < C; ++c) { float v = cr[c] * xr - ci[c] * xi; v = wave_sum(v); if (p == c) myy = v; }
        if (p < C) { const float up = xp[pc] * r * gnp; z[row * D + g * C + p] = (bf16)f2bf(gelu_tanh(myy + dp * up)); }
    }
}
struct ConvJob { const float* W; const float* gain; bf16* WT; int K, N, Nh, row_off, items; };
__device__ __forceinline__ ConvJob conv_job(int j, const float* const* in, unsigned char* ws) {
    ConvJob J;
    switch (j) {
    case 0:  J = ConvJob{in[9], nullptr, (bf16*)(ws + WS_WGLU), D, 2 * D, D, 0, (D / 64) * (2 * D / 64)}; break;
    case 1:  J = ConvJob{in[12], in[11], (bf16*)(ws + WS_WIN0), D, 2 * FF, FF, 0, (D / 64) * (2 * FF / 64)}; break;
    case 2:  J = ConvJob{in[13], nullptr, (bf16*)(ws + WS_WOUT0), FF, D, 0, 0, (FF / 64) * (D / 64)}; break;
    case 3:  J = ConvJob{in[15], in[14], (bf16*)(ws + WS_WQKV), D, NQ, 0, 0, (D / 64) * (NQ / 64)}; break;
    case 4:  J = ConvJob{in[18], in[17], (bf16*)(ws + WS_WQKV), D, 2 * NKVC, 0, NQ, (D / 64) * (2 * NKVC / 64)}; break;
    case 5:  J = ConvJob{in[16], nullptr, (bf16*)(ws + WS_WO), D, D, 0, 0, (D / 64) * (D / 64)}; break;
    case 6:  J = ConvJob{in[12] + (size_t)D * 2 * FF, in[11] + D, (bf16*)(ws + WS_WIN1), D, 2 * FF, FF, 0, (D / 64) * (2 * FF / 64)}; break;
    default: J = ConvJob{in[13] + (size_t)FF * D, nullptr, (bf16*)(ws + WS_WOUT1), FF, D, 0, 0, (FF / 64) * (D / 64)}; break;
    }
    return J;
}
__device__ __forceinline__ void conv_jobs(int j_lo, int j_hi, int w, int nw, const float* const* in, unsigned char* ws, LAS float* scr, int lane) {
    asm volatile("" : "+v"(lane));
    int off = 0;
#pragma unroll 1
    for (int j = j_lo; j < j_hi; ++j) {
        const ConvJob J = conv_job(j, in, ws);
        int first = w - off; if (first < 0) first += nw;
#pragma unroll 1
        for (int it = first; it < J.items; it += nw) p0_transpose_item(J.W, J.K, J.N, J.gain, J.WT, J.Nh, J.row_off, scr, it, lane);
        off = (off + J.items) % nw;
    }
}
__device__ __forceinline__ void idle_rank(int nwg, int G, int c, int& rank, int& cnt) {
    const int rounds = (nwg + G - 1) / G, c0 = nwg - (rounds - 1) * G;
    if (c0 >= G) { rank = c; cnt = G; } else { rank = c - c0; cnt = G - c0; }
}

struct Args { const float* in[20]; float* out; unsigned char* ws; int ph_lo, ph_hi; };

__global__ void __launch_bounds__(NWAVES * 64, 2) mk_fwd(Args args) {
    extern __shared__ __attribute__((aligned(16))) unsigned char lds[];
    Frame F;
    F.lds = (LAS unsigned char*)lds;
    F.MISC = (volatile LAS unsigned*)(F.lds + MISC_OFF);
    F.tid = threadIdx.x; F.lane = F.tid & 63; F.wave = __builtin_amdgcn_readfirstlane(F.tid >> 6);
    F.G = gridDim.x; { const int bx = blockIdx.x; F.vcu = (F.G % 8 == 0) ? (bx % 8) * (F.G / 8) + bx / 8 : bx; }
    unsigned char* ws = args.ws;
    F.ctl = (gu32*)(ws + WS_CTL);
    const float* x = args.in[0];
    bf16* WgluT = (bf16*)(ws + WS_WGLU); bf16* Win0T = (bf16*)(ws + WS_WIN0); bf16* Wout0T = (bf16*)(ws + WS_WOUT0); bf16* WqkvT = (bf16*)(ws + WS_WQKV);
    bf16* WoT = (bf16*)(ws + WS_WO); bf16* Win1T = (bf16*)(ws + WS_WIN1); bf16* Wout1T = (bf16*)(ws + WS_WOUT1);
    float* XA = (float*)(ws + WS_XA); bf16* XB = (bf16*)(ws + WS_XB); bf16* ZO = (bf16*)(ws + WS_ZO); bf16* HQ = (bf16*)(ws + WS_HQ);
    bf16* KB = (bf16*)(ws + WS_K); bf16* VB = (bf16*)(ws + WS_V);
    float* rstd0 = (float*)(ws + WS_RSTD0);
    float* rowsq = (float*)(ws + WS_CTL) + CW_ROWSQ;
    for (int u = F.tid; u < (LDS_BYTES - LDSCTL_OFF) / 4; u += NWAVES * 64) ((LAS unsigned*)(F.lds + LDSCTL_OFF))[u] = 0u;
    __syncthreads();
    XcdBarrier bar = xcd_barrier_post((unsigned*)(F.ctl + CW_BAR), F.MISC + 8);
    const int lo = args.ph_lo, hi = args.ph_hi;
#ifndef REP0
#define REP0 1
#endif
#ifndef REP1
#define REP1 1
#endif
#ifndef REP3
#define REP3 1
#endif
#ifndef REP5
#define REP5 1
#endif
#ifndef REP67
#define REP67 1
#endif
#ifndef PHMASK
#define PHMASK 0xFFF
#endif
#define IN(k) (((PHMASK >> (k)) & 1) && lo <= (k) && (k) < hi)
#define BOTH(k) (IN(k) && IN((k) + 1))
#define GRID_BAR() xcd_barrier(bar)

    for (int rep_ = 0; rep_ < REP0; ++rep_) if (IN(0)) {
        LAS float* scr = (LAS float*)(F.lds + RING_OFF + F.wave * 16896);
        const int gw = F.vcu * NWAVES + F.wave, NGW = F.G * NWAVES;
        conv_jobs(0, 2, gw, NGW, args.in, ws, scr, F.lane);
        for (int m = gw; m < T; m += NGW) {
            const GAS f32x4* xr = (const GAS f32x4*)(x + (size_t)m * D) + F.lane; float s = 0.f;
#pragma unroll
            for (int j = 0; j < D / 256; ++j) { const f32x4 v = xr[64 * j]; s += (v.x * v.x + v.y * v.y) + (v.z * v.z + v.w * v.w); }
            s = wave_sum(s);
            if (F.lane == 0) rstd0[m] = 1.0f / sqrtf(s * (1.0f / D) + EPS);
        }
        if (BOTH(0)) GRID_BAR();
    }
    for (int rep_ = 0; rep_ < REP1; ++rep_) if (IN(1)) {
        static_assert(s5::LDS_END <= LDSCTL_OFF, "s5 LDS map");
        const s5::Params SPm{x, rstd0, args.in[10], args.in[1], args.in[2], args.in[3], args.in[4], args.in[5], args.in[6], args.in[7], args.in[8], ZO};
        int tid_ = threadIdx.x; asm volatile("" : "+v"(tid_));
        for (int it = F.vcu; it < NB * SG; it += F.G) s5::item(SPm, F.lds, it / SG, it % SG, tid_, __builtin_amdgcn_readfirstlane(tid_ >> 6), tid_ & 63);
        if (BOTH(1)) GRID_BAR();
    }
    if (IN(2)) {
        pg8::Gemm g{ZO, WgluT, T, 2 * D, D}; pg8::StaticOrder S; S.init(T, 2 * D, F.G, (int)blockIdx.x);
        pg8::EpiGluRes E{x, XA, XB, rowsq};
        pg8::gemm_phase<pg8::EpiGluRes, pg8::StaticOrder, true, true>(F.lds + RING_OFF, g, S, E);
        if (BOTH(2)) GRID_BAR();
    }
    for (int rep_ = 0; rep_ < REP3; ++rep_) if (IN(3)) {
        pg8::Gemm g{XB, Win0T, T, 2 * FF, D}; pg8::StaticOrder S; S.init(T, 2 * FF, F.G, (int)blockIdx.x);
        pg8::EpiSwiGlu E{rowsq, HQ, FF};
        pg8::gemm_phase<pg8::EpiSwiGlu, pg8::StaticOrder, true, true>(F.lds + RING_OFF, g, S, E);
        { int rk, cn; idle_rank((T / 256) * (2 * FF / 256), F.G, (int)blockIdx.x, rk, cn);
          if (rk >= 0) conv_jobs(2, 6, rk * NWAVES + F.wave, cn * NWAVES, args.in, ws, (LAS float*)(F.lds + RING_OFF + F.wave * 16896), F.lane); }
        if (BOTH(3)) GRID_BAR();
    }
    if (IN(4)) {
        pg8::Gemm g{HQ, Wout0T, T, D, FF}; pg8::StaticOrder S; S.init(T, D, F.G, (int)blockIdx.x);
        pg8::EpiRes<true> E{XA, XB, rowsq + T};
        pg8::gemm_phase<pg8::EpiRes<true>, pg8::StaticOrder, true, true>(F.lds + RING_OFF, g, S, E);
        if (BOTH(4)) GRID_BAR();
    }
    for (int rep_ = 0; rep_ < REP5; ++rep_) if (IN(5)) {
        pg8::Gemm g{XB, WqkvT, T, NQKV, D}; pg8::StaticOrder S; S.init(T, NQKV, F.G, (int)blockIdx.x);
        pg8::EpiQKV E{rowsq + T, HQ, KB, VB, QSCALE};
        pg8::gemm_phase<pg8::EpiQKV, pg8::StaticOrder, true, true>(F.lds + RING_OFF, g, S, E);
        { int rk, cn; idle_rank((T / 256) * (NQKV / 256), F.G, (int)blockIdx.x, rk, cn);
          if (rk >= 0) conv_jobs(6, 7, rk * NWAVES + F.wave, cn * NWAVES, args.in, ws, (LAS float*)(F.lds + RING_OFF + F.wave * 16896), F.lane); }
        if (BOTH(5)) GRID_BAR();
    }
    for (int rep_ = 0; rep_ < REP67; ++rep_) {
    if (IN(6)) {
        static_assert(att::LDS_END <= LDSCTL_OFF, "att LDS map");
        const att::Tensors TS{HQ, KB, VB, (bf16*)(ws + WS_OG), (float*)(ws + WS_LSE), ZO};
        int tid_ = threadIdx.x; asm volatile("" : "+v"(tid_));
        for (int u = blockIdx.x; u < 8 * 128; u += F.G) {
            const int pair = u & 7, v = u >> 3, g = 1 + (v >> 6), w = v & 63;
            const int rho = (g == 1) ? (w & 3) : (w & 15), qb = (g == 1) ? (w >> 2) : (w >> 4);
            const int un = u + F.G; int np = -1, ng = 0, nrho = 0, nqb = 0;
            if (un < 8 * 128) { const int v2 = un >> 3, w2 = v2 & 63; np = un & 7; ng = 1 + (v2 >> 6); nrho = (ng == 1) ? (w2 & 3) : (w2 & 15); nqb = (ng == 1) ? (w2 >> 2) : (w2 >> 4); }
            else if ((int)blockIdx.x < 8 * 64) { np = blockIdx.x & 7; ng = 0; nrho = 0; nqb = blockIdx.x >> 3; }
            att::unit<false>(TS, F.lds, pair, g, rho, qb, np, ng, nrho, nqb, tid_, __builtin_amdgcn_readfirstlane(tid_ >> 6), tid_ & 63);
        }
        if (BOTH(6)) GRID_BAR();
    }
    if (IN(7)) {
        const att::Tensors TS{HQ, KB, VB, (bf16*)(ws + WS_OG), (float*)(ws + WS_LSE), ZO};
        int tid_ = threadIdx.x; asm volatile("" : "+v"(tid_));
        for (int u = blockIdx.x; u < 8 * 64; u += F.G) { const int un = u + F.G; const int np = (un < 8 * 64) ? (un & 7) : -1;
            att::unit<true>(TS, F.lds, u & 7, 0, 0, u >> 3, np, 0, 0, un >> 3, tid_, __builtin_amdgcn_readfirstlane(tid_ >> 6), tid_ & 63); }
        if (BOTH(7)) GRID_BAR();
    }
    }
    if (IN(8)) {
        pg8::Gemm g{ZO, WoT, T, D, D}; pg8::StaticOrder S; S.init(T, D, F.G, (int)blockIdx.x);
        pg8::EpiRes<true> E{XA, XB, rowsq + 2 * T};
        pg8::gemm_phase<pg8::EpiRes<true>, pg8::StaticOrder, true, true>(F.lds + RING_OFF, g, S, E);
        if (BOTH(8)) GRID_BAR();
    }
    if (IN(9)) {
        pg8::Gemm g{XB, Win1T, T, 2 * FF, D}; pg8::StaticOrder S; S.init(T, 2 * FF, F.G, (int)blockIdx.x);
        pg8::EpiSwiGlu E{rowsq + 2 * T, HQ, FF};
        pg8::gemm_phase<pg8::EpiSwiGlu, pg8::StaticOrder, true, true>(F.lds + RING_OFF, g, S, E);
        { int rk, cn; idle_rank((T / 256) * (2 * FF / 256), F.G, (int)blockIdx.x, rk, cn);
          if (rk >= 0) conv_jobs(7, 8, rk * NWAVES + F.wave, cn * NWAVES, args.in, ws, (LAS float*)(F.lds + RING_OFF + F.wave * 16896), F.lane); }
        if (BOTH(9)) GRID_BAR();
    }
    if (IN(10)) {
        pg8::Gemm g{HQ, Wout1T, T, D, FF}; pg8::StaticOrder S; S.init(T, D, F.G, (int)blockIdx.x);
        pg8::EpiRes<true> E{XA, XB, rowsq + 3 * T};
        pg8::gemm_phase<pg8::EpiRes<true>, pg8::StaticOrder, true, true>(F.lds + RING_OFF, g, S, E);
        if (BOTH(10)) GRID_BAR();
    }
    if (IN(11)) {
        int lane_ = threadIdx.x & 63; asm volatile("" : "+v"(lane_));
        const int gw = F.vcu * NWAVES + F.wave, NGW = F.G * NWAVES;
        const GAS f32x4* gr = (const GAS f32x4*)args.in[19] + lane_;
        for (int m = gw; m < T; m += NGW) {
            const GAS f32x4* xr = (const GAS f32x4*)(XA + (size_t)m * D) + lane_; GAS f32x4* orow = (GAS f32x4*)(args.out + (size_t)m * D) + lane_;
            f32x4 v[D / 256]; float s = 0.f;
#pragma unroll
            for (int j = 0; j < D / 256; ++j) { v[j] = xr[64 * j]; s += (v[j].x * v[j].x + v[j].y * v[j].y) + (v[j].z * v[j].z + v[j].w * v[j].w); }
            s = wave_sum(s);
            const float r = 1.0f / sqrtf(s * (1.0f / D) + EPS);
#pragma unroll
            for (int j = 0; j < D / 256; ++j) orow[64 * j] = v[j] * r * gr[64 * j];
        }
    }
#undef IN
#undef BOTH
#undef GRID_BAR
}

extern "C" void kernel_launch(void* const* d_in, const int* in_sizes, int n_in, void* d_out, int out_size, void* d_ws, size_t ws_size, hipStream_t stream) {
    static int grid = 0;
    if (grid == 0) {
        if (n_in != 20 || out_size != T * D || ws_size < WS_END) { fprintf(stderr, "kernel_launch: unexpected shapes/ws (n_in %d out %d ws %zu)\n", n_in, out_size, ws_size); grid = -1; return; }
        int dev = 0, cus = 0;
        if (hipGetDevice(&dev) != hipSuccess || hipDeviceGetAttribute(&cus, hipDeviceAttributeMultiprocessorCount, dev) != hipSuccess) { grid = -1; return; }
        if (hipFuncSetAttribute((const void*)mk_fwd, hipFuncAttributeMaxDynamicSharedMemorySize, LDS_BYTES) != hipSuccess) { fprintf(stderr, "kernel_launch: hipFuncSetAttribute failed\n"); grid = -1; return; }
        (void)hipGetLastError();
        grid = cus;
    }
    if (grid < 0) return;
    (void)hipMemsetAsync((char*)d_ws + WS_CTL, 0, CTL_ZERO_BYTES, stream);
    Args a{};
    for (int i = 0; i < 20; ++i) a.in[i] = (const float*)d_in[i];
    a.out = (float*)d_out; a.ws = (unsigned char*)d_ws;
    unsigned char* ws = (unsigned char*)d_ws;
#define LAUNCH(lo_, hi_) do { a.ph_lo = (lo_); a.ph_hi = (hi_); hipLaunchKernelGGL(mk_fwd, dim3(grid), dim3(NWAVES * 64), LDS_BYTES, stream, a); } while (0)
    LAUNCH(0, 12);
#undef LAUNCH
}
```
